# Optimizing an MI355X kernel written in HIP

```python
import jax, jax.numpy as jnp
from jax import lax
import numpy as np

D_MODEL = 1024
BATCH = 8
SEQ = 2048
DEPTH = 2

MIX_WIDTH = D_MODEL
RET_WIDTH = MIX_WIDTH // 2
HG_WIDTH = MIX_WIDTH - RET_WIDTH
RET_HEADS = 4
RET_V_DIM = RET_WIDTH // RET_HEADS
RET_QK_DIM = RET_V_DIM // 2
RET_QK_WIDTH = RET_HEADS * RET_QK_DIM
HG_HEADS = 4
HG_DIM = HG_WIDTH // HG_HEADS
CHUNK = 64
D_FF = -(-8 * D_MODEL // (3 * 256)) * 256
ROPE_BASE = 10000.0
EPS = 1e-6
N_MOD = 6
IN_SPLITS = (RET_QK_WIDTH, RET_QK_WIDTH, RET_WIDTH, RET_WIDTH, HG_WIDTH, HG_WIDTH, HG_WIDTH, HG_WIDTH)
IN_WIDTH = sum(IN_SPLITS)
IN_OFFSETS = tuple(int(v) for v in np.cumsum(IN_SPLITS)[:-1])

kernel_name = "hybrid_retention_hgrn2_adaln_block"


def rmsnorm(x, w):
    xf = x.astype(jnp.float32)
    y = xf * lax.rsqrt(jnp.mean(xf * xf, axis=-1, keepdims=True) + EPS)
    return (y * w.astype(jnp.float32)).astype(x.dtype)


def head_rmsnorm(o, w):
    B, S, H, d = o.shape
    y = o * lax.rsqrt(jnp.mean(o * o, axis=-1, keepdims=True) + EPS)
    return y.reshape(B, S, H * d) * w.astype(jnp.float32)


def rotary(x, pos):
    d = x.shape[-1]
    inv = ROPE_BASE ** (-jnp.linspace(0.0, 1.0, d // 2, dtype=jnp.float32))
    theta = pos[:, None] * inv[None, :]
    cos = jnp.cos(theta)[None, :, None, :]
    sin = jnp.sin(theta)[None, :, None, :]
    x1, x2 = x[..., 0::2], x[..., 1::2]
    out = jnp.stack([x1 * cos - x2 * sin, x1 * sin + x2 * cos], axis=-1)
    return out.reshape(x.shape)


def to_chunks(x):
    B, S, H, d = x.shape
    return x.reshape(B, S // CHUNK, CHUNK, H, d).transpose(1, 0, 3, 2, 4)


def from_chunks(y):
    nC, B, H, C, d = y.shape
    return y.transpose(1, 0, 3, 2, 4).reshape(B, nC * C, H, d)


def retention_chunkwise(q, k, v):
    B, S, H, dk = q.shape
    dv = v.shape[-1]
    log_gamma = jnp.log(1.0 - jnp.power(2.0, -5.0 - jnp.arange(H, dtype=jnp.float32)))
    idx = jnp.arange(CHUNK, dtype=jnp.float32)
    rel = idx[:, None] - idx[None, :]
    inner_decay = jnp.exp(jnp.where(rel[None] >= 0, log_gamma[:, None, None] * rel[None], -jnp.inf))
    cross_decay = jnp.exp(log_gamma[:, None] * (idx[None, :] + 1.0))
    state_decay = jnp.exp(log_gamma[:, None] * (CHUNK - 1.0 - idx[None, :]))
    chunk_decay = jnp.exp(log_gamma * CHUNK)

    def step(R, inp):
        qc, kc, vc = inp
        scores = jnp.einsum('bhtd,bhsd->bhts', qc, kc) * inner_decay[None]
        o = (jnp.einsum('bhts,bhsv->bhtv', scores, vc)
             + jnp.einsum('bhtd,bhdv->bhtv', qc, R) * cross_decay[None, :, :, None])
        R = (chunk_decay[None, :, None, None] * R
             + jnp.einsum('bhsd,bhsv->bhdv', kc * state_decay[None, :, :, None], vc))
        return R, o

    R0 = jnp.zeros((B, H, dk, dv), jnp.float32)
    _, o = lax.scan(step, R0, (to_chunks(q), to_chunks(k), to_chunks(v)))
    return from_chunks(o)


def hgrn2_chunkwise(q, k, log_f, v):
    B, S, H, dk = q.shape
    dv = v.shape[-1]
    causal = jnp.tril(jnp.ones((CHUNK, CHUNK), dtype=bool))

    def step(St, inp):
        qc, kc, gc, vc = inp
        b = jnp.cumsum(gc, axis=2)
        diff = b[:, :, :, None, :] - b[:, :, None, :, :]
        decay = jnp.exp(jnp.where(causal[None, None, :, :, None], diff, -jnp.inf))
        scores = jnp.einsum('bhtsd,bhsd->bhts', decay * qc[:, :, :, None, :], kc)
        o = (jnp.einsum('bhts,bhsv->bhtv', scores, vc)
             + jnp.einsum('bhtd,bhdv->bhtv', qc * jnp.exp(b), St))
        b_last = b[:, :, -1:, :]
        St = (jnp.exp(b_last[:, :, 0, :])[..., None] * St
              + jnp.einsum('bhsd,bhsv->bhdv', kc * jnp.exp(b_last - b), vc))
        return St, o

    S0 = jnp.zeros((B, H, dk, dv), jnp.float32)
    _, o = lax.scan(step, S0, (to_chunks(q), to_chunks(k), to_chunks(log_f), to_chunks(v)))
    return from_chunks(o)


def hybrid_mixer(h, layer, w_in, ret_norm_w, hg_lower_bounds, hg_norm_w, w_out):
    B, S, _ = h.shape
    pos = jnp.arange(S, dtype=jnp.float32)
    proj = h @ w_in
    rq, rk, rv, rg, hq, hf, hi, hg = jnp.split(proj, IN_OFFSETS, axis=-1)

    rq = rotary(rq.astype(jnp.float32).reshape(B, S, RET_HEADS, RET_QK_DIM), pos)
    rk = rotary(rk.astype(jnp.float32).reshape(B, S, RET_HEADS, RET_QK_DIM), pos) * (RET_QK_DIM ** -0.5)
    rv = rv.astype(jnp.float32).reshape(B, S, RET_HEADS, RET_V_DIM)
    o_ret = retention_chunkwise(rq, rk, rv)
    o_ret = head_rmsnorm(o_ret, ret_norm_w) * jax.nn.silu(rg.astype(jnp.float32))

    hf = hf.astype(jnp.float32)
    if layer == 0:
        log_f = jax.nn.log_sigmoid(hf)
        k_in = jax.nn.sigmoid(-hf)
    else:
        probs = jax.nn.softmax(hg_lower_bounds.astype(jnp.float32), axis=0)
        lb = (jnp.cumsum(probs, axis=0) - probs[0:1])[layer]
        f = lb + (1.0 - lb) * jax.nn.sigmoid(hf)
        log_f = jnp.log(f)
        k_in = 1.0 - f
    hq = jax.nn.silu(hq.astype(jnp.float32)).reshape(B, S, HG_HEADS, HG_DIM)
    o_hg = hgrn2_chunkwise(hq,
                           k_in.reshape(B, S, HG_HEADS, HG_DIM),
                           log_f.reshape(B, S, HG_HEADS, HG_DIM),
                           hi.astype(jnp.float32).reshape(B, S, HG_HEADS, HG_DIM))
    o_hg = head_rmsnorm(o_hg, hg_norm_w) * jax.nn.silu(hg.astype(jnp.float32))

    o = jnp.concatenate([o_ret, o_hg], axis=-1).astype(h.dtype)
    return o @ w_out


def swiglu(h, w_gate, w_up, w_down):
    return (jax.nn.silu(h @ w_gate) * (h @ w_up)) @ w_down


def setup_inputs(seed: int = 0) -> dict:
    key = jax.random.key(seed)
    ks = jax.random.split(key, 16)
    f32 = jnp.float32
    nrm = lambda k, shape, s: jax.random.normal(k, shape, f32) * s
    return {
        "x": nrm(ks[0], (BATCH, SEQ, D_MODEL), 1.0),
        "c": nrm(ks[1], (BATCH, D_MODEL), 1.0),
        "w_ada": nrm(ks[2], (DEPTH, D_MODEL, N_MOD * D_MODEL), 0.5 * D_MODEL ** -0.5),
        "b_ada": nrm(ks[3], (DEPTH, N_MOD * D_MODEL), 0.01),
        "norm_mix_w": 1.0 + nrm(ks[4], (DEPTH, D_MODEL), 0.02),
        "w_in": nrm(ks[5], (DEPTH, D_MODEL, IN_WIDTH), D_MODEL ** -0.5),
        "ret_norm_w": 1.0 + nrm(ks[6], (DEPTH, RET_WIDTH), 0.02),
        "hg_lower_bounds": nrm(ks[7], (DEPTH, HG_WIDTH), 0.5),
        "hg_norm_w": 1.0 + nrm(ks[8], (DEPTH, HG_WIDTH), 0.02),
        "w_out": nrm(ks[9], (DEPTH, MIX_WIDTH, D_MODEL), MIX_WIDTH ** -0.5),
        "norm_ffn_w": 1.0 + nrm(ks[10], (DEPTH, D_MODEL), 0.02),
        "w_ffn_gate": nrm(ks[11], (DEPTH, D_MODEL, D_FF), D_MODEL ** -0.5),
        "w_ffn_up": nrm(ks[12], (DEPTH, D_MODEL, D_FF), D_MODEL ** -0.5),
        "w_ffn_down": nrm(ks[13], (DEPTH, D_FF, D_MODEL), D_FF ** -0.5),
        "final_norm_w": 1.0 + nrm(ks[14], (D_MODEL,), 0.02),
    }


def reference(x, c, w_ada, b_ada, norm_mix_w, w_in, ret_norm_w, hg_lower_bounds, hg_norm_w, w_out,
              norm_ffn_w, w_ffn_gate, w_ffn_up, w_ffn_down, final_norm_w):
    c_act = jax.nn.silu(c)
    for layer in range(DEPTH):
        mod = c_act @ w_ada[layer] + b_ada[layer]
        sh1, sc1, g1, sh2, sc2, g2 = jnp.split(mod[:, None, :], N_MOD, axis=-1)
        h = rmsnorm(x, norm_mix_w[layer]) * (1.0 + sc1) + sh1
        x = x + g1 * hybrid_mixer(h, layer, w_in[layer], ret_norm_w[layer], hg_lower_bounds,
                                  hg_norm_w[layer], w_out[layer])
        h = rmsnorm(x, norm_ffn_w[layer]) * (1.0 + sc2) + sh2
        x = x + g2 * swiglu(h, w_ffn_gate[layer], w_ffn_up[layer], w_ffn_down[layer])
    return rmsnorm(x, final_norm_w)
```

```cpp
#include <hip/hip_runtime.h>
#include <cstdio>
#include <cstdint>
#define LAS __attribute__((address_space(3)))


#define XB_TMO      128
#define XB_XCNT(j)  (256  + 64 * (j))
#define XB_XSUB(j)  (1280 + 64 * (j))
#define XB_XGEN(j)  (2304 + 64 * (j))
#define XB_TOP      3328
#define XB_TOPGEN   3392
#define XCD_BAR_WORDS 3456
#define XB_SPIN_CAP (1u << 18)

__device__ __forceinline__ unsigned xb_ld(unsigned* p)              { return __hip_atomic_load(p, __ATOMIC_RELAXED, __HIP_MEMORY_SCOPE_AGENT); }
__device__ __forceinline__ unsigned xb_add(unsigned* p, unsigned v) { return __hip_atomic_fetch_add(p, v, __ATOMIC_RELAXED, __HIP_MEMORY_SCOPE_AGENT); }
__device__ __forceinline__ unsigned xb_xcc_id() { return (unsigned)__builtin_amdgcn_s_getreg((3 << 11) | 20) & 0xFu; }
#define XB_SPIN(cond, bar) do { unsigned _sp = 0; while (cond) { __builtin_amdgcn_s_sleep(1); \
    if ((++_sp & 255u) == 0u) { if (xb_ld(&(bar)[XB_TMO])) break; if (_sp > XB_SPIN_CAP) { atomicAdd(&(bar)[XB_TMO], 1u); break; } } } } while (0)

struct XcdBarrier {
    unsigned* bar; unsigned x;
    volatile LAS unsigned* st;
};

__device__ __forceinline__ XcdBarrier xcd_barrier_post(unsigned* bar, volatile LAS unsigned* st) {
    XcdBarrier b; b.bar = bar; b.x = xb_xcc_id(); b.st = st;
    if (threadIdx.x == 0) (void)xb_add(&bar[XB_XCNT(b.x)], 1u);
    return b;
}
__device__ __forceinline__ void xcd_barrier_complete(unsigned* bar, unsigned x, unsigned& nloc, unsigned& nx) {
    const unsigned G = gridDim.x * gridDim.y * gridDim.z;
    unsigned sum, cnt, mine, sp = 0u;
    for (;;) {
        sum = 0u; cnt = 0u; mine = 0u;
#pragma unroll
        for (unsigned j = 0; j < 16; ++j) { const unsigned c = xb_ld(&bar[XB_XCNT(j)]); sum += c; cnt += (c > 0u) ? 1u : 0u; mine = (j == x) ? c : mine; }
        if (sum == G) break;
        __builtin_amdgcn_s_sleep(1);
        if ((++sp & 255u) == 0u) { if (xb_ld(&bar[XB_TMO])) break; if (sp > XB_SPIN_CAP) { atomicAdd(&bar[XB_TMO], 1u); break; } }
    }
    nloc = mine > 0u ? mine : 1u; nx = cnt > 0u ? cnt : 1u;
}

__device__ __forceinline__ void xcd_barrier(const XcdBarrier& b) {
    asm volatile("s_waitcnt vmcnt(0)" ::: "memory");
    __syncthreads();
    if (threadIdx.x == 0) {
        unsigned* bar = b.bar; const unsigned bx_ = xb_xcc_id();
        __builtin_amdgcn_s_waitcnt(0);
        unsigned nloc = b.st[0], nx = b.st[1];
        if (nloc == 0u) { xcd_barrier_complete(bar, bx_, nloc, nx); b.st[0] = nloc; b.st[1] = nx; }
        const unsigned old = xb_add(&bar[XB_XSUB(bx_)], 1u);
        const unsigned gen = old / nloc;
        if (old + 1u == (gen + 1u) * nloc) {
            __builtin_amdgcn_fence(__ATOMIC_RELEASE, "agent");
            asm volatile("s_waitcnt vmcnt(0)" ::: "memory");
            const unsigned og = xb_add(&bar[XB_TOP], 1u);
            const unsigned tg = og / nx;
            if (og + 1u == (tg + 1u) * nx) xb_add(&bar[XB_TOPGEN], 1u);
            else XB_SPIN(xb_ld(&bar[XB_TOPGEN]) == tg, bar);
            __builtin_amdgcn_fence(__ATOMIC_ACQUIRE, "agent");
            xb_add(&bar[XB_XGEN(bx_)], 1u);
            asm volatile("s_waitcnt vmcnt(0)" ::: "memory");
        } else {
            XB_SPIN(xb_ld(&bar[XB_XGEN(bx_)]) == gen, bar);
            __builtin_amdgcn_fence(__ATOMIC_ACQUIRE, "agent");
            asm volatile("s_waitcnt vmcnt(0)" ::: "memory");
        }
    }
    __syncthreads();
}

namespace pg8 {
#define PG8_LAS __attribute__((address_space(3)))
typedef unsigned short bf16_t;
typedef short bf16x8 __attribute__((ext_vector_type(8)));
typedef float f32x4 __attribute__((ext_vector_type(4)));
typedef unsigned u32x4 __attribute__((ext_vector_type(4)));
constexpr int BM = 256, BK = 64, HALF = 128, HTB = HALF * BK * 2  , STAGE_BYTES = 8 * HTB, NXCD = 8;
constexpr int WGM = 2;

__host__ __device__ __forceinline__ int lds_byte(int r, int c) { const int st = (r >> 4) * 2 + (c >> 5), rr = r & 15, cc = c & 31, ob = rr * 64 + cc * 2; return st * 1024 + (ob ^ (((ob >> 9) & 1) << 5)); }
__host__ __device__ __forceinline__ void stage_rc(int b, int& R, int& C) { const int st = b / 1024, sb = b % 1024, swz = sb ^ (((sb >> 9) & 1) << 5); R = (st >> 1) * 16 + swz / 64; C = (st & 1) * 32 + (swz % 64) / 2; }
__host__ __device__ __forceinline__ int perm32(int rho) { const int n = rho >> 4, i = rho & 15; return 8 * (i >> 2) + 4 * n + (i & 3); }

struct Unit { int pm, pn; };
struct Gemm { const bf16_t* A; const bf16_t* Bt; int M, N, K; };

struct StaticOrder {
    int nM, nN, nwg, G, c;
    __host__ __device__ void init(int M, int N, int G_, int c_) { nM = M / BM; nN = N / BM; nwg = nM * nN; G = G_; c = c_; }
    __host__ __device__ bool next(int i, Unit& u) const {
        const long L = (long)i * G + c; if (L >= nwg) return false;
        int wgid = (int)L; { const int q = nwg / NXCD, r = nwg % NXCD, xcd = wgid % NXCD, off = wgid / NXCD; wgid = (xcd < r ? xcd * (q + 1) : r * (q + 1) + (xcd - r) * q) + off; }
        const int nig = WGM * nN, gid = wgid / nig, fm = gid * WGM, gsz = (nM - fm) < WGM ? (nM - fm) : WGM;
        u.pm = fm + ((wgid % nig) % gsz); u.pn = (wgid % nig) / gsz; return true;
    }
    __device__ __forceinline__ void a_ready(const Unit&) const {}
    __device__ __forceinline__ void done(const Unit&) const {}
};

typedef float f32x2c_t __attribute__((ext_vector_type(2))); typedef __bf16 bf16x2c_t __attribute__((ext_vector_type(2)));
__device__ __forceinline__ unsigned cvt_pk_bf16(float lo, float hi) { const f32x2c_t v = {lo, hi}; const bf16x2c_t b = __builtin_convertvector(v, bf16x2c_t); return __builtin_bit_cast(unsigned, b); }
typedef float f32x2 __attribute__((ext_vector_type(2)));


constexpr float K_EPS = 1e-6f;
#define PG8_LD1(p) (*(p))
#define PG8_ST(T, p, v) (*(T*)(p) = (v))
__device__ __forceinline__ float silu_f(float v) { return v * __builtin_amdgcn_rcpf(1.f + __expf(-v)); }
__device__ __forceinline__ unsigned pk_f16(float lo, float hi) { const _Float16 a = (_Float16)lo, b = (_Float16)hi; return (unsigned)__builtin_bit_cast(unsigned short, a) | ((unsigned)__builtin_bit_cast(unsigned short, b) << 16); }

struct EpiWin {
    static constexpr bool PERM = true, AFTER_DRAIN = false, STAGED = true; static constexpr int NSTORE = 16;
    bf16_t* proj;
    const float* ssum;
    const float* shw;
    const float2* tab;
    const float* lbw;
    int layer;
    PG8_LAS unsigned char* stage;
    int pn_off;
    __device__ __forceinline__ void prefetch(const Unit& u, int ui, int wid, int lane) const {
        const float* src = wid < 4 ? ssum + u.pm * BM + 64 * wid + lane : shw + (size_t)(u.pm >> 3) * 3584 + (u.pn + pn_off) * BM + 64 * (wid - 4) + lane;
        __builtin_amdgcn_global_load_lds((const unsigned*)src, (PG8_LAS unsigned*)(stage + (ui & 1) * 2048 + wid * 256), 4, 0, 0);
    }
    __device__ __forceinline__ void operator()(const f32x4 (&acc)[2][2][4][2], const Unit& u, int wr, int wc, int fr_in, int fq_in, int ui) const {
        int fr = fr_in, fq = fq_in; asm volatile("" : "+v"(fr), "+v"(fq));
        const int b = u.pm >> 3, pn = u.pn + pn_off;
        const int colb = pn * BM + wc * 32 + 8 * fq;
        const PG8_LAS float* SS = (const PG8_LAS float*)(stage + (ui & 1) * 2048); const PG8_LAS float* SV = SS + 256;
        const int type = pn == 0 ? 0 : pn == 1 ? 1 : (pn == 2 || pn == 3 || pn == 10 || pn == 11) ? 2 : (pn == 8 || pn == 9) ? 4 : 3;
        f32x4 sv[2][2];
#pragma unroll
        for (int bj = 0; bj < 2; ++bj)
#pragma unroll
            for (int n = 0; n < 2; ++n) sv[bj][n] = *(const PG8_LAS f32x4*)(SV + bj * HALF + wc * 32 + 8 * fq + 4 * n);
        float lb[2][8];
#pragma unroll
        for (int bj = 0; bj < 2; ++bj)
#pragma unroll
            for (int i = 0; i < 8; ++i) lb[bj][i] = 0.f;
        if (type == 4 && layer != 0) {
#pragma unroll
            for (int bj = 0; bj < 2; ++bj)
#pragma unroll
                for (int i = 0; i < 8; ++i) { const int c = colb + bj * HALF + i - 2048; lb[bj][i] = __builtin_amdgcn_rcpf(1.f + __expf(lbw[c] - lbw[512 + c])); }
        }
        if (type <= 1) {
            const float sc = type == 1 ? 0.125f : 1.f;
#pragma unroll
            for (int ap = 0; ap < 4; ++ap) { const int ai = ap >> 1, m0 = (ap & 1) * 2;
                f32x4 tb[2][2][2];
#pragma unroll
                for (int mm = 0; mm < 2; ++mm)
#pragma unroll
                    for (int bj = 0; bj < 2; ++bj) { const int pos = (u.pm * BM + ai * HALF + wr * 64 + (m0 + mm) * 16 + fr) & 2047, i0 = ((colb + bj * HALF) & 63) >> 1;
                        tb[mm][bj][0] = *(const f32x4*)(tab + pos * 32 + i0); tb[mm][bj][1] = *(const f32x4*)(tab + pos * 32 + i0 + 2); }
#pragma unroll
                for (int mm = 0; mm < 2; ++mm) { const int m = m0 + mm; const int row = u.pm * BM + ai * HALF + wr * 64 + m * 16 + fr;
                    const float rs = __builtin_amdgcn_rsqf(SS[ai * HALF + wr * 64 + m * 16 + fr] * (1.f / 1024.f) + K_EPS);
#pragma unroll
                    for (int bj = 0; bj < 2; ++bj) {
                        const f32x4 v0 = acc[ai][bj][m][0] * rs + sv[bj][0], v1 = acc[ai][bj][m][1] * rs + sv[bj][1];
                        const f32x4 t0 = tb[mm][bj][0], t1 = tb[mm][bj][1];
                        float o[8];
                        o[0] = (v0[0] * t0[0] - v0[1] * t0[1]) * sc; o[1] = (v0[0] * t0[1] + v0[1] * t0[0]) * sc;
                        o[2] = (v0[2] * t0[2] - v0[3] * t0[3]) * sc; o[3] = (v0[2] * t0[3] + v0[3] * t0[2]) * sc;
                        o[4] = (v1[0] * t1[0] - v1[1] * t1[1]) * sc; o[5] = (v1[0] * t1[1] + v1[1] * t1[0]) * sc;
                        o[6] = (v1[2] * t1[2] - v1[3] * t1[3]) * sc; o[7] = (v1[2] * t1[3] + v1[3] * t1[2]) * sc;
                        u32x4 w; w.x = cvt_pk_bf16(o[0], o[1]); w.y = cvt_pk_bf16(o[2], o[3]); w.z = cvt_pk_bf16(o[4], o[5]); w.w = cvt_pk_bf16(o[6], o[7]);
                        PG8_ST(u32x4, proj + (size_t)row * 3584 + colb + bj * HALF, w);
                    }
                }
                asm volatile("" ::: "memory");
            }
            return;
        }
#pragma unroll
        for (int ai = 0; ai < 2; ++ai)
#pragma unroll
            for (int m = 0; m < 4; ++m) {
                const int row = u.pm * BM + ai * HALF + wr * 64 + m * 16 + fr;
                const float rs = __builtin_amdgcn_rsqf(SS[ai * HALF + wr * 64 + m * 16 + fr] * (1.f / 1024.f) + K_EPS);
                const int pos = row & 2047;
#pragma unroll
                for (int bj = 0; bj < 2; ++bj) {
                    float v[8];
                    {   const f32x4 v0 = acc[ai][bj][m][0] * rs + sv[bj][0], v1 = acc[ai][bj][m][1] * rs + sv[bj][1];
                        v[0] = v0[0]; v[1] = v0[1]; v[2] = v0[2]; v[3] = v0[3]; v[4] = v1[0]; v[5] = v1[1]; v[6] = v1[2]; v[7] = v1[3]; }
                    u32x4 w;
                    if (type == 2) {
                        w.x = cvt_pk_bf16(v[0], v[1]); w.y = cvt_pk_bf16(v[2], v[3]); w.z = cvt_pk_bf16(v[4], v[5]); w.w = cvt_pk_bf16(v[6], v[7]);
                    } else if (type == 3) {
                        unsigned wv[4];
#pragma unroll
                        for (int q = 0; q < 4; ++q) { const f32x2 x = (f32x2){v[2 * q], v[2 * q + 1]}, xn = x * (-1.44269504089f);
                            f32x2 e; e.x = __builtin_amdgcn_exp2f(xn.x); e.y = __builtin_amdgcn_exp2f(xn.y);
                            const f32x2 d = e + 1.0f; f32x2 r; r.x = __builtin_amdgcn_rcpf(d.x); r.y = __builtin_amdgcn_rcpf(d.y);
                            const f32x2 o = x * r; wv[q] = cvt_pk_bf16(o.x, o.y); }
                        w.x = wv[0]; w.y = wv[1]; w.z = wv[2]; w.w = wv[3];
                    } else {
                        float g[8];
                        if (layer == 0) {
#pragma unroll
                            for (int i = 0; i < 8; ++i) g[i] = fminf(v[i], 0.f) - __logf(1.f + __expf(-fabsf(v[i])));
                        } else {
#pragma unroll
                            for (int i = 0; i < 8; ++i) { const float s = __builtin_amdgcn_rcpf(1.f + __expf(-v[i])); g[i] = __logf(lb[bj][i] + (1.f - lb[bj][i]) * s); }
                        }
                        w.x = pk_f16(g[0], g[1]); w.y = pk_f16(g[2], g[3]); w.z = pk_f16(g[4], g[5]); w.w = pk_f16(g[6], g[7]);
                    }
                    PG8_ST(u32x4, proj + (size_t)row * 3584 + colb + bj * HALF, w);
                }
            }
    }
};

__device__ __forceinline__ float f16lo(unsigned w) { return (float)__builtin_bit_cast(_Float16, (unsigned short)(w & 0xffffu)); }
__device__ __forceinline__ float f16hi(unsigned w) { return (float)__builtin_bit_cast(_Float16, (unsigned short)(w >> 16)); }
template <bool XF32> struct EpiRes {
    static constexpr bool PERM = true, AFTER_DRAIN = false, STAGED = false; static constexpr int NSTORE = 0;
    const void* xres; bf16_t* xout;
    const float* gvec;
    const float* nw; const float* scv;
    bf16_t* anext;
    float* ssum;
    __device__ __forceinline__ void operator()(const f32x4 (&acc)[2][2][4][2], const Unit& u, int wr, int wc, int fr_in, int fq_in) const {
        int fr = fr_in, fq = fq_in; asm volatile("" : "+v"(fr), "+v"(fq));
        const int b = u.pm >> 3;
        const int colb = u.pn * BM + wc * 32 + 8 * fq;
        f32x4 gv[2][2], wm[2][2];
#pragma unroll
        for (int bj = 0; bj < 2; ++bj)
#pragma unroll
            for (int n = 0; n < 2; ++n) {
                const int c = colb + bj * HALF + 4 * n;
                gv[bj][n] = *(const f32x4*)(gvec + (size_t)b * 6144 + c);
                wm[bj][n] = nw ? (*(const f32x4*)(nw + c)) * (1.f + *(const f32x4*)(scv + (size_t)b * 6144 + c)) : (f32x4){0.f, 0.f, 0.f, 0.f};
            }
#pragma unroll
        for (int ap = 0; ap < 4; ++ap) { const int ai = ap >> 1, m0 = (ap & 1) * 2;
            f32x4 pre[2][2][2];
#pragma unroll
            for (int mm = 0; mm < 2; ++mm)
#pragma unroll
                for (int bj = 0; bj < 2; ++bj) { const size_t off = (size_t)(u.pm * BM + ai * HALF + wr * 64 + (m0 + mm) * 16 + fr) * 1024 + colb + bj * HALF;
                    if constexpr (XF32) { pre[mm][bj][0] = *(const f32x4*)((const float*)xres + off); pre[mm][bj][1] = *(const f32x4*)((const float*)xres + off + 4); }
                    else { const u32x4 h = *(const u32x4*)((const bf16_t*)xres + off); pre[mm][bj][0] = __builtin_bit_cast(f32x4, h); } }
#pragma unroll
            for (int mm = 0; mm < 2; ++mm) { const int m = m0 + mm;
                const int row = u.pm * BM + ai * HALF + wr * 64 + m * 16 + fr;
                float ss = 0.f;
#pragma unroll
                for (int bj = 0; bj < 2; ++bj) {
                    const size_t off = (size_t)row * 1024 + colb + bj * HALF;
                    f32x4 r0, r1;
                    if constexpr (XF32) { r0 = pre[mm][bj][0]; r1 = pre[mm][bj][1]; }
                    else { const u32x4 h = __builtin_bit_cast(u32x4, pre[mm][bj][0]); r0 = (f32x4){f16lo(h.x), f16hi(h.x), f16lo(h.y), f16hi(h.y)}; r1 = (f32x4){f16lo(h.z), f16hi(h.z), f16lo(h.w), f16hi(h.w)}; }
                    const f32x4 x0 = r0 + gv[bj][0] * acc[ai][bj][m][0], x1 = r1 + gv[bj][1] * acc[ai][bj][m][1];
                    { u32x4 hx; hx.x = pk_f16(x0[0], x0[1]); hx.y = pk_f16(x0[2], x0[3]); hx.z = pk_f16(x1[0], x1[1]); hx.w = pk_f16(x1[2], x1[3]); PG8_ST(u32x4, xout + off, hx); }
                    ss += (x0[0] * x0[0] + x0[1] * x0[1]) + (x0[2] * x0[2] + x0[3] * x0[3]) + (x1[0] * x1[0] + x1[1] * x1[1]) + (x1[2] * x1[2] + x1[3] * x1[3]);
                    if (nw) { const f32x4 a0 = x0 * wm[bj][0], a1 = x1 * wm[bj][1]; u32x4 w; w.x = cvt_pk_bf16(a0[0], a0[1]); w.y = cvt_pk_bf16(a0[2], a0[3]); w.z = cvt_pk_bf16(a1[0], a1[1]); w.w = cvt_pk_bf16(a1[2], a1[3]);
                        PG8_ST(u32x4, anext + off, w); }
                }
                ss += __shfl_xor(ss, 16); ss += __shfl_xor(ss, 32);
                if (fq == 0) atomicAdd(ssum + row, ss);
            }
            asm volatile("" ::: "memory");
        }
    }
};

struct EpiFinal {
    static constexpr bool PERM = true, AFTER_DRAIN = true, STAGED = false; static constexpr int NSTORE = 0;
    const bf16_t* xres; float* out; const float* gvec; const float* fw; float* ssum; const XcdBarrier* bar;
    __device__ __forceinline__ void fused(f32x4 (&acc)[2][2][4][2], const Unit& u, int wr, int wc, int fr_in, int fq_in, PG8_LAS unsigned char* lds, int wid, int lane) const {
        int fr = fr_in, fq = fq_in; asm volatile("" : "+v"(fr), "+v"(fq));
        const int b = u.pm >> 3;
        const int colb = u.pn * BM + wc * 32 + 8 * fq;
        {
            f32x4 gv[2][2];
#pragma unroll
            for (int bj = 0; bj < 2; ++bj)
#pragma unroll
                for (int n = 0; n < 2; ++n) gv[bj][n] = *(const f32x4*)(gvec + (size_t)b * 6144 + colb + bj * HALF + 4 * n);
#pragma unroll
            for (int ai = 0; ai < 2; ++ai) {
                u32x4 pre[4][2];
#pragma unroll
                for (int m = 0; m < 4; ++m)
#pragma unroll
                    for (int bj = 0; bj < 2; ++bj) pre[m][bj] = *(const u32x4*)(xres + (size_t)(u.pm * BM + ai * HALF + wr * 64 + m * 16 + fr) * 1024 + colb + bj * HALF);
#pragma unroll
                for (int m = 0; m < 4; ++m) {
                    const int row = u.pm * BM + ai * HALF + wr * 64 + m * 16 + fr;
                    float ss = 0.f;
#pragma unroll
                    for (int bj = 0; bj < 2; ++bj) {
                        const u32x4 h = pre[m][bj];
                        const f32x4 r0 = (f32x4){f16lo(h.x), f16hi(h.x), f16lo(h.y), f16hi(h.y)}, r1 = (f32x4){f16lo(h.z), f16hi(h.z), f16lo(h.w), f16hi(h.w)};
                        const f32x4 x0 = r0 + gv[bj][0] * acc[ai][bj][m][0], x1 = r1 + gv[bj][1] * acc[ai][bj][m][1];
                        acc[ai][bj][m][0] = x0; acc[ai][bj][m][1] = x1;
                        ss += (x0[0] * x0[0] + x0[1] * x0[1]) + (x0[2] * x0[2] + x0[3] * x0[3]) + (x1[0] * x1[0] + x1[1] * x1[1]) + (x1[2] * x1[2] + x1[3] * x1[3]);
                    }
                    ss += __shfl_xor(ss, 16); ss += __shfl_xor(ss, 32);
                    if (fq == 0) atomicAdd(ssum + row, ss);
                }
                asm volatile("" ::: "memory");
            }
        }
        xcd_barrier(*bar);
        f32x4 fv[2][2];
#pragma unroll
        for (int bj = 0; bj < 2; ++bj)
#pragma unroll
            for (int n = 0; n < 2; ++n) fv[bj][n] = *(const f32x4*)(fw + colb + bj * HALF + 4 * n);
        float sq[2][4];
#pragma unroll
        for (int ai = 0; ai < 2; ++ai)
#pragma unroll
            for (int m = 0; m < 4; ++m) sq[ai][m] = __hip_atomic_load(ssum + u.pm * BM + ai * HALF + wr * 64 + m * 16 + fr, __ATOMIC_RELAXED, __HIP_MEMORY_SCOPE_AGENT);
#pragma unroll
        for (int ai = 0; ai < 2; ++ai)
#pragma unroll
            for (int m = 0; m < 4; ++m) {
                const int row = u.pm * BM + ai * HALF + wr * 64 + m * 16 + fr;
                const float rs = __builtin_amdgcn_rsqf(sq[ai][m] * (1.f / 1024.f) + K_EPS);
#pragma unroll
                for (int bj = 0; bj < 2; ++bj) {
                    const size_t off = (size_t)row * 1024 + colb + bj * HALF;
                    *(f32x4*)(out + off) = acc[ai][bj][m][0] * rs * fv[bj][0]; *(f32x4*)(out + off + 4) = acc[ai][bj][m][1] * rs * fv[bj][1];
                }
            }
    }
};

struct EpiFfn {
    static constexpr bool PERM = true, AFTER_DRAIN = false, STAGED = true; static constexpr int NSTORE = 8;
    bf16_t* act; const float* ssum; const float* shw;
    PG8_LAS unsigned char* stage;
    __device__ __forceinline__ void prefetch(const Unit& u, int ui, int wid, int lane) const {
        const float* src = wid < 4 ? ssum + u.pm * BM + 64 * wid + lane : shw + (size_t)(u.pm >> 3) * 5632 + u.pn * BM + 64 * (wid - 4) + lane;
        __builtin_amdgcn_global_load_lds((const unsigned*)src, (PG8_LAS unsigned*)(stage + (ui & 1) * 2048 + wid * 256), 4, 0, 0);
    }
    __device__ __forceinline__ void operator()(const f32x4 (&acc)[2][2][4][2], const Unit& u, int wr, int wc, int fr_in, int fq_in, int ui) const {
        int fr = fr_in, fq = fq_in; asm volatile("" : "+v"(fr), "+v"(fq));
        const int cl = wc * 32 + 8 * fq;
        const PG8_LAS float* SS = (const PG8_LAS float*)(stage + (ui & 1) * 2048); const PG8_LAS float* SV = SS + 256;
        f32x2 sg[4], sgn[4], su[4];
#pragma unroll
        for (int n = 0; n < 2; ++n) { const f32x4 a = *(const PG8_LAS f32x4*)(SV + cl + 4 * n), c = *(const PG8_LAS f32x4*)(SV + HALF + cl + 4 * n);
            sg[2 * n] = (f32x2){a[0], a[1]}; sg[2 * n + 1] = (f32x2){a[2], a[3]}; su[2 * n] = (f32x2){c[0], c[1]}; su[2 * n + 1] = (f32x2){c[2], c[3]}; }
#pragma unroll
        for (int q = 0; q < 4; ++q) sgn[q] = sg[q] * (-1.44269504089f);
#pragma unroll
        for (int ai = 0; ai < 2; ++ai)
#pragma unroll
            for (int m = 0; m < 4; ++m) {
                const int row = u.pm * BM + ai * HALF + wr * 64 + m * 16 + fr;
                const float rs = __builtin_amdgcn_rsqf(SS[ai * HALF + wr * 64 + m * 16 + fr] * (1.f / 1024.f) + K_EPS), nrs = rs * (-1.44269504089f);
                unsigned wv[4];
#pragma unroll
                for (int q = 0; q < 4; ++q) {
                    const f32x4 ag4 = acc[ai][0][m][q >> 1], au4 = acc[ai][1][m][q >> 1];
                    const f32x2 ag = (q & 1) ? (f32x2){ag4[2], ag4[3]} : (f32x2){ag4[0], ag4[1]}, au = (q & 1) ? (f32x2){au4[2], au4[3]} : (f32x2){au4[0], au4[1]};
                    const f32x2 g = ag * rs + sg[q], gn = ag * nrs + sgn[q], uu = au * rs + su[q];
                    f32x2 e; e.x = __builtin_amdgcn_exp2f(gn.x); e.y = __builtin_amdgcn_exp2f(gn.y);
                    const f32x2 d = e + 1.0f;
                    f32x2 r; r.x = __builtin_amdgcn_rcpf(d.x); r.y = __builtin_amdgcn_rcpf(d.y);
                    const f32x2 o = (g * uu) * r;
                    wv[q] = cvt_pk_bf16(o.x, o.y);
                }
                u32x4 w; w.x = wv[0]; w.y = wv[1]; w.z = wv[2]; w.w = wv[3];
                PG8_ST(u32x4, act + (size_t)row * 2816 + u.pn * HALF + cl, w);
            }
    }
};


template <class Epi, class Sched, bool ALIGN_EPI = false, bool SP2 = false>
__device__ __forceinline__ void gemm_phase(PG8_LAS unsigned char* lds, const Gemm g, const Sched& S, const Epi& E) {
    int tid_l = threadIdx.x; asm volatile("" : "+v"(tid_l));
    const int tid = tid_l, wid = __builtin_amdgcn_readfirstlane(tid >> 6), lane = tid & 63, wr = wid >> 2, wc = wid & 3, fr = lane & 15, fq = lane >> 4;
    const int K = g.K, nt = K / BK;
#define PG8_TW(t) (t)
    unsigned voffA[2], voffB[2];
#pragma unroll
    for (int i = 0; i < 2; ++i) { int R, C; stage_rc(tid * 16 + i * 8192, R, C); const int Rb = Epi::PERM ? ((R & ~31) + perm32(R & 31)) : R;
        voffA[i] = (unsigned)(R * K + C) * 2u; voffB[i] = (unsigned)(Rb * K + C) * 2u; }
    const size_t kstep = (size_t)(BK * 2);
    const size_t hstep = (size_t)HALF * K * 2;
    const size_t tstep = 2 * hstep;
    const unsigned ldsw = (unsigned)wid * 1024u;
    const int aoff = lds_byte(wr * 64 + fr, fq * 8), boff = lds_byte(wc * 32 + fr, fq * 8);
#define PG8_SA(b, h) (((b) * 2 + (h)) * HTB)
#define PG8_SB(b, h) ((4 + (b) * 2 + (h)) * HTB)
#define PG8_STAGE(bufoff, gbase, voff) do { _Pragma("unroll") for (int _i = 0; _i < 2; ++_i) \
        __builtin_amdgcn_global_load_lds((const unsigned*)((const char*)(gbase) + (voff)[_i]), (PG8_LAS unsigned*)(lds + (bufoff) + ldsw + _i * 8192), 16, 0, 0); } while (0)
#define PG8_LDA(dst, b, h) do { _Pragma("unroll") for (int m = 0; m < 4; ++m) _Pragma("unroll") for (int k = 0; k < 2; ++k) dst[m][k] = *(const PG8_LAS bf16x8*)(lds + PG8_SA(b, h) + aoff + m * 2048 + k * 1024); } while (0)
#define PG8_LDB(dst, b, h) do { _Pragma("unroll") for (int n = 0; n < 2; ++n) _Pragma("unroll") for (int k = 0; k < 2; ++k) dst[n][k] = *(const PG8_LAS bf16x8*)(lds + PG8_SB(b, h) + boff + n * 2048 + k * 1024); } while (0)
#define PG8_MMA(ai, bj, At, Bt) do { __builtin_amdgcn_s_setprio(1); _Pragma("unroll") for (int m = 0; m < 4; ++m) _Pragma("unroll") for (int n = 0; n < 2; ++n) _Pragma("unroll") for (int k = 0; k < 2; ++k) \
        acc[ai][bj][m][n] = __builtin_amdgcn_mfma_f32_16x16x32_bf16(Bt[n][k], At[m][k], acc[ai][bj][m][n], 0, 0, 0); __builtin_amdgcn_s_setprio(0); } while (0)
#define PG8_WAIT_V(n) asm volatile("s_waitcnt vmcnt(" #n ")" ::: "memory")
#define PG8_WAIT_L(n) asm volatile("s_waitcnt lgkmcnt(" #n ")" ::: "memory")
#define PG8_BAR __builtin_amdgcn_s_barrier()
#define PG8_SCHED __builtin_amdgcn_sched_barrier(0)
    Unit cur, nxt; int ui = 0;
    if (!S.next(0, cur)) return;
    f32x4 acc[2][2][4][2];
#pragma unroll
    for (int a = 0; a < 2; ++a)
#pragma unroll
        for (int b = 0; b < 2; ++b)
#pragma unroll
            for (int m = 0; m < 4; ++m)
#pragma unroll
                for (int n = 0; n < 2; ++n) acc[a][b][m][n] = (f32x4){0.f, 0.f, 0.f, 0.f};
    bf16x8 At[4][2], B0[2][2], B1[2][2];
    const char* cA = (const char*)g.A + (size_t)cur.pm * tstep; const char* cB = (const char*)g.Bt + (size_t)cur.pn * tstep;
    S.a_ready(cur);
    if constexpr (SP2) {
        PG8_STAGE(PG8_SB(0, 0), cB, voffB); PG8_STAGE(PG8_SB(0, 1), cB + hstep, voffB); PG8_STAGE(PG8_SA(0, 0), cA, voffA); PG8_STAGE(PG8_SA(0, 1), cA + hstep, voffA);
        if (wr == 1) PG8_BAR;
        PG8_WAIT_V(2); PG8_BAR;
        PG8_STAGE(PG8_SB(1, 0), cB + kstep, voffB); PG8_STAGE(PG8_SA(1, 0), cA + kstep, voffA); PG8_STAGE(PG8_SB(1, 1), cB + hstep + kstep, voffB);
        PG8_WAIT_V(6); PG8_BAR;
    } else {
        PG8_STAGE(PG8_SB(0, 0), cB, voffB); PG8_STAGE(PG8_SA(0, 0), cA, voffA); PG8_STAGE(PG8_SB(0, 1), cB + hstep, voffB); PG8_STAGE(PG8_SA(0, 1), cA + hstep, voffA);
        if (wr == 1) PG8_BAR;
        PG8_WAIT_V(4); PG8_BAR;
        PG8_STAGE(PG8_SB(1, 0), cB + kstep, voffB); PG8_STAGE(PG8_SA(1, 0), cA + kstep, voffA); PG8_STAGE(PG8_SB(1, 1), cB + hstep + kstep, voffB);
        PG8_WAIT_V(6); PG8_BAR;
    }
    for (;;) {
        const bool has_next = S.next(ui + 1, nxt);
        const char* nA = has_next ? (const char*)g.A + (size_t)nxt.pm * tstep : cA; const char* nB = has_next ? (const char*)g.Bt + (size_t)nxt.pn * tstep : cB;
        if constexpr (Epi::STAGED) E.prefetch(cur, ui, wid, lane);
        for (int t = 0; t < nt; t += 2) {
            const bool last = (t == nt - 2);
            const char* a1 = cA + (size_t)PG8_TW(t + 1) * kstep;
            const char* a2 = last ? nA : cA + (size_t)PG8_TW(t + 2) * kstep; const char* b2 = last ? nB : cB + (size_t)PG8_TW(t + 2) * kstep;
            const char* a3 = a2 + kstep; const char* b3 = b2 + kstep;
            if (last && has_next) S.a_ready(nxt);
            if constexpr (SP2) {
            PG8_LDB(B0, 0, 0); PG8_LDB(B1, 0, 1); PG8_SCHED; PG8_LDA(At, 0, 0); PG8_STAGE(PG8_SA(1, 1), a1 + hstep, voffA);
            PG8_WAIT_V(8); PG8_WAIT_L(0); PG8_BAR; PG8_MMA(0, 0, At, B0); PG8_MMA(0, 1, At, B1); PG8_BAR; PG8_SCHED;
            PG8_LDA(At, 0, 1); PG8_STAGE(PG8_SB(0, 0), b2, voffB); PG8_STAGE(PG8_SB(0, 1), b2 + hstep, voffB); PG8_STAGE(PG8_SA(0, 0), a2, voffA);
            PG8_WAIT_V(8); PG8_WAIT_L(0); PG8_BAR; PG8_MMA(1, 0, At, B0); PG8_MMA(1, 1, At, B1); PG8_BAR; PG8_SCHED;
            PG8_LDB(B0, 1, 0); PG8_LDB(B1, 1, 1); PG8_SCHED; PG8_LDA(At, 1, 0); PG8_STAGE(PG8_SA(0, 1), a2 + hstep, voffA);
            PG8_WAIT_V(8); PG8_WAIT_L(0); PG8_BAR; PG8_MMA(0, 0, At, B0); PG8_MMA(0, 1, At, B1); PG8_BAR; PG8_SCHED;
            PG8_LDA(At, 1, 1); PG8_STAGE(PG8_SB(1, 0), b3, voffB); PG8_STAGE(PG8_SB(1, 1), b3 + hstep, voffB); PG8_STAGE(PG8_SA(1, 0), a3, voffA);
            PG8_WAIT_V(8); PG8_WAIT_L(0); PG8_BAR; PG8_MMA(1, 0, At, B0); PG8_MMA(1, 1, At, B1); PG8_BAR; PG8_SCHED;
            } else {
            PG8_LDB(B0, 0, 0); PG8_SCHED; PG8_LDA(At, 0, 0); PG8_STAGE(PG8_SA(1, 1), a1 + hstep, voffA);
            PG8_WAIT_L(8); PG8_BAR; PG8_WAIT_L(0); PG8_MMA(0, 0, At, B0); PG8_BAR; PG8_SCHED;
            PG8_LDB(B1, 0, 1); PG8_STAGE(PG8_SB(0, 0), b2, voffB);
            PG8_BAR; PG8_WAIT_L(0); PG8_MMA(0, 1, At, B1); PG8_BAR;
            PG8_LDA(At, 0, 1); PG8_STAGE(PG8_SA(0, 0), a2, voffA);
            PG8_BAR; PG8_WAIT_L(0); PG8_MMA(1, 0, At, B0); PG8_BAR; PG8_SCHED;
            PG8_STAGE(PG8_SB(0, 1), b2 + hstep, voffB);
            PG8_WAIT_V(6); PG8_BAR; PG8_MMA(1, 1, At, B1); PG8_BAR;
            PG8_LDB(B0, 1, 0); PG8_SCHED; PG8_LDA(At, 1, 0); PG8_STAGE(PG8_SA(0, 1), a2 + hstep, voffA);
            PG8_WAIT_L(8); PG8_BAR; PG8_WAIT_L(0); PG8_MMA(0, 0, At, B0); PG8_BAR; PG8_SCHED;
            PG8_LDB(B1, 1, 1); PG8_STAGE(PG8_SB(1, 0), b3, voffB);
            PG8_BAR; PG8_WAIT_L(0); PG8_MMA(0, 1, At, B1); PG8_BAR;
            PG8_LDA(At, 1, 1); PG8_STAGE(PG8_SA(1, 0), a3, voffA);
            PG8_BAR; PG8_WAIT_L(0); PG8_MMA(1, 0, At, B0); PG8_BAR; PG8_SCHED;
            PG8_STAGE(PG8_SB(1, 1), b3 + hstep, voffB);
            PG8_WAIT_V(6); PG8_BAR; PG8_MMA(1, 1, At, B1); PG8_BAR;
            }
        }
        if constexpr (ALIGN_EPI) { if (wr == 0) PG8_BAR; }
        if constexpr (!Epi::AFTER_DRAIN) { if constexpr (Epi::STAGED) E(acc, cur, wr, wc, fr, fq, ui); else E(acc, cur, wr, wc, fr, fq); S.done(cur); }
        if (!has_next) break;
#pragma unroll
        for (int a = 0; a < 2; ++a)
#pragma unroll
            for (int b = 0; b < 2; ++b)
#pragma unroll
                for (int m = 0; m < 4; ++m)
#pragma unroll
                    for (int n = 0; n < 2; ++n) acc[a][b][m][n] = (f32x4){0.f, 0.f, 0.f, 0.f};
        cur = nxt; cA = nA; cB = nB; ++ui;
        if constexpr (ALIGN_EPI) { if (wr == 1) PG8_BAR; }
    }
    PG8_WAIT_V(0);
    if constexpr (!ALIGN_EPI) { if (wr == 0) PG8_BAR; }
    PG8_BAR;
    if constexpr (Epi::AFTER_DRAIN) { E.fused(acc, cur, wr, wc, fr, fq, lds, wid, lane); S.done(cur); }
#undef PG8_SA
#undef PG8_SB
#undef PG8_STAGE
#undef PG8_LDA
#undef PG8_LDB
#undef PG8_MMA
#undef PG8_WAIT_V
#undef PG8_WAIT_L
#undef PG8_BAR
#undef PG8_SCHED
}
}


constexpr int NWAVES = 8;
constexpr int D = 1024, BATCH = 8, SEQ = 2048, DEPTH = 2, M = BATCH * SEQ, INW = 3584, DFF = 2816, NMOD = 6, NCH = SEQ / 64;
constexpr float EPS = 1e-6f;
constexpr size_t MiB = 1u << 20, KiB = 1u << 10;
constexpr size_t WS_CTL = 0, CTL_ZERO_BYTES = 1 * MiB;
constexpr size_t WS_MOD = 64 * KiB;
constexpr size_t WS_SSUM = 448 * KiB;
constexpr size_t WS_TAB = 1 * MiB;
constexpr size_t WS_SHW1 = WS_TAB + 512 * KiB;
constexpr size_t WS_SHW2 = WS_SHW1 + 2 * 8 * 3584 * 4;
constexpr size_t WS_BL = 3 * MiB;
constexpr size_t WS_W = 4 * MiB;
constexpr size_t W_IN_OFF = 0, W_OUT_OFF = (size_t)INW * D * 2, W_GU_OFF = W_OUT_OFF + (size_t)D * D * 2, W_DN_OFF = W_GU_OFF + (size_t)2 * DFF * D * 2, W_LAYER = W_DN_OFF + (size_t)DFF * D * 2;
constexpr size_t WS_A = 56 * MiB;
constexpr size_t WS_PROJ = 88 * MiB;
constexpr size_t WS_URET = 200 * MiB;
constexpr size_t WS_UHG = 216 * MiB;
constexpr size_t WS_A2 = 200 * MiB;
constexpr size_t WS_END = 248 * MiB;
static_assert(WS_SHW2 + 2 * 8 * 5632 * 4 <= WS_BL && WS_W + 2 * W_LAYER <= WS_A && WS_A + (size_t)M * D * 2 <= WS_PROJ && WS_PROJ + (size_t)M * INW * 2 <= WS_URET, "d_ws map");
static_assert(WS_MOD + 2 * 8 * 6144 * 4 <= WS_SSUM && WS_SSUM + 5 * M * 4 <= CTL_ZERO_BYTES, "ctl map");
constexpr int CW_BAR = 4096;
constexpr int RING_BYTES = 131072;
constexpr int LDSCTL_OFF = RING_BYTES, MISC_OFF = LDSCTL_OFF + 320;
constexpr int STAGE_OFF = RING_BYTES + 4096;
constexpr int LDS_BYTES = 147456;

#define GAS __attribute__((address_space(1)))
#define LAS __attribute__((address_space(3)))
typedef unsigned short bf16;
typedef unsigned v4u __attribute__((ext_vector_type(4)));
typedef unsigned v2u __attribute__((ext_vector_type(2)));
typedef float f32x4 __attribute__((ext_vector_type(4)));
typedef short bf16x8 __attribute__((ext_vector_type(8)));
typedef GAS unsigned gu32;
#define RLX_AGENT __ATOMIC_RELAXED, __HIP_MEMORY_SCOPE_AGENT
#define LDS_WAIT() asm volatile("s_waitcnt lgkmcnt(0)" ::: "memory")
#define LD_LAST(p) (*(p))
#define LD_ONCE(p) __builtin_nontemporal_load(p)
typedef float f32x2_t __attribute__((ext_vector_type(2)));
typedef __bf16 bf16x2_t __attribute__((ext_vector_type(2)));
__device__ __forceinline__ unsigned pk2(float lo, float hi) { const f32x2_t v = {lo, hi}; const bf16x2_t b = __builtin_convertvector(v, bf16x2_t); return __builtin_bit_cast(unsigned, b); }
__device__ __forceinline__ unsigned f2bf(float f) { return (unsigned)__builtin_bit_cast(unsigned short, (__bf16)f); }
__device__ __forceinline__ float bf2f(unsigned short u) { return __builtin_bit_cast(float, (unsigned)u << 16); }
__device__ __forceinline__ float h2f(unsigned short u) { return (float)__builtin_bit_cast(_Float16, u); }
__device__ __forceinline__ float dpp_f(float v, int ctrl_sel) {
    const int x = __builtin_bit_cast(int, v);
    int r;
    if (ctrl_sel == 0) r = __builtin_amdgcn_mov_dpp(x, 0xB1, 0xF, 0xF, true);
    else if (ctrl_sel == 1) r = __builtin_amdgcn_mov_dpp(x, 0x4E, 0xF, 0xF, true);
    else if (ctrl_sel == 2) r = __builtin_amdgcn_mov_dpp(x, 0x141, 0xF, 0xF, true);
    else r = __builtin_amdgcn_mov_dpp(x, 0x140, 0xF, 0xF, true);
    return __builtin_bit_cast(float, r);
}
__device__ __forceinline__ float row16_sum(float v) { v += dpp_f(v, 0); v += dpp_f(v, 1); v += dpp_f(v, 2); v += dpp_f(v, 3); return v; }
__device__ __forceinline__ float wave_sum(float v) {
    v = row16_sum(v);
    const int x = __builtin_bit_cast(int, v);
    return __builtin_bit_cast(float, __builtin_amdgcn_readlane(x, 0)) + __builtin_bit_cast(float, __builtin_amdgcn_readlane(x, 16))
         + __builtin_bit_cast(float, __builtin_amdgcn_readlane(x, 32)) + __builtin_bit_cast(float, __builtin_amdgcn_readlane(x, 48));
}


__device__ __forceinline__ f32x4 mfma16(bf16x8 a, bf16x8 b, f32x4 c) { return __builtin_amdgcn_mfma_f32_16x16x32_bf16(a, b, c, 0, 0, 0); }

struct TrItem { const float* W; bf16* WT; int K, N, item, mode; };
__device__ __forceinline__ void transpose_load(f32x4 (&v)[8], const TrItem& t, int lane) {
    const int nblk = t.N / 32, kb = t.item / nblk, nb = t.item % nblk, k0 = 64 * kb, n0 = 32 * nb;
    const float* src = t.W + (size_t)(k0 + (lane >> 3)) * t.N + n0 + (lane & 7) * 4;
#pragma unroll
    for (int i = 0; i < 8; ++i) v[i] = LD_ONCE((const f32x4*)(src + (size_t)(8 * i) * t.N));
}
__device__ __forceinline__ void transpose_store(const f32x4 (&v)[8], const TrItem& t, LAS float* scr, int lane) {
    const int nblk = t.N / 32, kb = t.item / nblk, nb = t.item % nblk, k0 = 64 * kb, n0 = 32 * nb;
    const int drow = t.mode == 0 ? n0 : (256 * (n0 >> 7) + (n0 & 127) + (t.mode == 2 ? 128 : 0));
#pragma unroll
    for (int i = 0; i < 8; ++i) { LAS float* p = scr + (8 * i + (lane >> 3)) * 33 + (lane & 7) * 4; p[0] = v[i][0]; p[1] = v[i][1]; p[2] = v[i][2]; p[3] = v[i][3]; }
    LDS_WAIT(); asm volatile("" ::: "memory");
    const int c = lane & 7;
#pragma unroll
    for (int j = 0; j < 4; ++j) { const int n = (lane >> 3) + 8 * j; const LAS float* s = scr + (8 * c) * 33 + n;
        v4u o; o.x = pk2(s[0 * 33], s[1 * 33]); o.y = pk2(s[2 * 33], s[3 * 33]); o.z = pk2(s[4 * 33], s[5 * 33]); o.w = pk2(s[6 * 33], s[7 * 33]);
        *(GAS v4u*)(t.WT + (size_t)(drow + n) * t.K + k0 + 8 * c) = o; }
    LDS_WAIT(); asm volatile("" ::: "memory");
}

typedef short v4i16_t __attribute__((ext_vector_type(4)));
__device__ __forceinline__ unsigned off_b(unsigned row, unsigned ch) { return 256u * row + 16u * (ch ^ (((row & 3) << 2) | ((row >> 2) & 3))); }
__device__ __forceinline__ unsigned tr_addr16(unsigned lane, unsigned c, unsigned ks, unsigned t) {
    const unsigned g = lane >> 4, q = (lane & 15) >> 2, p = lane & 3;
    return off_b(32 * ks + 8 * g + 4 * t + q, 2 * c + (p >> 1)) + 8 * (p & 1);
}
__device__ __forceinline__ bf16x8 tr_frag(LAS unsigned char* img, unsigned lane, unsigned c, unsigned ks) {
    const v4i16_t a = __builtin_amdgcn_ds_read_tr16_b64_v4i16((LAS v4i16_t*)(img + tr_addr16(lane, c, ks, 0)));
    const v4i16_t b = __builtin_amdgcn_ds_read_tr16_b64_v4i16((LAS v4i16_t*)(img + tr_addr16(lane, c, ks, 1)));
    return (bf16x8){a[0], a[1], a[2], a[3], b[0], b[1], b[2], b[3]};
}

template <int DK> struct StRegs { v4u k[DK / 64]; v4u v[2]; };
template <int DK, bool RET>
__device__ __forceinline__ void mix_state_load(StRegs<DK>& R, const bf16* proj, int it, int tid) {
    const int b = it >> 7, h = (it >> 5) & 3, c = it & 31;
    const size_t r0 = (size_t)b * 2048 + c * 64;
#pragma unroll
    for (int k = 0; k < 2; ++k) { const bf16* base = proj + (r0 + (tid >> 4) + 32 * k) * 3584 + (tid & 15) * 8 + h * 128;
        R.v[k] = *(const v4u*)(base + (RET ? 512 : 2560));
        if (!RET) R.k[k] = *(const v4u*)(base + 2048); }
    if (RET) R.k[0] = *(const v4u*)(proj + (r0 + (tid >> 3)) * 3584 + 256 + h * 64 + (tid & 7) * 8);
}
template <int DK, bool RET>
__device__ __forceinline__ void mix_state_item(LAS unsigned char* lds, const StRegs<DK>& R, bf16* ST, float* BL, int it, int tid) {
    constexpr int NSEG = 512 / DK, TS = 64 / NSEG;
    const int lane = tid & 63, wave = tid >> 6, d = tid % DK, seg = tid / DK, fr = lane & 15, fq = lane >> 4;
    const int h = (it >> 5) & 3;
    LAS unsigned char* VI = lds; LAS unsigned char* RAW = lds + 16384; LAS unsigned char* KI = lds + 32768; LAS float* TOT = (LAS float*)(lds + 49152);
#pragma unroll
    for (int k = 0; k < 2; ++k) { *(LAS v4u*)(VI + off_b((tid >> 4) + 32 * k, tid & 15)) = R.v[k];
        if (!RET) *(LAS v4u*)(RAW + ((tid >> 4) + 32 * k) * 256 + (tid & 15) * 16) = R.k[k]; }
    if (RET) *(LAS v4u*)(RAW + (tid >> 3) * 128 + (tid & 7) * 16) = R.k[0];
    __syncthreads();
    float kp[TS];
    if (RET) {
        const float lg2 = __log2f(1.f - exp2f(-5.f - (float)h)), gam = 1.f - exp2f(-5.f - (float)h);
        float f = __builtin_amdgcn_exp2f((float)(63 - seg * TS - (TS - 1)) * lg2);
#pragma unroll
        for (int i = TS - 1; i >= 0; --i) { const int t = seg * TS + i; kp[i] = bf2f(*(const LAS unsigned short*)(RAW + t * 128 + d * 2)) * f; f *= gam; }
    } else {
        float g[TS], bs[TS]; float run = 0.f;
#pragma unroll
        for (int i = 0; i < TS; ++i) { g[i] = h2f(*(const LAS unsigned short*)(RAW + (seg * TS + i) * 256 + d * 2)) * 1.44269504089f; run += g[i]; bs[i] = run; }
        TOT[seg * DK + d] = run;
        __syncthreads();
        float pre = 0.f, bl = 0.f;
#pragma unroll
        for (int s2 = 0; s2 < NSEG; ++s2) { const float t = TOT[s2 * DK + d]; bl += t; if (s2 < seg) pre += t; }
#pragma unroll
        for (int i = 0; i < TS; ++i) { const float bb = pre + bs[i]; kp[i] = (1.f - __builtin_amdgcn_exp2f(g[i])) * __builtin_amdgcn_exp2f(bl - bb); }
        if (seg == 0) BL[(size_t)it * 128 + d] = bl;
    }
#pragma unroll
    for (int i = 0; i < TS; i += 2) { const unsigned w = pk2(kp[i], kp[i + 1]);
        *(LAS unsigned short*)(KI + off_b(seg * TS + i, d >> 3) + (d & 7) * 2) = (unsigned short)w; *(LAS unsigned short*)(KI + off_b(seg * TS + i + 1, d >> 3) + (d & 7) * 2) = (unsigned short)(w >> 16); }
    __syncthreads();
    {
        bf16x8 bfr[2];
#pragma unroll
        for (int ks = 0; ks < 2; ++ks) bfr[ks] = tr_frag(VI, lane, wave, ks);
        bf16* dst = ST + (size_t)it * (128 * DK) + (size_t)(16 * wave + fr) * DK + 4 * fq;
#pragma unroll
        for (int dt = 0; dt < DK / 16; ++dt) {
            f32x4 acc = (f32x4){0.f, 0.f, 0.f, 0.f};
#pragma unroll
            for (int ks = 0; ks < 2; ++ks) acc = mfma16(tr_frag(KI, lane, dt, ks), bfr[ks], acc);
            v2u w; w.x = pk2(acc[0], acc[1]); w.y = pk2(acc[2], acc[3]);
            *(v2u*)(dst + 16 * dt) = w;
        }
    }
    __syncthreads();
}

template <int DK> struct OutRegs { v4u q[DK / 64]; v4u g[DK / 64]; v4u v[2]; v4u gate[2]; bf16x8 s[DK / 32]; float nwv; };
template <int DK, bool RET>
__device__ __forceinline__ void mix_out_load(OutRegs<DK>& R, const bf16* proj, const bf16* ST, const float* nw, int it, int tid) {
    const int lane = tid & 63, wave = tid >> 6, fr = lane & 15, fq = lane >> 4;
    const int b = it >> 7, h = (it >> 5) & 3, c = it & 31;
    const size_t r0 = (size_t)b * 2048 + c * 64;
#pragma unroll
    for (int k = 0; k < 2; ++k) { const bf16* base = proj + (r0 + (tid >> 4) + 32 * k) * 3584 + (tid & 15) * 8 + h * 128;
        R.v[k] = LD_LAST((const v4u*)(base + (RET ? 512 : 2560))); R.gate[k] = LD_LAST((const v4u*)(base + (RET ? 1024 : 3072)));
        if (!RET) { R.q[k] = LD_LAST((const v4u*)(base + 1536)); R.g[k] = LD_LAST((const v4u*)(base + 2048)); } }
    if (RET) { const bf16* base = proj + (r0 + (tid >> 3)) * 3584 + h * 64 + (tid & 7) * 8; R.q[0] = LD_LAST((const v4u*)base); R.g[0] = LD_LAST((const v4u*)(base + 256)); }
#pragma unroll
    for (int kd = 0; kd < DK / 32; ++kd) R.s[kd] = *(const bf16x8*)(ST + (size_t)it * (128 * DK) + (size_t)(16 * wave + fr) * DK + 32 * kd + 8 * fq);
    R.nwv = nw[h * 128 + 16 * wave + fr];
}
template <int DK, bool RET>
__device__ __forceinline__ void mix_out_park(LAS unsigned char* lds, const OutRegs<DK>& R, int tid) {
    LAS unsigned char* VI = lds; LAS unsigned char* RAWQ = lds + 16384; LAS unsigned char* RAWG = lds + 32768; LAS float* RED = (LAS float*)(lds + 128000);
#pragma unroll
    for (int k = 0; k < 2; ++k) { *(LAS v4u*)(VI + off_b((tid >> 4) + 32 * k, tid & 15)) = R.v[k];
        if (!RET) { *(LAS v4u*)(RAWQ + ((tid >> 4) + 32 * k) * 256 + (tid & 15) * 16) = R.q[k]; *(LAS v4u*)(RAWG + ((tid >> 4) + 32 * k) * 256 + (tid & 15) * 16) = R.g[k]; } }
    if (RET) { *(LAS v4u*)(RAWQ + (tid >> 3) * 128 + (tid & 7) * 16) = R.q[0]; *(LAS v4u*)(RAWG + (tid >> 3) * 128 + (tid & 7) * 16) = R.g[0]; }
    if (tid < 64) RED[tid] = 0.f;
    __syncthreads();
}
template <int DK, bool RET>
__device__ __forceinline__ void mix_out_item(LAS unsigned char* lds, const v4u (&gate)[2], const bf16x8 (&sfr)[DK / 32], float nwv, bf16* O, int it, int tid) {
    constexpr int NSEG = 512 / DK, TS = 64 / NSEG, PITCH = DK * 2 + 16, KD = DK / 32, RP = DK * 2;
    const int lane = tid & 63, wave = tid >> 6, d = tid % DK, seg = tid / DK, fr = lane & 15, fq = lane >> 4;
    const int b = it >> 7, h = (it >> 5) & 3, c = it & 31;
    const size_t r0 = (size_t)b * 2048 + c * 64;
    LAS unsigned char* VI = lds; LAS unsigned char* RAWQ = lds + 16384; LAS unsigned char* RAWG = lds + 32768;
    LAS unsigned char* QA = lds + 49152; LAS unsigned char* KC = lds + 66560; LAS unsigned char* QB = lds + 83968; LAS unsigned char* P = lds + 101376;
    LAS float* TOT = (LAS float*)(lds + 101376);
    LAS unsigned char* OT = lds + 110592; LAS float* RED = (LAS float*)(lds + 128000);
    float qa[TS], kc[TS], qb[TS];
    if (RET) {
        const float lg2 = __log2f(1.f - exp2f(-5.f - (float)h)), gam = 1.f - exp2f(-5.f - (float)h), eref = __builtin_amdgcn_exp2f(32.f * lg2);
        const int tb = seg * TS;
        float fa = __builtin_amdgcn_exp2f((float)(tb - 31) * lg2), fk = __builtin_amdgcn_exp2f((float)(31 - tb - (TS - 1)) * lg2);
#pragma unroll
        for (int i = 0; i < TS; ++i) { const float q = bf2f(*(const LAS unsigned short*)(RAWQ + (tb + i) * RP + d * 2)); qa[i] = q * fa; qb[i] = qa[i] * eref; fa *= gam; }
#pragma unroll
        for (int i = TS - 1; i >= 0; --i) { kc[i] = bf2f(*(const LAS unsigned short*)(RAWG + (tb + i) * RP + d * 2)) * fk; fk *= gam; }
    } else {
        float g[TS], bs[TS], q[TS]; float run = 0.f;
#pragma unroll
        for (int i = 0; i < TS; ++i) { const int t = seg * TS + i; q[i] = bf2f(*(const LAS unsigned short*)(RAWQ + t * RP + d * 2)); g[i] = h2f(*(const LAS unsigned short*)(RAWG + t * RP + d * 2)) * 1.44269504089f; run += g[i]; bs[i] = run; }
        TOT[seg * DK + d] = run;
        __syncthreads();
        float pre = 0.f, ref = 0.f;
#pragma unroll
        for (int s2 = 0; s2 < NSEG; ++s2) { const float t = TOT[s2 * DK + d]; if (s2 < NSEG / 2) ref += t; if (s2 < seg) pre += t; }
        const float eref = __builtin_amdgcn_exp2f(ref);
#pragma unroll
        for (int i = 0; i < TS; ++i) { const float e1 = __builtin_amdgcn_fmed3f(pre + bs[i] - ref, -115.f, 115.f);
            qa[i] = q[i] * __builtin_amdgcn_exp2f(e1); kc[i] = (1.f - __builtin_amdgcn_exp2f(g[i])) * __builtin_amdgcn_exp2f(-e1); qb[i] = qa[i] * eref; }
    }
#pragma unroll
    for (int i = 0; i < TS; i += 2) { const int t = seg * TS + i; const unsigned wa = pk2(qa[i], qa[i + 1]), wk = pk2(kc[i], kc[i + 1]), wb = pk2(qb[i], qb[i + 1]);
        *(LAS unsigned short*)(QA + t * PITCH + d * 2) = (unsigned short)wa; *(LAS unsigned short*)(QA + (t + 1) * PITCH + d * 2) = (unsigned short)(wa >> 16);
        *(LAS unsigned short*)(KC + t * PITCH + d * 2) = (unsigned short)wk; *(LAS unsigned short*)(KC + (t + 1) * PITCH + d * 2) = (unsigned short)(wk >> 16);
        *(LAS unsigned short*)(QB + t * PITCH + d * 2) = (unsigned short)wb; *(LAS unsigned short*)(QB + (t + 1) * PITCH + d * 2) = (unsigned short)(wb >> 16); }
    __syncthreads();
    {
        const int tt = wave & 3, sp = wave >> 2;
#pragma unroll
        for (int hh = 0; hh < 2; ++hh) {
            const int st = 2 * sp + hh;
            f32x4 acc = (f32x4){0.f, 0.f, 0.f, 0.f};
#pragma unroll
            for (int kd = 0; kd < KD; ++kd) { const bf16x8 a = *(const LAS bf16x8*)(KC + (16 * st + fr) * PITCH + (32 * kd + 8 * fq) * 2), bq = *(const LAS bf16x8*)(QA + (16 * tt + fr) * PITCH + (32 * kd + 8 * fq) * 2);
                acc = mfma16(a, bq, acc); }
            const int t = 16 * tt + fr, s0 = 16 * st + 4 * fq;
            const float p0 = (s0 + 0 <= t) ? acc[0] : 0.f, p1 = (s0 + 1 <= t) ? acc[1] : 0.f, p2 = (s0 + 2 <= t) ? acc[2] : 0.f, p3 = (s0 + 3 <= t) ? acc[3] : 0.f;
            v2u w; w.x = pk2(p0, p1); w.y = pk2(p2, p3);
            *(LAS v2u*)(P + t * 144 + s0 * 2) = w;
        }
    }
    __syncthreads();
    f32x4 o[4];
    {
        f32x4 accX[4];
#pragma unroll
        for (int tt = 0; tt < 4; ++tt) { o[tt] = (f32x4){0.f, 0.f, 0.f, 0.f}; accX[tt] = (f32x4){0.f, 0.f, 0.f, 0.f}; }
#pragma unroll
        for (int ks = 0; ks < 2; ++ks) { const bf16x8 bv = tr_frag(VI, lane, wave, ks);
#pragma unroll
            for (int tt = 0; tt < 4; ++tt) { const bf16x8 a = *(const LAS bf16x8*)(P + (16 * tt + fr) * 144 + (32 * ks + 8 * fq) * 2); o[tt] = mfma16(a, bv, o[tt]); } }
#pragma unroll
        for (int kd = 0; kd < KD; ++kd)
#pragma unroll
            for (int tt = 0; tt < 4; ++tt) { const bf16x8 a = *(const LAS bf16x8*)(QB + (16 * tt + fr) * PITCH + (32 * kd + 8 * fq) * 2); accX[tt] = mfma16(a, sfr[kd], accX[tt]); }
#pragma unroll
        for (int tt = 0; tt < 4; ++tt) o[tt] = o[tt] + accX[tt];
    }
#pragma unroll
    for (int tt = 0; tt < 4; ++tt)
#pragma unroll
        for (int r = 0; r < 4; ++r) { float s = row16_sum(o[tt][r] * o[tt][r]);
            if (fr == 0) __hip_atomic_fetch_add(RED + 16 * tt + 4 * fq + r, s, __ATOMIC_RELAXED, __HIP_MEMORY_SCOPE_WORKGROUP); }
    __syncthreads();
#pragma unroll
    for (int tt = 0; tt < 4; ++tt)
#pragma unroll
        for (int r = 0; r < 4; r += 2) { const int t = 16 * tt + 4 * fq + r; const float rs0 = __builtin_amdgcn_rsqf(RED[t] * (1.f / 128.f) + EPS), rs1 = __builtin_amdgcn_rsqf(RED[t + 1] * (1.f / 128.f) + EPS);
            const unsigned w = pk2(o[tt][r] * rs0 * nwv, o[tt][r + 1] * rs1 * nwv);
            *(LAS unsigned short*)(OT + t * 272 + (16 * wave + fr) * 2) = (unsigned short)w; *(LAS unsigned short*)(OT + (t + 1) * 272 + (16 * wave + fr) * 2) = (unsigned short)(w >> 16); }
    __syncthreads();
    {
        const int ocol = (RET ? 0 : 512) + h * 128;
#pragma unroll
        for (int k = 0; k < 2; ++k) { const int row = (tid >> 4) + 32 * k, ch = tid & 15;
            const v4u ov = *(const LAS v4u*)(OT + row * 272 + ch * 16); const v4u gv = gate[k];
            const unsigned oo[4] = {ov.x, ov.y, ov.z, ov.w}, gg[4] = {gv.x, gv.y, gv.z, gv.w}; unsigned w[4];
#pragma unroll
            for (int e = 0; e < 4; ++e) w[e] = pk2(__builtin_bit_cast(float, oo[e] << 16) * __builtin_bit_cast(float, gg[e] << 16), __builtin_bit_cast(float, oo[e] & 0xffff0000u) * __builtin_bit_cast(float, gg[e] & 0xffff0000u));
            v4u wv; wv.x = w[0]; wv.y = w[1]; wv.z = w[2]; wv.w = w[3];
            *(v4u*)(O + (r0 + row) * 1024 + ocol + ch * 8) = wv; }
    }
}

template <int DK, bool RET>
__device__ __forceinline__ void mix_state_loop(LAS unsigned char* lds, const bf16* proj, bf16* ST, float* BL, int first, int step, int end, int tid_in) {
    int tid = tid_in; asm volatile("" : "+v"(tid));
    if (first >= end) return;
    StRegs<DK> cur; mix_state_load<DK, RET>(cur, proj, first, tid);
    for (int it = first; it < end; it += step) {
        StRegs<DK> nxt = cur;
        const bool more = it + step < end;
        if (more) mix_state_load<DK, RET>(nxt, proj, it + step, tid);
        mix_state_item<DK, RET>(lds, cur, ST, BL, it, tid);
        cur = nxt;
    }
}
template <int DK, bool RET>
__device__ __forceinline__ void mix_out_loop(LAS unsigned char* lds, const bf16* proj, const bf16* ST, const float* nw, bf16* O, int first, int step, int tid_in) {
    int tid = tid_in; asm volatile("" : "+v"(tid));
    if (first >= 1024) return;
    OutRegs<DK> cur; mix_out_load<DK, RET>(cur, proj, ST, nw, first, tid);
    for (int it = first; it < 1024; it += step) {
        mix_out_park<DK, RET>(lds, cur, tid);
        const v4u gate[2] = {cur.gate[0], cur.gate[1]}; bf16x8 sfr[DK / 32]; const float nwv = cur.nwv;
#pragma unroll
        for (int kd = 0; kd < DK / 32; ++kd) sfr[kd] = cur.s[kd];
        if (it + step < 1024) mix_out_load<DK, RET>(cur, proj, ST, nw, it + step, tid);
        mix_out_item<DK, RET>(lds, gate, sfr, nwv, O, it, tid);
    }
}


#ifndef GEMM_SP2
#define GEMM_SP2 true
#endif
#ifndef GEMM_ALIGN
#define GEMM_ALIGN true
#endif
constexpr int I_IN = 16 * 112, I_OUT = 16 * 32, I_G = 16 * 88, I_DN = 44 * 32, I_LAYER = I_IN + I_OUT + 2 * I_G + I_DN;
#define TR_DECODE(T, IT) do { const int l_ = (IT) / I_LAYER; int r_ = (IT) % I_LAYER; bf16* Wl_ = (bf16*)(ws + WS_W + (size_t)l_ * W_LAYER); \
    if (r_ < I_IN) { T.W = w_in + (size_t)l_ * D * INW; T.WT = Wl_ + W_IN_OFF / 2; T.K = D; T.N = INW; T.item = r_; T.mode = 0; } \
    else if (r_ < I_IN + I_OUT) { T.W = w_out + (size_t)l_ * D * D; T.WT = Wl_ + W_OUT_OFF / 2; T.K = D; T.N = D; T.item = r_ - I_IN; T.mode = 0; } \
    else if (r_ < I_IN + I_OUT + I_G) { T.W = w_gate + (size_t)l_ * D * DFF; T.WT = Wl_ + W_GU_OFF / 2; T.K = D; T.N = DFF; T.item = r_ - I_IN - I_OUT; T.mode = 1; } \
    else if (r_ < I_IN + I_OUT + 2 * I_G) { T.W = w_up + (size_t)l_ * D * DFF; T.WT = Wl_ + W_GU_OFF / 2; T.K = D; T.N = DFF; T.item = r_ - I_IN - I_OUT - I_G; T.mode = 2; } \
    else { T.W = w_down + (size_t)l_ * DFF * D; T.WT = Wl_ + W_DN_OFF / 2; T.K = DFF; T.N = D; T.item = r_ - I_IN - I_OUT - 2 * I_G; T.mode = 0; } } while (0)
#define TRANSPOSE_RANGE(IT0, IT1, WIDX, NW) do { LAS float* scr_ = (LAS float*)(lds + wave * 16384); int it_ = (IT0) + (WIDX); \
    if (it_ < (IT1)) { TrItem cur_; TR_DECODE(cur_, it_); f32x4 v_[8]; transpose_load(v_, cur_, lane); \
        for (;;) { const int nx_ = it_ + (NW); const bool more_ = nx_ < (IT1); TrItem nt_ = cur_; f32x4 vn_[8]; \
            if (more_) { TR_DECODE(nt_, nx_); transpose_load(vn_, nt_, lane); } \
            transpose_store(v_, cur_, scr_, lane); \
            if (!more_) break; \
            cur_ = nt_; it_ = nx_; \
            _Pragma("unroll") for (int i_ = 0; i_ < 8; ++i_) v_[i_] = vn_[i_]; } } } while (0)
#define TRANSPOSE_RANGE_SIMPLE(IT0, IT1, WIDX, NW) do { LAS float* scr_ = (LAS float*)(lds + wave * 16384); \
    for (int it_ = (IT0) + (WIDX); it_ < (IT1); it_ += (NW)) { TrItem cur_; TR_DECODE(cur_, it_); f32x4 v_[8]; transpose_load(v_, cur_, lane); transpose_store(v_, cur_, scr_, lane); } } while (0)
#define SHW_MFMA_ALL() do { __syncthreads(); \
    for (int i_ = tid; i_ < 4 * BATCH * 128; i_ += NWAVES * 64) { const int grp_ = i_ >> 10, b_ = (i_ >> 7) & 7, ch_ = i_ & 127; \
        const float* src_ = MOD + ((size_t)(grp_ >> 1) * BATCH + b_) * (NMOD * D) + ((grp_ & 1) ? 3 * D : 0) + ch_ * 8; \
        const f32x4 a_ = *(const f32x4*)src_, c_ = *(const f32x4*)(src_ + 4); \
        v4u hi_, lo_; hi_.x = pk2(a_[0], a_[1]); hi_.y = pk2(a_[2], a_[3]); hi_.z = pk2(c_[0], c_[1]); hi_.w = pk2(c_[2], c_[3]); \
        lo_.x = pk2(a_[0] - __builtin_bit_cast(float, hi_.x << 16), a_[1] - __builtin_bit_cast(float, hi_.x & 0xffff0000u)); lo_.y = pk2(a_[2] - __builtin_bit_cast(float, hi_.y << 16), a_[3] - __builtin_bit_cast(float, hi_.y & 0xffff0000u)); \
        lo_.z = pk2(c_[0] - __builtin_bit_cast(float, hi_.z << 16), c_[1] - __builtin_bit_cast(float, hi_.z & 0xffff0000u)); lo_.w = pk2(c_[2] - __builtin_bit_cast(float, hi_.w << 16), c_[3] - __builtin_bit_cast(float, hi_.w & 0xffff0000u)); \
        *(LAS v4u*)(lds + grp_ * 32768 + b_ * 2048 + ((ch_ ^ b_) << 4)) = hi_; *(LAS v4u*)(lds + grp_ * 32768 + (8 + b_) * 2048 + ((ch_ ^ (8 + b_)) << 4)) = lo_; } \
    __syncthreads(); \
    for (int it_ = wave * G + vcu; it_ < DEPTH * 9216 / 16; it_ += NWAVES * G) { \
        const int r0_ = it_ * 16, l_ = r0_ / 9216, rr_ = r0_ % 9216, type_ = rr_ >= INW ? 1 : 0, np0_ = type_ ? rr_ - INW : rr_, fr_ = lane & 15, fq_ = lane >> 4; \
        const bf16* wrow_ = (const bf16*)(ws + WS_W + (size_t)l_ * W_LAYER + (type_ ? W_GU_OFF : W_IN_OFF)) + (size_t)(np0_ + fr_) * D + 8 * fq_; \
        LAS unsigned char* ab_ = lds + (l_ * 2 + type_) * 32768 + fr_ * 2048; \
        f32x4 c_ = {0.f, 0.f, 0.f, 0.f}; \
        { bf16x8 bw_[32];                                     \
            _Pragma("unroll") for (int j_ = 0; j_ < 32; ++j_) bw_[j_] = *(const bf16x8*)(wrow_ + j_ * 32); \
            _Pragma("unroll") for (int j_ = 0; j_ < 32; ++j_) { const int ch_ = 4 * j_ + fq_; c_ = mfma16(*(const LAS bf16x8*)(ab_ + ((ch_ ^ fr_) << 4)), bw_[j_], c_); } } \
        _Pragma("unroll") for (int r_ = 0; r_ < 4; ++r_) { const float t_ = c_[r_] + __shfl_xor(c_[r_], 32); \
            if (lane < 32) { const int bt_ = 4 * fq_ + r_; if (type_) SHW2[((size_t)l_ * BATCH + bt_) * 5632 + np0_ + fr_] = t_; else SHW1[((size_t)l_ * BATCH + bt_) * INW + np0_ + fr_] = t_; } } } } while (0)
#ifndef A0_ROWS
#define A0_ROWS 8
#endif
struct Args { const float* in[15]; float* out; unsigned char* ws; };
__global__ void __launch_bounds__(NWAVES * 64, 2) fwd_kernel(Args args) {
    extern __shared__ __attribute__((aligned(16))) unsigned char lds_raw[];
    LAS unsigned char* lds = (LAS unsigned char*)lds_raw;
    volatile LAS unsigned* MISC = (volatile LAS unsigned*)(lds + MISC_OFF);
    const int tid = threadIdx.x, lane = tid & 63, wave = __builtin_amdgcn_readfirstlane(tid >> 6);
    const int G = gridDim.x, bx = blockIdx.x;
    const int vcu = (G % 8 == 0) ? (bx % 8) * (G / 8) + bx / 8 : bx;
    const int gw = vcu * NWAVES + wave, NGW = G * NWAVES;
    unsigned char* ws = args.ws;
    const float* x = args.in[0]; const float* cvec = args.in[1]; const float* w_ada = args.in[2]; const float* b_ada = args.in[3];
    const float* norm_mix_w = args.in[4]; const float* w_in = args.in[5]; const float* ret_norm_w = args.in[6]; const float* hg_lb = args.in[7];
    const float* hg_norm_w = args.in[8]; const float* w_out = args.in[9]; const float* norm_ffn_w = args.in[10]; const float* w_gate = args.in[11];
    const float* w_up = args.in[12]; const float* w_down = args.in[13]; const float* final_w = args.in[14];
    float* out = args.out; bf16* X16 = (bf16*)args.out;
    gu32* ctl = (gu32*)(ws + WS_CTL);
    float* MOD = (float*)(ws + WS_MOD); float* SSUM = (float*)(ws + WS_SSUM); float2* TAB = (float2*)(ws + WS_TAB);
    float* SHW1 = (float*)(ws + WS_SHW1); float* SHW2 = (float*)(ws + WS_SHW2); float* BL = (float*)(ws + WS_BL);
    bf16* ABUF = (bf16*)(ws + WS_A); bf16* PROJ = (bf16*)(ws + WS_PROJ); bf16* URET = (bf16*)(ws + WS_URET); bf16* UHG = (bf16*)(ws + WS_UHG); bf16* A2 = (bf16*)(ws + WS_A2);

    for (int u = tid; u < (LDS_BYTES - LDSCTL_OFF) / 4; u += NWAVES * 64) ((LAS unsigned*)(lds + LDSCTL_OFF))[u] = 0u;
    __syncthreads();
    XcdBarrier bar = xcd_barrier_post((unsigned*)(ctl + CW_BAR), MISC + 8);
#define GRID_BAR() xcd_barrier(bar)

    {
        LAS float* cs = (LAS float*)lds;
        for (int i = tid; i < BATCH * D; i += NWAVES * 64) cs[i] = pg8::silu_f(cvec[i]);
        __syncthreads();
        const int rep_ = 1;
        for (int uidx = vcu; uidx < 240; uidx += G) {
            const int l = uidx / 120, r = uidx % 120, cg = r / 10, ks = r % 10, k0 = (ks * 1024) / 10, k1 = ((ks + 1) * 1024) / 10, n = cg * 512 + tid;
            float acc[BATCH];
#pragma unroll
            for (int b = 0; b < BATCH; ++b) acc[b] = 0.f;
            const float* w = w_ada + (size_t)l * D * (NMOD * D) + n;
#pragma unroll 17
            for (int k = k0; k < k1; ++k) { const float wv = LD_ONCE(w + (size_t)k * (NMOD * D));
#pragma unroll
                for (int b = 0; b < BATCH; ++b) acc[b] += cs[b * D + k] * wv; }
            const float bb = ks == 0 ? b_ada[l * NMOD * D + n] : 0.f;
#pragma unroll
            for (int b = 0; b < BATCH; ++b) atomicAdd((rep_ == 1 ? MOD : (float*)(ws + WS_URET)) + ((size_t)l * BATCH + b) * (NMOD * D) + n, acc[b] + bb);
        }
        __syncthreads();
        TRANSPOSE_RANGE(0, DEPTH * I_LAYER, gw, NGW);
        for (int idx = vcu * (NWAVES * 64) + tid; idx < SEQ * 32; idx += G * NWAVES * 64) {
            const int pos = idx >> 5, i = idx & 31;
            const float lin = (float)i / 31.0f;
            const float inv = (float)exp(-(double)lin * 9.210340371976184);
            const float theta = (float)pos * inv;
            const double rev = (double)theta * 0.15915494309189535;
            const double ang = (rev - rint(rev)) * 6.283185307179586;
            TAB[idx] = make_float2((float)cos(ang), (float)sin(ang));
        }
    }
    GRID_BAR();
    {
        for (int rg = gw; rg < M / A0_ROWS; rg += NGW) {
            const int row0 = rg * A0_ROWS, b = row0 >> 11;
            f32x4 v[A0_ROWS][4];
#pragma unroll
            for (int r = 0; r < A0_ROWS; ++r)
#pragma unroll
                for (int j = 0; j < 4; ++j) v[r][j] = LD_ONCE((const f32x4*)(x + (size_t)(row0 + r) * D) + lane + 64 * j);
            f32x4 wm[4];
#pragma unroll
            for (int j = 0; j < 4; ++j) { const int col = (lane + 64 * j) * 4; wm[j] = (*(const f32x4*)(norm_mix_w + col)) * (1.f + *(const f32x4*)(MOD + (size_t)b * (NMOD * D) + D + col)); }
#pragma unroll
            for (int r = 0; r < A0_ROWS; ++r) {
                float s = 0.f;
#pragma unroll
                for (int j = 0; j < 4; ++j) s += (v[r][j][0] * v[r][j][0] + v[r][j][1] * v[r][j][1]) + (v[r][j][2] * v[r][j][2] + v[r][j][3] * v[r][j][3]);
                s = wave_sum(s);
                if (lane == 0) SSUM[row0 + r] = s;
                v2u* o8 = (v2u*)(ABUF + (size_t)(row0 + r) * D) + lane;
#pragma unroll
                for (int j = 0; j < 4; ++j) { const f32x4 a = v[r][j] * wm[j]; v2u w; w.x = pk2(a[0], a[1]); w.y = pk2(a[2], a[3]); o8[64 * j] = w; }
            }
        }
        SHW_MFMA_ALL();
    }
    GRID_BAR();
    for (int l = 0; l < DEPTH; ++l) {
        const bf16* Wl = (const bf16*)(ws + WS_W + (size_t)l * W_LAYER);
        const float* modl = MOD + (size_t)l * BATCH * (NMOD * D);
        {
            const int nM = M / 256;
            const bool split = (nM * 12) % G == 0 && nM * 4 == G;
            for (int part = 0; part < 2; ++part) {
                const int t0 = part == 0 ? 0 : (split ? 12 : 14), ntl = part == 0 ? (split ? 12 : 14) : (split ? 2 : 0);
                pg8::Gemm g{ABUF, Wl + W_IN_OFF / 2 + (size_t)t0 * 256 * D, M, ntl * 256, D}; pg8::StaticOrder S; S.init(M, ntl * 256, G, bx);
                pg8::EpiWin E{PROJ, SSUM + (size_t)(2 * l) * M, SHW1 + (size_t)l * BATCH * INW, TAB, hg_lb, l, lds + STAGE_OFF, t0};
                pg8::gemm_phase<pg8::EpiWin, pg8::StaticOrder, GEMM_ALIGN, GEMM_SP2>(lds, g, S, E);
                if (part == 0) GRID_BAR();
            }
            int first = bx, step = G;
            if (split) { const int nb = nM * 2; if (bx < nb) { first = bx; step = 1024; } else { first = bx; step = G - nb; } }
            mix_state_loop<128, false>(lds, PROJ, UHG, BL, first, step, 1024, tid);
            mix_state_loop<64, true>(lds, PROJ, URET, BL, first, step, 1024, tid);
        }
        GRID_BAR();
        {
            int tid3 = threadIdx.x; asm volatile("" : "+v"(tid3));
            for (int w = bx * (NWAVES * 64) + tid3; w < 32768; w += G * NWAVES * 64) {
                const int bh = w >> 10; bf16* base = URET + (size_t)bh * 32 * 8192 + (size_t)(w & 1023) * 8;
                const float dret = __builtin_amdgcn_exp2f(64.f * __log2f(1.f - exp2f(-5.f - (float)(bh & 3))));
                float S[8];
#pragma unroll
                for (int e = 0; e < 8; ++e) S[e] = 0.f;
                for (int cb = 0; cb < NCH; cb += 8) {
                    v4u uv[8];
#pragma unroll
                    for (int k = 0; k < 8; ++k) uv[k] = *(const v4u*)(base + (size_t)(cb + k) * 8192);
#pragma unroll
                    for (int k = 0; k < 8; ++k) {
                        v4u sv; sv.x = pk2(S[0], S[1]); sv.y = pk2(S[2], S[3]); sv.z = pk2(S[4], S[5]); sv.w = pk2(S[6], S[7]);
                        *(v4u*)(base + (size_t)(cb + k) * 8192) = sv;
                        const unsigned uu[4] = {uv[k].x, uv[k].y, uv[k].z, uv[k].w};
#pragma unroll
                        for (int e = 0; e < 4; ++e) { S[2 * e] = dret * S[2 * e] + __builtin_bit_cast(float, uu[e] << 16); S[2 * e + 1] = dret * S[2 * e + 1] + __builtin_bit_cast(float, uu[e] & 0xffff0000u); }
                    }
                }
            }
            for (int w2 = bx * (NWAVES * 64) + tid3; w2 < 65536; w2 += G * NWAVES * 64) {
                const int bh = w2 >> 11, d0 = (w2 & 15) * 8; bf16* base = UHG + (size_t)bh * 32 * 16384 + (size_t)(w2 & 2047) * 8; const float* blp = BL + (size_t)bh * 32 * 128 + d0;
                float S[8];
#pragma unroll
                for (int e = 0; e < 8; ++e) S[e] = 0.f;
                for (int cb = 0; cb < NCH; cb += 4) {
                    v4u uv[4]; f32x4 bl0[4], bl1[4];
#pragma unroll
                    for (int k = 0; k < 4; ++k) { uv[k] = *(const v4u*)(base + (size_t)(cb + k) * 16384); bl0[k] = *(const f32x4*)(blp + (cb + k) * 128); bl1[k] = *(const f32x4*)(blp + (cb + k) * 128 + 4); }
#pragma unroll
                    for (int k = 0; k < 4; ++k) {
                        float dec[8];
#pragma unroll
                        for (int e = 0; e < 4; ++e) { dec[e] = __builtin_amdgcn_exp2f(bl0[k][e]); dec[4 + e] = __builtin_amdgcn_exp2f(bl1[k][e]); }
                        v4u sv; sv.x = pk2(S[0], S[1]); sv.y = pk2(S[2], S[3]); sv.z = pk2(S[4], S[5]); sv.w = pk2(S[6], S[7]);
                        *(v4u*)(base + (size_t)(cb + k) * 16384) = sv;
                        const unsigned uu[4] = {uv[k].x, uv[k].y, uv[k].z, uv[k].w};
#pragma unroll
                        for (int e = 0; e < 4; ++e) { S[2 * e] = dec[2 * e] * S[2 * e] + __builtin_bit_cast(float, uu[e] << 16); S[2 * e + 1] = dec[2 * e + 1] * S[2 * e + 1] + __builtin_bit_cast(float, uu[e] & 0xffff0000u); }
                    }
                }
            }
        }
        GRID_BAR();
        {
            { mix_out_loop<128, false>(lds, PROJ, UHG, hg_norm_w + l * 512, ABUF, bx, G, tid);
            mix_out_loop<64, true>(lds, PROJ, URET, ret_norm_w + l * 512, ABUF, bx, G, tid); __syncthreads(); }
        }
        GRID_BAR();
        {
            pg8::Gemm g{ABUF, Wl + W_OUT_OFF / 2, M, D, D}; pg8::StaticOrder S; S.init(M, D, G, bx);
            if (l == 0) { pg8::EpiRes<true> E{x, X16, modl + 2 * D, norm_ffn_w + l * D, modl + 4 * D, A2, SSUM + (size_t)(2 * l + 1) * M};
                pg8::gemm_phase<pg8::EpiRes<true>, pg8::StaticOrder, true, GEMM_SP2>(lds, g, S, E); }
            else { pg8::EpiRes<false> E{X16, X16, modl + 2 * D, norm_ffn_w + l * D, modl + 4 * D, A2, SSUM + (size_t)(2 * l + 1) * M};
                pg8::gemm_phase<pg8::EpiRes<false>, pg8::StaticOrder, true, GEMM_SP2>(lds, g, S, E); }
        }
        GRID_BAR();
        {
            pg8::Gemm g{A2, Wl + W_GU_OFF / 2, M, 2 * DFF, D}; pg8::StaticOrder S; S.init(M, 2 * DFF, G, bx);
            pg8::EpiFfn E{PROJ, SSUM + (size_t)(2 * l + 1) * M, SHW2 + (size_t)l * BATCH * 5632, lds + STAGE_OFF};
            pg8::gemm_phase<pg8::EpiFfn, pg8::StaticOrder, GEMM_ALIGN, GEMM_SP2>(lds, g, S, E);
        }
        GRID_BAR();
        const bool has_next = (l + 1 < DEPTH);
        const bool fuse_final = !has_next && (M / 256) * (D / 256) == G;
        {
            pg8::Gemm g{PROJ, Wl + W_DN_OFF / 2, M, D, DFF}; pg8::StaticOrder S; S.init(M, D, G, bx);
            if (fuse_final) {
                pg8::EpiFinal E{X16, out, modl + 5 * D, final_w, SSUM + (size_t)(2 * l + 2) * M, &bar};
                pg8::gemm_phase<pg8::EpiFinal, pg8::StaticOrder, false, GEMM_SP2>(lds, g, S, E);
            } else {
                pg8::EpiRes<false> E{X16, X16, modl + 5 * D, has_next ? norm_mix_w + (l + 1) * D : nullptr, modl + BATCH * (NMOD * D) + D, ABUF, SSUM + (size_t)(2 * l + 2) * M};
                pg8::gemm_phase<pg8::EpiRes<false>, pg8::StaticOrder, true, GEMM_SP2>(lds, g, S, E);
            }
        }
        if (fuse_final) return;
        GRID_BAR();
    }
    {
        int tid_f = threadIdx.x; asm volatile("" : "+v"(tid_f)); const int lane_f = tid_f & 63;
        v4u hold[16][2];
#pragma unroll
        for (int i = 0; i < 16; ++i) { const int row = gw + i * NGW; if (row < M) { hold[i][0] = *((const v4u*)(X16 + (size_t)row * D) + lane_f * 2); hold[i][1] = *((const v4u*)(X16 + (size_t)row * D) + lane_f * 2 + 1); } }
        GRID_BAR();
#pragma unroll
        for (int i = 0; i < 16; ++i) { const int row = gw + i * NGW; if (row < M) {
            const float rs = __builtin_amdgcn_rsqf(SSUM[(size_t)4 * M + row] * (1.f / D) + EPS);
#pragma unroll
            for (int hh = 0; hh < 2; ++hh) { const unsigned w4[4] = {hold[i][hh].x, hold[i][hh].y, hold[i][hh].z, hold[i][hh].w};
#pragma unroll
                for (int q = 0; q < 2; ++q) { const int col = lane_f * 16 + hh * 8 + q * 4; const f32x4 fwv = *(const f32x4*)(final_w + col);
                    f32x4 o; o[0] = pg8::f16lo(w4[2 * q]); o[1] = pg8::f16hi(w4[2 * q]); o[2] = pg8::f16lo(w4[2 * q + 1]); o[3] = pg8::f16hi(w4[2 * q + 1]);
                    *(f32x4*)(out + (size_t)row * D + col) = o * rs * fwv; } } } }
    }
}

extern "C" void kernel_launch(void* const* d_in, const int* in_sizes, int n_in, void* d_out, int out_size, void* d_ws, size_t ws_size, hipStream_t stream) {
    static int grid = 0;
    if (grid == 0) {
        if (n_in != 15 || in_sizes[0] != M * D || out_size != M * D || ws_size < WS_END) { fprintf(stderr, "kernel_launch: unexpected shapes (n_in %d, in0 %d, out %d, ws %zu); nothing launched\n", n_in, n_in > 0 ? in_sizes[0] : -1, out_size, ws_size); grid = -1; return; }
        int dev = 0, cus = 0, per_cu = 0;
        if (hipGetDevice(&dev) != hipSuccess || hipDeviceGetAttribute(&cus, hipDeviceAttributeMultiprocessorCount, dev) != hipSuccess) { fprintf(stderr, "kernel_launch: device query failed\n"); grid = -1; return; }
        if (hipFuncSetAttribute((const void*)fwd_kernel, hipFuncAttributeMaxDynamicSharedMemorySize, LDS_BYTES) != hipSuccess) { fprintf(stderr, "kernel_launch: hipFuncSetAttribute failed\n"); grid = -1; return; }
        if (hipOccupancyMaxActiveBlocksPerMultiprocessor(&per_cu, (const void*)fwd_kernel, NWAVES * 64, LDS_BYTES) != hipSuccess || per_cu < 1)
            fprintf(stderr, "kernel_launch: note: occupancy query reports %d workgroups per CU\n", per_cu);
        (void)hipGetLastError();
        grid = cus;
    }
    if (grid < 0) return;
    if (hipMemsetAsync((char*)d_ws + WS_CTL, 0, CTL_ZERO_BYTES, stream) != hipSuccess) { fprintf(stderr, "kernel_launch: hipMemsetAsync failed\n"); return; }
    Args a{};
    for (int i = 0; i < 15; ++i) a.in[i] = (const float*)d_in[i];
    a.out = (float*)d_out; a.ws = (unsigned char*)d_ws;
    hipLaunchKernelGGL(fwd_kernel, dim3(grid), dim3(NWAVES * 64), LDS_BYTES, stream, a);
    const hipError_t le = hipPeekAtLastError();
    if (le != hipSuccess) fprintf(stderr, "kernel_launch: launch failed: %s\n", hipGetErrorName(le));
}
```

```cpp
#include <hip/hip_runtime.h>
#include <cstdio>
#include <cstdint>
#define LAS __attribute__((address_space(3)))

#define RED_ATOMIC 1
#define PG8_WGM 2
#define SHW_MFMA 1
#define MIX_CHAIN 1
#define MIX_CHAIN_P4ONLY 1
#define XB_TMO      128
#define XB_XCNT(j)  (256  + 64 * (j))
#define XB_XSUB(j)  (1280 + 64 * (j))
#define XB_XGEN(j)  (2304 + 64 * (j))
#define XB_TOP      3328
#define XB_TOPGEN   3392
#define XCD_BAR_WORDS 3456
#define XB_SPIN_CAP (1u << 18)

__device__ __forceinline__ unsigned xb_ld(unsigned* p)              { return __hip_atomic_load(p, __ATOMIC_RELAXED, __HIP_MEMORY_SCOPE_AGENT); }
__device__ __forceinline__ unsigned xb_add(unsigned* p, unsigned v) { return __hip_atomic_fetch_add(p, v, __ATOMIC_RELAXED, __HIP_MEMORY_SCOPE_AGENT); }
__device__ __forceinline__ unsigned xb_xcc_id() { return (unsigned)__builtin_amdgcn_s_getreg((3 << 11) | 20) & 0xFu; }
#define XB_SPIN(cond, bar) do { unsigned _sp = 0; while (cond) { __builtin_amdgcn_s_sleep(1); \
    if ((++_sp & 255u) == 0u) { if (xb_ld(&(bar)[XB_TMO])) break; if (_sp > XB_SPIN_CAP) { atomicAdd(&(bar)[XB_TMO], 1u); break; } } } } while (0)

struct XcdBarrier {
    unsigned* bar; unsigned x;
    volatile LAS unsigned* st;
};

__device__ __forceinline__ XcdBarrier xcd_barrier_post(unsigned* bar, volatile LAS unsigned* st) {
    XcdBarrier b; b.bar = bar; b.x = xb_xcc_id(); b.st = st;
    if (threadIdx.x == 0) (void)xb_add(&bar[XB_XCNT(b.x)], 1u);
    return b;
}
__device__ __forceinline__ void xcd_barrier_complete(unsigned* bar, unsigned x, unsigned& nloc, unsigned& nx) {
    const unsigned G = gridDim.x * gridDim.y * gridDim.z;
    unsigned sum, cnt, mine, sp = 0u;
    for (;;) {
        sum = 0u; cnt = 0u; mine = 0u;
#pragma unroll
        for (unsigned j = 0; j < 16; ++j) { const unsigned c = xb_ld(&bar[XB_XCNT(j)]); sum += c; cnt += (c > 0u) ? 1u : 0u; mine = (j == x) ? c : mine; }
        if (sum == G) break;
        __builtin_amdgcn_s_sleep(1);
        if ((++sp & 255u) == 0u) { if (xb_ld(&bar[XB_TMO])) break; if (sp > XB_SPIN_CAP) { atomicAdd(&bar[XB_TMO], 1u); break; } }
    }
    nloc = mine > 0u ? mine : 1u; nx = cnt > 0u ? cnt : 1u;
}

__device__ __forceinline__ void xcd_barrier(const XcdBarrier& b) {
    asm volatile("s_waitcnt vmcnt(0)" ::: "memory");
    __syncthreads();
    if (threadIdx.x == 0) {
        unsigned* bar = b.bar; const unsigned bx_ = xb_xcc_id();
        __builtin_amdgcn_s_waitcnt(0);
        unsigned nloc = b.st[0], nx = b.st[1];
        if (nloc == 0u) { xcd_barrier_complete(bar, bx_, nloc, nx); b.st[0] = nloc; b.st[1] = nx; }
        const unsigned old = xb_add(&bar[XB_XSUB(bx_)], 1u);
        const unsigned gen = old / nloc;
        if (old + 1u == (gen + 1u) * nloc) {
            __builtin_amdgcn_fence(__ATOMIC_RELEASE, "agent");
            asm volatile("s_waitcnt vmcnt(0)" ::: "memory");
            const unsigned og = xb_add(&bar[XB_TOP], 1u);
            const unsigned tg = og / nx;
            if (og + 1u == (tg + 1u) * nx) xb_add(&bar[XB_TOPGEN], 1u);
            else XB_SPIN(xb_ld(&bar[XB_TOPGEN]) == tg, bar);
            __builtin_amdgcn_fence(__ATOMIC_ACQUIRE, "agent");
            xb_add(&bar[XB_XGEN(bx_)], 1u);
            asm volatile("s_waitcnt vmcnt(0)" ::: "memory");
        } else {
            XB_SPIN(xb_ld(&bar[XB_XGEN(bx_)]) == gen, bar);
            __builtin_amdgcn_fence(__ATOMIC_ACQUIRE, "agent");
            asm volatile("s_waitcnt vmcnt(0)" ::: "memory");
        }
    }
    __syncthreads();
}
namespace pg8 {
#define PG8_LAS __attribute__((address_space(3)))
typedef unsigned short bf16_t;
typedef short bf16x8 __attribute__((ext_vector_type(8)));
typedef float f32x4 __attribute__((ext_vector_type(4)));
typedef unsigned u32x4 __attribute__((ext_vector_type(4)));
constexpr int BM = 256, BK = 64, HALF = 128, HTB = HALF * BK * 2  , STAGE_BYTES = 8 * HTB, NXCD = 8;
#ifndef PG8_WGM
#define PG8_WGM 8
#endif
constexpr int WGM = PG8_WGM;

__host__ __device__ __forceinline__ int lds_byte(int r, int c) { const int st = (r >> 4) * 2 + (c >> 5), rr = r & 15, cc = c & 31, ob = rr * 64 + cc * 2; return st * 1024 + (ob ^ (((ob >> 9) & 1) << 5)); }
__host__ __device__ __forceinline__ void stage_rc(int b, int& R, int& C) { const int st = b / 1024, sb = b % 1024, swz = sb ^ (((sb >> 9) & 1) << 5); R = (st >> 1) * 16 + swz / 64; C = (st & 1) * 32 + (swz % 64) / 2; }
__host__ __device__ __forceinline__ int perm32(int rho) { const int n = rho >> 4, i = rho & 15; return 8 * (i >> 2) + 4 * n + (i & 3); }

struct Unit { int pm, pn; };
struct Gemm { const bf16_t* A; const bf16_t* Bt; int M, N, K; };

struct StaticOrder {
    int nM, nN, nwg, G, c;
    __host__ __device__ void init(int M, int N, int G_, int c_) { nM = M / BM; nN = N / BM; nwg = nM * nN; G = G_; c = c_; }
    __host__ __device__ bool next(int i, Unit& u) const {
        const long L = (long)i * G + c; if (L >= nwg) return false;
        int wgid = (int)L; { const int q = nwg / NXCD, r = nwg % NXCD, xcd = wgid % NXCD, off = wgid / NXCD; wgid = (xcd < r ? xcd * (q + 1) : r * (q + 1) + (xcd - r) * q) + off; }
        const int nig = WGM * nN, gid = wgid / nig, fm = gid * WGM, gsz = (nM - fm) < WGM ? (nM - fm) : WGM;
        u.pm = fm + ((wgid % nig) % gsz); u.pn = (wgid % nig) / gsz; return true;
    }
    __device__ __forceinline__ void a_ready(const Unit&) const {}
    __device__ __forceinline__ void done(const Unit&) const {}
};

typedef float f32x2c_t __attribute__((ext_vector_type(2))); typedef __bf16 bf16x2c_t __attribute__((ext_vector_type(2)));
__device__ __forceinline__ unsigned cvt_pk_bf16(float lo, float hi) { const f32x2c_t v = {lo, hi}; const bf16x2c_t b = __builtin_convertvector(v, bf16x2c_t); return __builtin_bit_cast(unsigned, b); }
typedef float f32x2 __attribute__((ext_vector_type(2)));

constexpr float K_EPS = 1e-6f;
#ifdef NT_RES
#define PG8_LD1(p) __builtin_nontemporal_load(p)
#else
#define PG8_LD1(p) (*(p))
#endif
#ifdef EPI_NT
#define PG8_ST(T, p, v) __builtin_nontemporal_store((v), (T*)(p))
#else
#define PG8_ST(T, p, v) (*(T*)(p) = (v))
#endif
__device__ __forceinline__ float silu_f(float v) { return v * __builtin_amdgcn_rcpf(1.f + __expf(-v)); }
__device__ __forceinline__ unsigned pk_f16(float lo, float hi) { const _Float16 a = (_Float16)lo, b = (_Float16)hi; return (unsigned)__builtin_bit_cast(unsigned short, a) | ((unsigned)__builtin_bit_cast(unsigned short, b) << 16); }

struct EpiWin {
    static constexpr bool PERM = true, AFTER_DRAIN = false, STAGED = true; static constexpr int NSTORE = 16;
    bf16_t* proj;
    const float* ssum;
    const float* shw;
    const float2* tab;
    const float* lbw;
    int layer;
    PG8_LAS unsigned char* stage;
    int pn_off;
    __device__ __forceinline__ void prefetch(const Unit& u, int ui, int wid, int lane) const {
        const float* src = wid < 4 ? ssum + u.pm * BM + 64 * wid + lane : shw + (size_t)(u.pm >> 3) * 3584 + (u.pn + pn_off) * BM + 64 * (wid - 4) + lane;
        __builtin_amdgcn_global_load_lds((const unsigned*)src, (PG8_LAS unsigned*)(stage + (ui & 1) * 2048 + wid * 256), 4, 0, 0);
    }
    __device__ __forceinline__ void operator()(const f32x4 (&acc)[2][2][4][2], const Unit& u, int wr, int wc, int fr_in, int fq_in, int ui) const {
        int fr = fr_in, fq = fq_in; asm volatile("" : "+v"(fr), "+v"(fq));
        const int b = u.pm >> 3, pn = u.pn + pn_off;
        const int colb = pn * BM + wc * 32 + 8 * fq;
        const PG8_LAS float* SS = (const PG8_LAS float*)(stage + (ui & 1) * 2048); const PG8_LAS float* SV = SS + 256;
        const int type = pn == 0 ? 0 : pn == 1 ? 1 : (pn == 2 || pn == 3 || pn == 10 || pn == 11) ? 2 : (pn == 8 || pn == 9) ? 4 : 3;
        f32x4 sv[2][2];
#pragma unroll
        for (int bj = 0; bj < 2; ++bj)
#pragma unroll
            for (int n = 0; n < 2; ++n) sv[bj][n] = *(const PG8_LAS f32x4*)(SV + bj * HALF + wc * 32 + 8 * fq + 4 * n);
        float lb[2][8];
#pragma unroll
        for (int bj = 0; bj < 2; ++bj)
#pragma unroll
            for (int i = 0; i < 8; ++i) lb[bj][i] = 0.f;
        if (type == 4 && layer != 0) {
#pragma unroll
            for (int bj = 0; bj < 2; ++bj)
#pragma unroll
                for (int i = 0; i < 8; ++i) { const int c = colb + bj * HALF + i - 2048; lb[bj][i] = __builtin_amdgcn_rcpf(1.f + __expf(lbw[c] - lbw[512 + c])); }
        }
        if (type <= 1) {
            const float sc = type == 1 ? 0.125f : 1.f;
#pragma unroll
            for (int ap = 0; ap < 4; ++ap) { const int ai = ap >> 1, m0 = (ap & 1) * 2;
                f32x4 tb[2][2][2];
#pragma unroll
                for (int mm = 0; mm < 2; ++mm)
#pragma unroll
                    for (int bj = 0; bj < 2; ++bj) { const int pos = (u.pm * BM + ai * HALF + wr * 64 + (m0 + mm) * 16 + fr) & 2047, i0 = ((colb + bj * HALF) & 63) >> 1;
                        tb[mm][bj][0] = *(const f32x4*)(tab + pos * 32 + i0); tb[mm][bj][1] = *(const f32x4*)(tab + pos * 32 + i0 + 2); }
#pragma unroll
                for (int mm = 0; mm < 2; ++mm) { const int m = m0 + mm; const int row = u.pm * BM + ai * HALF + wr * 64 + m * 16 + fr;
                    const float rs = __builtin_amdgcn_rsqf(SS[ai * HALF + wr * 64 + m * 16 + fr] * (1.f / 1024.f) + K_EPS);
#pragma unroll
                    for (int bj = 0; bj < 2; ++bj) {
                        const f32x4 v0 = acc[ai][bj][m][0] * rs + sv[bj][0], v1 = acc[ai][bj][m][1] * rs + sv[bj][1];
                        const f32x4 t0 = tb[mm][bj][0], t1 = tb[mm][bj][1];
                        float o[8];
                        o[0] = (v0[0] * t0[0] - v0[1] * t0[1]) * sc; o[1] = (v0[0] * t0[1] + v0[1] * t0[0]) * sc;
                        o[2] = (v0[2] * t0[2] - v0[3] * t0[3]) * sc; o[3] = (v0[2] * t0[3] + v0[3] * t0[2]) * sc;
                        o[4] = (v1[0] * t1[0] - v1[1] * t1[1]) * sc; o[5] = (v1[0] * t1[1] + v1[1] * t1[0]) * sc;
                        o[6] = (v1[2] * t1[2] - v1[3] * t1[3]) * sc; o[7] = (v1[2] * t1[3] + v1[3] * t1[2]) * sc;
                        u32x4 w; w.x = cvt_pk_bf16(o[0], o[1]); w.y = cvt_pk_bf16(o[2], o[3]); w.z = cvt_pk_bf16(o[4], o[5]); w.w = cvt_pk_bf16(o[6], o[7]);
                        PG8_ST(u32x4, proj + (size_t)row * 3584 + colb + bj * HALF, w);
                    }
                }
                asm volatile("" ::: "memory");
            }
            return;
        }
#pragma unroll
        for (int ai = 0; ai < 2; ++ai)
#pragma unroll
            for (int m = 0; m < 4; ++m) {
                const int row = u.pm * BM + ai * HALF + wr * 64 + m * 16 + fr;
                const float rs = __builtin_amdgcn_rsqf(SS[ai * HALF + wr * 64 + m * 16 + fr] * (1.f / 1024.f) + K_EPS);
                const int pos = row & 2047;
#pragma unroll
                for (int bj = 0; bj < 2; ++bj) {
                    float v[8];
                    {   const f32x4 v0 = acc[ai][bj][m][0] * rs + sv[bj][0], v1 = acc[ai][bj][m][1] * rs + sv[bj][1];
                        v[0] = v0[0]; v[1] = v0[1]; v[2] = v0[2]; v[3] = v0[3]; v[4] = v1[0]; v[5] = v1[1]; v[6] = v1[2]; v[7] = v1[3]; }
                    u32x4 w;
                    if (type == 2) {
                        w.x = cvt_pk_bf16(v[0], v[1]); w.y = cvt_pk_bf16(v[2], v[3]); w.z = cvt_pk_bf16(v[4], v[5]); w.w = cvt_pk_bf16(v[6], v[7]);
                    } else if (type == 3) {
                        unsigned wv[4];
#pragma unroll
                        for (int q = 0; q < 4; ++q) { const f32x2 x = (f32x2){v[2 * q], v[2 * q + 1]}, xn = x * (-1.44269504089f);
                            f32x2 e; e.x = __builtin_amdgcn_exp2f(xn.x); e.y = __builtin_amdgcn_exp2f(xn.y);
                            const f32x2 d = e + 1.0f; f32x2 r; r.x = __builtin_amdgcn_rcpf(d.x); r.y = __builtin_amdgcn_rcpf(d.y);
                            const f32x2 o = x * r; wv[q] = cvt_pk_bf16(o.x, o.y); }
                        w.x = wv[0]; w.y = wv[1]; w.z = wv[2]; w.w = wv[3];
                    } else {
                        float g[8];
                        if (layer == 0) {
#pragma unroll
                            for (int i = 0; i < 8; ++i) g[i] = fminf(v[i], 0.f) - __logf(1.f + __expf(-fabsf(v[i])));
                        } else {
#pragma unroll
                            for (int i = 0; i < 8; ++i) { const float s = __builtin_amdgcn_rcpf(1.f + __expf(-v[i])); g[i] = __logf(lb[bj][i] + (1.f - lb[bj][i]) * s); }
                        }
                        w.x = pk_f16(g[0], g[1]); w.y = pk_f16(g[2], g[3]); w.z = pk_f16(g[4], g[5]); w.w = pk_f16(g[6], g[7]);
                    }
                    PG8_ST(u32x4, proj + (size_t)row * 3584 + colb + bj * HALF, w);
                }
            }
    }
};

__device__ __forceinline__ float f16lo(unsigned w) { return (float)__builtin_bit_cast(_Float16, (unsigned short)(w & 0xffffu)); }
__device__ __forceinline__ float f16hi(unsigned w) { return (float)__builtin_bit_cast(_Float16, (unsigned short)(w >> 16)); }
template <bool XF32> struct EpiRes {
    static constexpr bool PERM = true, AFTER_DRAIN = false, STAGED = false; static constexpr int NSTORE = 0;
    const void* xres; bf16_t* xout;
    const float* gvec;
    const float* nw; const float* scv;
    bf16_t* anext;
    float* ssum;
    __device__ __forceinline__ void operator()(const f32x4 (&acc)[2][2][4][2], const Unit& u, int wr, int wc, int fr_in, int fq_in) const {
        int fr = fr_in, fq = fq_in; asm volatile("" : "+v"(fr), "+v"(fq));
        const int b = u.pm >> 3;
        const int colb = u.pn * BM + wc * 32 + 8 * fq;
        f32x4 gv[2][2], wm[2][2];
#pragma unroll
        for (int bj = 0; bj < 2; ++bj)
#pragma unroll
            for (int n = 0; n < 2; ++n) {
                const int c = colb + bj * HALF + 4 * n;
                gv[bj][n] = *(const f32x4*)(gvec + (size_t)b * 6144 + c);
                wm[bj][n] = nw ? (*(const f32x4*)(nw + c)) * (1.f + *(const f32x4*)(scv + (size_t)b * 6144 + c)) : (f32x4){0.f, 0.f, 0.f, 0.f};
            }
#pragma unroll
        for (int ap = 0; ap < 4; ++ap) { const int ai = ap >> 1, m0 = (ap & 1) * 2;
            f32x4 pre[2][2][2];
#pragma unroll
            for (int mm = 0; mm < 2; ++mm)
#pragma unroll
                for (int bj = 0; bj < 2; ++bj) { const size_t off = (size_t)(u.pm * BM + ai * HALF + wr * 64 + (m0 + mm) * 16 + fr) * 1024 + colb + bj * HALF;
                    if constexpr (XF32) { pre[mm][bj][0] = *(const f32x4*)((const float*)xres + off); pre[mm][bj][1] = *(const f32x4*)((const float*)xres + off + 4); }
                    else { const u32x4 h = *(const u32x4*)((const bf16_t*)xres + off); pre[mm][bj][0] = __builtin_bit_cast(f32x4, h); } }
#pragma unroll
            for (int mm = 0; mm < 2; ++mm) { const int m = m0 + mm;
                const int row = u.pm * BM + ai * HALF + wr * 64 + m * 16 + fr;
                float ss = 0.f;
#pragma unroll
                for (int bj = 0; bj < 2; ++bj) {
                    const size_t off = (size_t)row * 1024 + colb + bj * HALF;
                    f32x4 r0, r1;
                    if constexpr (XF32) { r0 = pre[mm][bj][0]; r1 = pre[mm][bj][1]; }
                    else { const u32x4 h = __builtin_bit_cast(u32x4, pre[mm][bj][0]); r0 = (f32x4){f16lo(h.x), f16hi(h.x), f16lo(h.y), f16hi(h.y)}; r1 = (f32x4){f16lo(h.z), f16hi(h.z), f16lo(h.w), f16hi(h.w)}; }
                    const f32x4 x0 = r0 + gv[bj][0] * acc[ai][bj][m][0], x1 = r1 + gv[bj][1] * acc[ai][bj][m][1];
                    { u32x4 hx; hx.x = pk_f16(x0[0], x0[1]); hx.y = pk_f16(x0[2], x0[3]); hx.z = pk_f16(x1[0], x1[1]); hx.w = pk_f16(x1[2], x1[3]); PG8_ST(u32x4, xout + off, hx); }
                    ss += (x0[0] * x0[0] + x0[1] * x0[1]) + (x0[2] * x0[2] + x0[3] * x0[3]) + (x1[0] * x1[0] + x1[1] * x1[1]) + (x1[2] * x1[2] + x1[3] * x1[3]);
                    if (nw) { const f32x4 a0 = x0 * wm[bj][0], a1 = x1 * wm[bj][1]; u32x4 w; w.x = cvt_pk_bf16(a0[0], a0[1]); w.y = cvt_pk_bf16(a0[2], a0[3]); w.z = cvt_pk_bf16(a1[0], a1[1]); w.w = cvt_pk_bf16(a1[2], a1[3]);
                        PG8_ST(u32x4, anext + off, w); }
                }
                ss += __shfl_xor(ss, 16); ss += __shfl_xor(ss, 32);
                if (fq == 0) atomicAdd(ssum + row, ss);
            }
            asm volatile("" ::: "memory");
        }
    }
};

struct EpiFinal {
    static constexpr bool PERM = true, AFTER_DRAIN = true, STAGED = false; static constexpr int NSTORE = 0;
    const bf16_t* xres; float* out; const float* gvec; const float* fw; float* ssum; const XcdBarrier* bar;
    __device__ __forceinline__ void fused(f32x4 (&acc)[2][2][4][2], const Unit& u, int wr, int wc, int fr_in, int fq_in, PG8_LAS unsigned char* lds, int wid, int lane) const {
        int fr = fr_in, fq = fq_in; asm volatile("" : "+v"(fr), "+v"(fq));
        const int b = u.pm >> 3;
        const int colb = u.pn * BM + wc * 32 + 8 * fq;
        {
            f32x4 gv[2][2];
#pragma unroll
            for (int bj = 0; bj < 2; ++bj)
#pragma unroll
                for (int n = 0; n < 2; ++n) gv[bj][n] = *(const f32x4*)(gvec + (size_t)b * 6144 + colb + bj * HALF + 4 * n);
#pragma unroll
            for (int ai = 0; ai < 2; ++ai) {
                u32x4 pre[4][2];
#pragma unroll
                for (int m = 0; m < 4; ++m)
#pragma unroll
                    for (int bj = 0; bj < 2; ++bj) pre[m][bj] = *(const u32x4*)(xres + (size_t)(u.pm * BM + ai * HALF + wr * 64 + m * 16 + fr) * 1024 + colb + bj * HALF);
#pragma unroll
                for (int m = 0; m < 4; ++m) {
                    const int row = u.pm * BM + ai * HALF + wr * 64 + m * 16 + fr;
                    float ss = 0.f;
#pragma unroll
                    for (int bj = 0; bj < 2; ++bj) {
                        const u32x4 h = pre[m][bj];
                        const f32x4 r0 = (f32x4){f16lo(h.x), f16hi(h.x), f16lo(h.y), f16hi(h.y)}, r1 = (f32x4){f16lo(h.z), f16hi(h.z), f16lo(h.w), f16hi(h.w)};
                        const f32x4 x0 = r0 + gv[bj][0] * acc[ai][bj][m][0], x1 = r1 + gv[bj][1] * acc[ai][bj][m][1];
                        acc[ai][bj][m][0] = x0; acc[ai][bj][m][1] = x1;
                        ss += (x0[0] * x0[0] + x0[1] * x0[1]) + (x0[2] * x0[2] + x0[3] * x0[3]) + (x1[0] * x1[0] + x1[1] * x1[1]) + (x1[2] * x1[2] + x1[3] * x1[3]);
                    }
                    ss += __shfl_xor(ss, 16); ss += __shfl_xor(ss, 32);
                    if (fq == 0) atomicAdd(ssum + row, ss);
                }
                asm volatile("" ::: "memory");
            }
        }
        xcd_barrier(*bar);
        f32x4 fv[2][2];
#pragma unroll
        for (int bj = 0; bj < 2; ++bj)
#pragma unroll
            for (int n = 0; n < 2; ++n) fv[bj][n] = *(const f32x4*)(fw + colb + bj * HALF + 4 * n);
        float sq[2][4];
#pragma unroll
        for (int ai = 0; ai < 2; ++ai)
#pragma unroll
            for (int m = 0; m < 4; ++m) sq[ai][m] = __hip_atomic_load(ssum + u.pm * BM + ai * HALF + wr * 64 + m * 16 + fr, __ATOMIC_RELAXED, __HIP_MEMORY_SCOPE_AGENT);
#pragma unroll
        for (int ai = 0; ai < 2; ++ai)
#pragma unroll
            for (int m = 0; m < 4; ++m) {
                const int row = u.pm * BM + ai * HALF + wr * 64 + m * 16 + fr;
                const float rs = __builtin_amdgcn_rsqf(sq[ai][m] * (1.f / 1024.f) + K_EPS);
#pragma unroll
                for (int bj = 0; bj < 2; ++bj) {
                    const size_t off = (size_t)row * 1024 + colb + bj * HALF;
                    *(f32x4*)(out + off) = acc[ai][bj][m][0] * rs * fv[bj][0]; *(f32x4*)(out + off + 4) = acc[ai][bj][m][1] * rs * fv[bj][1];
                }
            }
    }
};

struct EpiFfn {
    static constexpr bool PERM = true, AFTER_DRAIN = false, STAGED = true; static constexpr int NSTORE = 8;
    bf16_t* act; const float* ssum; const float* shw;
    PG8_LAS unsigned char* stage;
    __device__ __forceinline__ void prefetch(const Unit& u, int ui, int wid, int lane) const {
        const float* src = wid < 4 ? ssum + u.pm * BM + 64 * wid + lane : shw + (size_t)(u.pm >> 3) * 5632 + u.pn * BM + 64 * (wid - 4) + lane;
        __builtin_amdgcn_global_load_lds((const unsigned*)src, (PG8_LAS unsigned*)(stage + (ui & 1) * 2048 + wid * 256), 4, 0, 0);
    }
    __device__ __forceinline__ void operator()(const f32x4 (&acc)[2][2][4][2], const Unit& u, int wr, int wc, int fr_in, int fq_in, int ui) const {
        int fr = fr_in, fq = fq_in; asm volatile("" : "+v"(fr), "+v"(fq));
        const int cl = wc * 32 + 8 * fq;
        const PG8_LAS float* SS = (const PG8_LAS float*)(stage + (ui & 1) * 2048); const PG8_LAS float* SV = SS + 256;
        f32x2 sg[4], sgn[4], su[4];
#pragma unroll
        for (int n = 0; n < 2; ++n) { const f32x4 a = *(const PG8_LAS f32x4*)(SV + cl + 4 * n), c = *(const PG8_LAS f32x4*)(SV + HALF + cl + 4 * n);
            sg[2 * n] = (f32x2){a[0], a[1]}; sg[2 * n + 1] = (f32x2){a[2], a[3]}; su[2 * n] = (f32x2){c[0], c[1]}; su[2 * n + 1] = (f32x2){c[2], c[3]}; }
#pragma unroll
        for (int q = 0; q < 4; ++q) sgn[q] = sg[q] * (-1.44269504089f);
#pragma unroll
        for (int ai = 0; ai < 2; ++ai)
#pragma unroll
            for (int m = 0; m < 4; ++m) {
                const int row = u.pm * BM + ai * HALF + wr * 64 + m * 16 + fr;
                const float rs = __builtin_amdgcn_rsqf(SS[ai * HALF + wr * 64 + m * 16 + fr] * (1.f / 1024.f) + K_EPS), nrs = rs * (-1.44269504089f);
                unsigned wv[4];
#pragma unroll
                for (int q = 0; q < 4; ++q) {
                    const f32x4 ag4 = acc[ai][0][m][q >> 1], au4 = acc[ai][1][m][q >> 1];
                    const f32x2 ag = (q & 1) ? (f32x2){ag4[2], ag4[3]} : (f32x2){ag4[0], ag4[1]}, au = (q & 1) ? (f32x2){au4[2], au4[3]} : (f32x2){au4[0], au4[1]};
                    const f32x2 g = ag * rs + sg[q], gn = ag * nrs + sgn[q], uu = au * rs + su[q];
                    f32x2 e; e.x = __builtin_amdgcn_exp2f(gn.x); e.y = __builtin_amdgcn_exp2f(gn.y);
                    const f32x2 d = e + 1.0f;
                    f32x2 r; r.x = __builtin_amdgcn_rcpf(d.x); r.y = __builtin_amdgcn_rcpf(d.y);
                    const f32x2 o = (g * uu) * r;
                    wv[q] = cvt_pk_bf16(o.x, o.y);
                }
                u32x4 w; w.x = wv[0]; w.y = wv[1]; w.z = wv[2]; w.w = wv[3];
                PG8_ST(u32x4, act + (size_t)row * 2816 + u.pn * HALF + cl, w);
            }
    }
};

template <class Epi, class Sched, bool ALIGN_EPI = false, bool SP2 = false>
__device__ __forceinline__ void gemm_phase(PG8_LAS unsigned char* lds, const Gemm g, const Sched& S, const Epi& E) {
    int tid_l = threadIdx.x; asm volatile("" : "+v"(tid_l));
    const int tid = tid_l, wid = __builtin_amdgcn_readfirstlane(tid >> 6), lane = tid & 63, wr = wid >> 2, wc = wid & 3, fr = lane & 15, fq = lane >> 4;
#ifdef DUP_K
    const int K = g.K, nt0 = K / BK, nt = 2 * nt0;
#ifdef DUP_KHIT
#define PG8_TW(t) ((((t) >> 2) << 1) | ((t) & 1))
#else
#define PG8_TW(t) ((t) % nt0)
#endif
#else
    const int K = g.K, nt = K / BK;
#define PG8_TW(t) (t)
#endif
    unsigned voffA[2], voffB[2];
#pragma unroll
    for (int i = 0; i < 2; ++i) { int R, C; stage_rc(tid * 16 + i * 8192, R, C); const int Rb = Epi::PERM ? ((R & ~31) + perm32(R & 31)) : R;
        voffA[i] = (unsigned)(R * K + C) * 2u; voffB[i] = (unsigned)(Rb * K + C) * 2u; }
    const size_t kstep = (size_t)(BK * 2);
    const size_t hstep = (size_t)HALF * K * 2;
    const size_t tstep = 2 * hstep;
    const unsigned ldsw = (unsigned)wid * 1024u;
    const int aoff = lds_byte(wr * 64 + fr, fq * 8), boff = lds_byte(wc * 32 + fr, fq * 8);
#define PG8_SA(b, h) (((b) * 2 + (h)) * HTB)
#define PG8_SB(b, h) ((4 + (b) * 2 + (h)) * HTB)
#define PG8_STAGE(bufoff, gbase, voff) do { _Pragma("unroll") for (int _i = 0; _i < 2; ++_i) \
        __builtin_amdgcn_global_load_lds((const unsigned*)((const char*)(gbase) + (voff)[_i]), (PG8_LAS unsigned*)(lds + (bufoff) + ldsw + _i * 8192), 16, 0, 0); } while (0)
#define PG8_LDA(dst, b, h) do { _Pragma("unroll") for (int m = 0; m < 4; ++m) _Pragma("unroll") for (int k = 0; k < 2; ++k) dst[m][k] = *(const PG8_LAS bf16x8*)(lds + PG8_SA(b, h) + aoff + m * 2048 + k * 1024); } while (0)
#define PG8_LDB(dst, b, h) do { _Pragma("unroll") for (int n = 0; n < 2; ++n) _Pragma("unroll") for (int k = 0; k < 2; ++k) dst[n][k] = *(const PG8_LAS bf16x8*)(lds + PG8_SB(b, h) + boff + n * 2048 + k * 1024); } while (0)
#define PG8_MMA(ai, bj, At, Bt) do { __builtin_amdgcn_s_setprio(1); _Pragma("unroll") for (int m = 0; m < 4; ++m) _Pragma("unroll") for (int n = 0; n < 2; ++n) _Pragma("unroll") for (int k = 0; k < 2; ++k) \
        acc[ai][bj][m][n] = __builtin_amdgcn_mfma_f32_16x16x32_bf16(Bt[n][k], At[m][k], acc[ai][bj][m][n], 0, 0, 0); __builtin_amdgcn_s_setprio(0); } while (0)
#define PG8_WAIT_V(n) asm volatile("s_waitcnt vmcnt(" #n ")" ::: "memory")
#define PG8_WAIT_L(n) asm volatile("s_waitcnt lgkmcnt(" #n ")" ::: "memory")
#define PG8_BAR __builtin_amdgcn_s_barrier()
#define PG8_SCHED __builtin_amdgcn_sched_barrier(0)
    Unit cur, nxt; int ui = 0;
    if (!S.next(0, cur)) return;
    f32x4 acc[2][2][4][2];
#pragma unroll
    for (int a = 0; a < 2; ++a)
#pragma unroll
        for (int b = 0; b < 2; ++b)
#pragma unroll
            for (int m = 0; m < 4; ++m)
#pragma unroll
                for (int n = 0; n < 2; ++n) acc[a][b][m][n] = (f32x4){0.f, 0.f, 0.f, 0.f};
    bf16x8 At[4][2], B0[2][2], B1[2][2];
    const char* cA = (const char*)g.A + (size_t)cur.pm * tstep; const char* cB = (const char*)g.Bt + (size_t)cur.pn * tstep;
    S.a_ready(cur);
    if constexpr (SP2) {
        PG8_STAGE(PG8_SB(0, 0), cB, voffB); PG8_STAGE(PG8_SB(0, 1), cB + hstep, voffB); PG8_STAGE(PG8_SA(0, 0), cA, voffA); PG8_STAGE(PG8_SA(0, 1), cA + hstep, voffA);
        if (wr == 1) PG8_BAR;
        PG8_WAIT_V(2); PG8_BAR;
        PG8_STAGE(PG8_SB(1, 0), cB + kstep, voffB); PG8_STAGE(PG8_SA(1, 0), cA + kstep, voffA); PG8_STAGE(PG8_SB(1, 1), cB + hstep + kstep, voffB);
        PG8_WAIT_V(6); PG8_BAR;
    } else {
        PG8_STAGE(PG8_SB(0, 0), cB, voffB); PG8_STAGE(PG8_SA(0, 0), cA, voffA); PG8_STAGE(PG8_SB(0, 1), cB + hstep, voffB); PG8_STAGE(PG8_SA(0, 1), cA + hstep, voffA);
        if (wr == 1) PG8_BAR;
        PG8_WAIT_V(4); PG8_BAR;
        PG8_STAGE(PG8_SB(1, 0), cB + kstep, voffB); PG8_STAGE(PG8_SA(1, 0), cA + kstep, voffA); PG8_STAGE(PG8_SB(1, 1), cB + hstep + kstep, voffB);
        PG8_WAIT_V(6); PG8_BAR;
    }
    for (;;) {
        const bool has_next = S.next(ui + 1, nxt);
        const char* nA = has_next ? (const char*)g.A + (size_t)nxt.pm * tstep : cA; const char* nB = has_next ? (const char*)g.Bt + (size_t)nxt.pn * tstep : cB;
        if constexpr (Epi::STAGED) E.prefetch(cur, ui, wid, lane);
        for (int t = 0; t < nt; t += 2) {
            const bool last = (t == nt - 2);
            const char* a1 = cA + (size_t)PG8_TW(t + 1) * kstep;
            const char* a2 = last ? nA : cA + (size_t)PG8_TW(t + 2) * kstep; const char* b2 = last ? nB : cB + (size_t)PG8_TW(t + 2) * kstep;
            const char* a3 = a2 + kstep; const char* b3 = b2 + kstep;
            if (last && has_next) S.a_ready(nxt);
            if constexpr (SP2) {
            PG8_LDB(B0, 0, 0); PG8_LDB(B1, 0, 1); PG8_SCHED; PG8_LDA(At, 0, 0); PG8_STAGE(PG8_SA(1, 1), a1 + hstep, voffA);
            PG8_WAIT_V(8); PG8_WAIT_L(0); PG8_BAR; PG8_MMA(0, 0, At, B0); PG8_MMA(0, 1, At, B1); PG8_BAR; PG8_SCHED;
            PG8_LDA(At, 0, 1); PG8_STAGE(PG8_SB(0, 0), b2, voffB); PG8_STAGE(PG8_SB(0, 1), b2 + hstep, voffB); PG8_STAGE(PG8_SA(0, 0), a2, voffA);
            PG8_WAIT_V(8); PG8_WAIT_L(0); PG8_BAR; PG8_MMA(1, 0, At, B0); PG8_MMA(1, 1, At, B1); PG8_BAR; PG8_SCHED;
            PG8_LDB(B0, 1, 0); PG8_LDB(B1, 1, 1); PG8_SCHED; PG8_LDA(At, 1, 0); PG8_STAGE(PG8_SA(0, 1), a2 + hstep, voffA);
            PG8_WAIT_V(8); PG8_WAIT_L(0); PG8_BAR; PG8_MMA(0, 0, At, B0); PG8_MMA(0, 1, At, B1); PG8_BAR; PG8_SCHED;
            PG8_LDA(At, 1, 1); PG8_STAGE(PG8_SB(1, 0), b3, voffB); PG8_STAGE(PG8_SB(1, 1), b3 + hstep, voffB); PG8_STAGE(PG8_SA(1, 0), a3, voffA);
            PG8_WAIT_V(8); PG8_WAIT_L(0); PG8_BAR; PG8_MMA(1, 0, At, B0); PG8_MMA(1, 1, At, B1); PG8_BAR; PG8_SCHED;
            } else {
            PG8_LDB(B0, 0, 0); PG8_SCHED; PG8_LDA(At, 0, 0); PG8_STAGE(PG8_SA(1, 1), a1 + hstep, voffA);
            PG8_WAIT_L(8); PG8_BAR; PG8_WAIT_L(0); PG8_MMA(0, 0, At, B0); PG8_BAR; PG8_SCHED;
            PG8_LDB(B1, 0, 1); PG8_STAGE(PG8_SB(0, 0), b2, voffB);
            PG8_BAR; PG8_WAIT_L(0); PG8_MMA(0, 1, At, B1); PG8_BAR;
            PG8_LDA(At, 0, 1); PG8_STAGE(PG8_SA(0, 0), a2, voffA);
            PG8_BAR; PG8_WAIT_L(0); PG8_MMA(1, 0, At, B0); PG8_BAR; PG8_SCHED;
            PG8_STAGE(PG8_SB(0, 1), b2 + hstep, voffB);
            PG8_WAIT_V(6); PG8_BAR; PG8_MMA(1, 1, At, B1); PG8_BAR;
            PG8_LDB(B0, 1, 0); PG8_SCHED; PG8_LDA(At, 1, 0); PG8_STAGE(PG8_SA(0, 1), a2 + hstep, voffA);
            PG8_WAIT_L(8); PG8_BAR; PG8_WAIT_L(0); PG8_MMA(0, 0, At, B0); PG8_BAR; PG8_SCHED;
            PG8_LDB(B1, 1, 1); PG8_STAGE(PG8_SB(1, 0), b3, voffB);
            PG8_BAR; PG8_WAIT_L(0); PG8_MMA(0, 1, At, B1); PG8_BAR;
            PG8_LDA(At, 1, 1); PG8_STAGE(PG8_SA(1, 0), a3, voffA);
            PG8_BAR; PG8_WAIT_L(0); PG8_MMA(1, 0, At, B0); PG8_BAR; PG8_SCHED;
            PG8_STAGE(PG8_SB(1, 1), b3 + hstep, voffB);
            PG8_WAIT_V(6); PG8_BAR; PG8_MMA(1, 1, At, B1); PG8_BAR;
            }
        }
        if constexpr (ALIGN_EPI) { if (wr == 0) PG8_BAR; }
#ifdef DUP_K
#pragma unroll
        for (int a_ = 0; a_ < 2; ++a_)
#pragma unroll
            for (int b_ = 0; b_ < 2; ++b_)
#pragma unroll
                for (int m_ = 0; m_ < 4; ++m_)
#pragma unroll
                    for (int n_ = 0; n_ < 2; ++n_) acc[a_][b_][m_][n_] *= 0.5f;
#endif
#ifdef DUP_EPI2
        if constexpr (!Epi::AFTER_DRAIN && Epi::STAGED) E(acc, cur, wr, wc, fr, fq, ui);
#endif
        if constexpr (!Epi::AFTER_DRAIN) { if constexpr (Epi::STAGED) E(acc, cur, wr, wc, fr, fq, ui); else E(acc, cur, wr, wc, fr, fq); S.done(cur); }
        if (!has_next) break;
#pragma unroll
        for (int a = 0; a < 2; ++a)
#pragma unroll
            for (int b = 0; b < 2; ++b)
#pragma unroll
                for (int m = 0; m < 4; ++m)
#pragma unroll
                    for (int n = 0; n < 2; ++n) acc[a][b][m][n] = (f32x4){0.f, 0.f, 0.f, 0.f};
        cur = nxt; cA = nA; cB = nB; ++ui;
        if constexpr (ALIGN_EPI) { if (wr == 1) PG8_BAR; }
    }
    PG8_WAIT_V(0);
    if constexpr (!ALIGN_EPI) { if (wr == 0) PG8_BAR; }
    PG8_BAR;
    if constexpr (Epi::AFTER_DRAIN) { E.fused(acc, cur, wr, wc, fr, fq, lds, wid, lane); S.done(cur); }
#undef PG8_SA
#undef PG8_SB
#undef PG8_STAGE
#undef PG8_LDA
#undef PG8_LDB
#undef PG8_MMA
#undef PG8_WAIT_V
#undef PG8_WAIT_L
#undef PG8_BAR
#undef PG8_SCHED
}
}

constexpr int NWAVES = 8;
constexpr int D = 1024, BATCH = 8, SEQ = 2048, DEPTH = 2, M = BATCH * SEQ, INW = 3584, DFF = 2816, NMOD = 6, NCH = SEQ / 64;
constexpr float EPS = 1e-6f;
constexpr size_t MiB = 1u << 20, KiB = 1u << 10;
constexpr size_t WS_CTL = 0, CTL_ZERO_BYTES = 1 * MiB;
constexpr size_t WS_MOD = 64 * KiB;
constexpr size_t WS_SSUM = 448 * KiB;
constexpr size_t WS_TAB = 1 * MiB;
constexpr size_t WS_SHW1 = WS_TAB + 512 * KiB;
constexpr size_t WS_SHW2 = WS_SHW1 + 2 * 8 * 3584 * 4;
constexpr size_t WS_BL = 3 * MiB;
constexpr size_t WS_W = 4 * MiB;
constexpr size_t W_IN_OFF = 0, W_OUT_OFF = (size_t)INW * D * 2, W_GU_OFF = W_OUT_OFF + (size_t)D * D * 2, W_DN_OFF = W_GU_OFF + (size_t)2 * DFF * D * 2, W_LAYER = W_DN_OFF + (size_t)DFF * D * 2;
constexpr size_t WS_A = 56 * MiB;
constexpr size_t WS_PROJ = 88 * MiB;
constexpr size_t WS_URET = 200 * MiB;
constexpr size_t WS_UHG = 216 * MiB;
constexpr size_t WS_A2 = 200 * MiB;
constexpr size_t WS_END = 248 * MiB;
static_assert(WS_SHW2 + 2 * 8 * 5632 * 4 <= WS_BL && WS_W + 2 * W_LAYER <= WS_A && WS_A + (size_t)M * D * 2 <= WS_PROJ && WS_PROJ + (size_t)M * INW * 2 <= WS_URET, "d_ws map");
static_assert(WS_MOD + 2 * 8 * 6144 * 4 <= WS_SSUM && WS_SSUM + 5 * M * 4 <= CTL_ZERO_BYTES, "ctl map");
constexpr int CW_BAR = 4096;
constexpr int RING_BYTES = 131072;
constexpr int LDSCTL_OFF = RING_BYTES, MISC_OFF = LDSCTL_OFF + 320;
constexpr int STAGE_OFF = RING_BYTES + 4096;
constexpr int LDS_BYTES = 147456;

#define GAS __attribute__((address_space(1)))
#define LAS __attribute__((address_space(3)))
typedef unsigned short bf16;
typedef unsigned v4u __attribute__((ext_vector_type(4)));
typedef unsigned v2u __attribute__((ext_vector_type(2)));
typedef float f32x4 __attribute__((ext_vector_type(4)));
typedef short bf16x8 __attribute__((ext_vector_type(8)));
typedef GAS unsigned gu32;
#define RLX_AGENT __ATOMIC_RELAXED, __HIP_MEMORY_SCOPE_AGENT
#define LDS_WAIT() asm volatile("s_waitcnt lgkmcnt(0)" ::: "memory")
#ifdef NT_P4
#define LD_LAST(p) __builtin_nontemporal_load(p)
#else
#define LD_LAST(p) (*(p))
#endif
#if 1
#define LD_ONCE(p) __builtin_nontemporal_load(p)
#else
#define LD_ONCE(p) (*(p))
#endif
typedef float f32x2_t __attribute__((ext_vector_type(2)));
typedef __bf16 bf16x2_t __attribute__((ext_vector_type(2)));
__device__ __forceinline__ unsigned pk2(float lo, float hi) { const f32x2_t v = {lo, hi}; const bf16x2_t b = __builtin_convertvector(v, bf16x2_t); return __builtin_bit_cast(unsigned, b); }
__device__ __forceinline__ unsigned f2bf(float f) { return (unsigned)__builtin_bit_cast(unsigned short, (__bf16)f); }
__device__ __forceinline__ float bf2f(unsigned short u) { return __builtin_bit_cast(float, (unsigned)u << 16); }
__device__ __forceinline__ float h2f(unsigned short u) { return (float)__builtin_bit_cast(_Float16, u); }
__device__ __forceinline__ float dpp_f(float v, int ctrl_sel) {
    const int x = __builtin_bit_cast(int, v);
    int r;
    if (ctrl_sel == 0) r = __builtin_amdgcn_mov_dpp(x, 0xB1, 0xF, 0xF, true);
    else if (ctrl_sel == 1) r = __builtin_amdgcn_mov_dpp(x, 0x4E, 0xF, 0xF, true);
    else if (ctrl_sel == 2) r = __builtin_amdgcn_mov_dpp(x, 0x141, 0xF, 0xF, true);
    else r = __builtin_amdgcn_mov_dpp(x, 0x140, 0xF, 0xF, true);
    return __builtin_bit_cast(float, r);
}
__device__ __forceinline__ float row16_sum(float v) { v += dpp_f(v, 0); v += dpp_f(v, 1); v += dpp_f(v, 2); v += dpp_f(v, 3); return v; }
__device__ __forceinline__ float wave_sum(float v) {
    v = row16_sum(v);
    const int x = __builtin_bit_cast(int, v);
    return __builtin_bit_cast(float, __builtin_amdgcn_readlane(x, 0)) + __builtin_bit_cast(float, __builtin_amdgcn_readlane(x, 16))
         + __builtin_bit_cast(float, __builtin_amdgcn_readlane(x, 32)) + __builtin_bit_cast(float, __builtin_amdgcn_readlane(x, 48));
}


__device__ __forceinline__ f32x4 mfma16(bf16x8 a, bf16x8 b, f32x4 c) { return __builtin_amdgcn_mfma_f32_16x16x32_bf16(a, b, c, 0, 0, 0); }

struct TrItem { const float* W; bf16* WT; int K, N, item, mode; };
__device__ __forceinline__ void transpose_load(f32x4 (&v)[8], const TrItem& t, int lane) {
    const int nblk = t.N / 32, kb = t.item / nblk, nb = t.item % nblk, k0 = 64 * kb, n0 = 32 * nb;
    const float* src = t.W + (size_t)(k0 + (lane >> 3)) * t.N + n0 + (lane & 7) * 4;
#pragma unroll
    for (int i = 0; i < 8; ++i) v[i] = LD_ONCE((const f32x4*)(src + (size_t)(8 * i) * t.N));
}
__device__ __forceinline__ void transpose_store(const f32x4 (&v)[8], const TrItem& t, LAS float* scr, int lane) {
    const int nblk = t.N / 32, kb = t.item / nblk, nb = t.item % nblk, k0 = 64 * kb, n0 = 32 * nb;
    const int drow = t.mode == 0 ? n0 : (256 * (n0 >> 7) + (n0 & 127) + (t.mode == 2 ? 128 : 0));
#pragma unroll
    for (int i = 0; i < 8; ++i) { LAS float* p = scr + (8 * i + (lane >> 3)) * 33 + (lane & 7) * 4; p[0] = v[i][0]; p[1] = v[i][1]; p[2] = v[i][2]; p[3] = v[i][3]; }
    LDS_WAIT(); asm volatile("" ::: "memory");
    const int c = lane & 7;
#pragma unroll
    for (int j = 0; j < 4; ++j) { const int n = (lane >> 3) + 8 * j; const LAS float* s = scr + (8 * c) * 33 + n;
        v4u o; o.x = pk2(s[0 * 33], s[1 * 33]); o.y = pk2(s[2 * 33], s[3 * 33]); o.z = pk2(s[4 * 33], s[5 * 33]); o.w = pk2(s[6 * 33], s[7 * 33]);
        *(GAS v4u*)(t.WT + (size_t)(drow + n) * t.K + k0 + 8 * c) = o; }
    LDS_WAIT(); asm volatile("" ::: "memory");
}

typedef short v4i16_t __attribute__((ext_vector_type(4)));
__device__ __forceinline__ unsigned off_b(unsigned row, unsigned ch) { return 256u * row + 16u * (ch ^ (((row & 3) << 2) | ((row >> 2) & 3))); }
__device__ __forceinline__ unsigned tr_addr16(unsigned lane, unsigned c, unsigned ks, unsigned t) {
    const unsigned g = lane >> 4, q = (lane & 15) >> 2, p = lane & 3;
    return off_b(32 * ks + 8 * g + 4 * t + q, 2 * c + (p >> 1)) + 8 * (p & 1);
}
__device__ __forceinline__ bf16x8 tr_frag(LAS unsigned char* img, unsigned lane, unsigned c, unsigned ks) {
    const v4i16_t a = __builtin_amdgcn_ds_read_tr16_b64_v4i16((LAS v4i16_t*)(img + tr_addr16(lane, c, ks, 0)));
    const v4i16_t b = __builtin_amdgcn_ds_read_tr16_b64_v4i16((LAS v4i16_t*)(img + tr_addr16(lane, c, ks, 1)));
    return (bf16x8){a[0], a[1], a[2], a[3], b[0], b[1], b[2], b[3]};
}

template <int DK> struct StRegs { v4u k[DK / 64]; v4u v[2]; };
template <int DK, bool RET>
__device__ __forceinline__ void mix_state_load(StRegs<DK>& R, const bf16* proj, int it, int tid) {
    const int b = it >> 7, h = (it >> 5) & 3, c = it & 31;
    const size_t r0 = (size_t)b * 2048 + c * 64;
#pragma unroll
    for (int k = 0; k < 2; ++k) { const bf16* base = proj + (r0 + (tid >> 4) + 32 * k) * 3584 + (tid & 15) * 8 + h * 128;
        R.v[k] = *(const v4u*)(base + (RET ? 512 : 2560));
        if (!RET) R.k[k] = *(const v4u*)(base + 2048); }
    if (RET) R.k[0] = *(const v4u*)(proj + (r0 + (tid >> 3)) * 3584 + 256 + h * 64 + (tid & 7) * 8);
}
template <int DK, bool RET>
__device__ __forceinline__ void mix_state_item(LAS unsigned char* lds, const StRegs<DK>& R, bf16* ST, float* BL, int it, int tid) {
    constexpr int NSEG = 512 / DK, TS = 64 / NSEG;
    const int lane = tid & 63, wave = tid >> 6, d = tid % DK, seg = tid / DK, fr = lane & 15, fq = lane >> 4;
    const int h = (it >> 5) & 3;
    LAS unsigned char* VI = lds; LAS unsigned char* RAW = lds + 16384; LAS unsigned char* KI = lds + 32768; LAS float* TOT = (LAS float*)(lds + 49152);
#pragma unroll
    for (int k = 0; k < 2; ++k) { *(LAS v4u*)(VI + off_b((tid >> 4) + 32 * k, tid & 15)) = R.v[k];
        if (!RET) *(LAS v4u*)(RAW + ((tid >> 4) + 32 * k) * 256 + (tid & 15) * 16) = R.k[k]; }
    if (RET) *(LAS v4u*)(RAW + (tid >> 3) * 128 + (tid & 7) * 16) = R.k[0];
    __syncthreads();
    float kp[TS];
    if (RET) {
        const float lg2 = __log2f(1.f - exp2f(-5.f - (float)h)), gam = 1.f - exp2f(-5.f - (float)h);
        float f = __builtin_amdgcn_exp2f((float)(63 - seg * TS - (TS - 1)) * lg2);
#pragma unroll
        for (int i = TS - 1; i >= 0; --i) { const int t = seg * TS + i; kp[i] = bf2f(*(const LAS unsigned short*)(RAW + t * 128 + d * 2)) * f; f *= gam; }
    } else {
        float g[TS], bs[TS]; float run = 0.f;
#pragma unroll
        for (int i = 0; i < TS; ++i) { g[i] = h2f(*(const LAS unsigned short*)(RAW + (seg * TS + i) * 256 + d * 2)) * 1.44269504089f; run += g[i]; bs[i] = run; }
        TOT[seg * DK + d] = run;
        __syncthreads();
        float pre = 0.f, bl = 0.f;
#pragma unroll
        for (int s2 = 0; s2 < NSEG; ++s2) { const float t = TOT[s2 * DK + d]; bl += t; if (s2 < seg) pre += t; }
#pragma unroll
        for (int i = 0; i < TS; ++i) { const float bb = pre + bs[i]; kp[i] = (1.f - __builtin_amdgcn_exp2f(g[i])) * __builtin_amdgcn_exp2f(bl - bb); }
        if (seg == 0) BL[(size_t)it * 128 + d] = bl;
    }
#pragma unroll
    for (int i = 0; i < TS; i += 2) { const unsigned w = pk2(kp[i], kp[i + 1]);
        *(LAS unsigned short*)(KI + off_b(seg * TS + i, d >> 3) + (d & 7) * 2) = (unsigned short)w; *(LAS unsigned short*)(KI + off_b(seg * TS + i + 1, d >> 3) + (d & 7) * 2) = (unsigned short)(w >> 16); }
    __syncthreads();
    {
        bf16x8 bfr[2];
#pragma unroll
        for (int ks = 0; ks < 2; ++ks) bfr[ks] = tr_frag(VI, lane, wave, ks);
        bf16* dst = ST + (size_t)it * (128 * DK) + (size_t)(16 * wave + fr) * DK + 4 * fq;
#pragma unroll
        for (int dt = 0; dt < DK / 16; ++dt) {
            f32x4 acc = (f32x4){0.f, 0.f, 0.f, 0.f};
#pragma unroll
            for (int ks = 0; ks < 2; ++ks) acc = mfma16(tr_frag(KI, lane, dt, ks), bfr[ks], acc);
            v2u w; w.x = pk2(acc[0], acc[1]); w.y = pk2(acc[2], acc[3]);
            *(v2u*)(dst + 16 * dt) = w;
        }
    }
    __syncthreads();
}

template <int DK> struct OutRegs { v4u q[DK / 64]; v4u g[DK / 64]; v4u v[2]; v4u gate[2]; bf16x8 s[DK / 32]; float nwv; };
template <int DK, bool RET>
__device__ __forceinline__ void mix_out_load(OutRegs<DK>& R, const bf16* proj, const bf16* ST, const float* nw, int it, int tid) {
    const int lane = tid & 63, wave = tid >> 6, fr = lane & 15, fq = lane >> 4;
    const int b = it >> 7, h = (it >> 5) & 3, c = it & 31;
    const size_t r0 = (size_t)b * 2048 + c * 64;
#pragma unroll
    for (int k = 0; k < 2; ++k) { const bf16* base = proj + (r0 + (tid >> 4) + 32 * k) * 3584 + (tid & 15) * 8 + h * 128;
        R.v[k] = LD_LAST((const v4u*)(base + (RET ? 512 : 2560))); R.gate[k] = LD_LAST((const v4u*)(base + (RET ? 1024 : 3072)));
        if (!RET) { R.q[k] = LD_LAST((const v4u*)(base + 1536)); R.g[k] = LD_LAST((const v4u*)(base + 2048)); } }
    if (RET) { const bf16* base = proj + (r0 + (tid >> 3)) * 3584 + h * 64 + (tid & 7) * 8; R.q[0] = LD_LAST((const v4u*)base); R.g[0] = LD_LAST((const v4u*)(base + 256)); }
#pragma unroll
    for (int kd = 0; kd < DK / 32; ++kd) R.s[kd] = *(const bf16x8*)(ST + (size_t)it * (128 * DK) + (size_t)(16 * wave + fr) * DK + 32 * kd + 8 * fq);
    R.nwv = nw[h * 128 + 16 * wave + fr];
}
template <int DK, bool RET>
__device__ __forceinline__ void mix_out_park(LAS unsigned char* lds, const OutRegs<DK>& R, int tid) {
    LAS unsigned char* VI = lds; LAS unsigned char* RAWQ = lds + 16384; LAS unsigned char* RAWG = lds + 32768; LAS float* RED = (LAS float*)(lds + 128000);
#pragma unroll
    for (int k = 0; k < 2; ++k) { *(LAS v4u*)(VI + off_b((tid >> 4) + 32 * k, tid & 15)) = R.v[k];
        if (!RET) { *(LAS v4u*)(RAWQ + ((tid >> 4) + 32 * k) * 256 + (tid & 15) * 16) = R.q[k]; *(LAS v4u*)(RAWG + ((tid >> 4) + 32 * k) * 256 + (tid & 15) * 16) = R.g[k]; } }
    if (RET) { *(LAS v4u*)(RAWQ + (tid >> 3) * 128 + (tid & 7) * 16) = R.q[0]; *(LAS v4u*)(RAWG + (tid >> 3) * 128 + (tid & 7) * 16) = R.g[0]; }
    if (tid < 64) RED[tid] = 0.f;
    __syncthreads();
}
template <int DK, bool RET>
__device__ __forceinline__ void mix_out_item(LAS unsigned char* lds, const v4u (&gate)[2], const bf16x8 (&sfr)[DK / 32], float nwv, bf16* O, int it, int tid, const bf16* DBG_PROJ = nullptr) {
    constexpr int NSEG = 512 / DK, TS = 64 / NSEG, PITCH = DK * 2 + 16, KD = DK / 32, RP = DK * 2;
    const int lane = tid & 63, wave = tid >> 6, d = tid % DK, seg = tid / DK, fr = lane & 15, fq = lane >> 4;
    const int b = it >> 7, h = (it >> 5) & 3, c = it & 31;
    const size_t r0 = (size_t)b * 2048 + c * 64;
    LAS unsigned char* VI = lds; LAS unsigned char* RAWQ = lds + 16384; LAS unsigned char* RAWG = lds + 32768;
    LAS unsigned char* QA = lds + 49152; LAS unsigned char* KC = lds + 66560; LAS unsigned char* QB = lds + 83968; LAS unsigned char* P = lds + 101376;
    LAS float* TOT = (LAS float*)(lds + 101376);
    LAS unsigned char* OT = lds + 110592; LAS float* RED = (LAS float*)(lds + 128000); LAS float* RED2 = (LAS float*)(lds + 128256);
    float qa[TS], kc[TS], qb[TS];
    if (RET) {
        const float lg2 = __log2f(1.f - exp2f(-5.f - (float)h)), gam = 1.f - exp2f(-5.f - (float)h), eref = __builtin_amdgcn_exp2f(32.f * lg2);
        const int tb = seg * TS;
        float fa = __builtin_amdgcn_exp2f((float)(tb - 31) * lg2), fk = __builtin_amdgcn_exp2f((float)(31 - tb - (TS - 1)) * lg2);
#pragma unroll
        for (int i = 0; i < TS; ++i) { const float q = bf2f(*(const LAS unsigned short*)(RAWQ + (tb + i) * RP + d * 2)); qa[i] = q * fa; qb[i] = qa[i] * eref; fa *= gam; }
#pragma unroll
        for (int i = TS - 1; i >= 0; --i) { kc[i] = bf2f(*(const LAS unsigned short*)(RAWG + (tb + i) * RP + d * 2)) * fk; fk *= gam; }
    } else {
        float g[TS], bs[TS], q[TS]; float run = 0.f;
#pragma unroll
        for (int i = 0; i < TS; ++i) { const int t = seg * TS + i; q[i] = bf2f(*(const LAS unsigned short*)(RAWQ + t * RP + d * 2)); g[i] = h2f(*(const LAS unsigned short*)(RAWG + t * RP + d * 2)) * 1.44269504089f; run += g[i]; bs[i] = run; }
        TOT[seg * DK + d] = run;
        __syncthreads();
        float pre = 0.f, ref = 0.f;
#pragma unroll
        for (int s2 = 0; s2 < NSEG; ++s2) { const float t = TOT[s2 * DK + d]; if (s2 < NSEG / 2) ref += t; if (s2 < seg) pre += t; }
        const float eref = __builtin_amdgcn_exp2f(ref);
#pragma unroll
        for (int i = 0; i < TS; ++i) { const float e1 = __builtin_amdgcn_fmed3f(pre + bs[i] - ref, -115.f, 115.f);
            qa[i] = q[i] * __builtin_amdgcn_exp2f(e1); kc[i] = (1.f - __builtin_amdgcn_exp2f(g[i])) * __builtin_amdgcn_exp2f(-e1); qb[i] = qa[i] * eref; }
    }
#pragma unroll
    for (int i = 0; i < TS; i += 2) { const int t = seg * TS + i; const unsigned wa = pk2(qa[i], qa[i + 1]), wk = pk2(kc[i], kc[i + 1]), wb = pk2(qb[i], qb[i + 1]);
        *(LAS unsigned short*)(QA + t * PITCH + d * 2) = (unsigned short)wa; *(LAS unsigned short*)(QA + (t + 1) * PITCH + d * 2) = (unsigned short)(wa >> 16);
        *(LAS unsigned short*)(KC + t * PITCH + d * 2) = (unsigned short)wk; *(LAS unsigned short*)(KC + (t + 1) * PITCH + d * 2) = (unsigned short)(wk >> 16);
        *(LAS unsigned short*)(QB + t * PITCH + d * 2) = (unsigned short)wb; *(LAS unsigned short*)(QB + (t + 1) * PITCH + d * 2) = (unsigned short)(wb >> 16); }
    __syncthreads();
    {
        const int tt = wave & 3, sp = wave >> 2;
#pragma unroll
        for (int hh = 0; hh < 2; ++hh) {
            const int st = 2 * sp + hh;
            f32x4 acc = (f32x4){0.f, 0.f, 0.f, 0.f};
#pragma unroll
            for (int kd = 0; kd < KD; ++kd) { const bf16x8 a = *(const LAS bf16x8*)(KC + (16 * st + fr) * PITCH + (32 * kd + 8 * fq) * 2), bq = *(const LAS bf16x8*)(QA + (16 * tt + fr) * PITCH + (32 * kd + 8 * fq) * 2);
                acc = mfma16(a, bq, acc); }
            const int t = 16 * tt + fr, s0 = 16 * st + 4 * fq;
            const float p0 = (s0 + 0 <= t) ? acc[0] : 0.f, p1 = (s0 + 1 <= t) ? acc[1] : 0.f, p2 = (s0 + 2 <= t) ? acc[2] : 0.f, p3 = (s0 + 3 <= t) ? acc[3] : 0.f;
            v2u w; w.x = pk2(p0, p1); w.y = pk2(p2, p3);
            *(LAS v2u*)(P + t * 144 + s0 * 2) = w;
        }
    }
    __syncthreads();
    f32x4 o[4];
    {
        f32x4 accX[4];
#pragma unroll
        for (int tt = 0; tt < 4; ++tt) { o[tt] = (f32x4){0.f, 0.f, 0.f, 0.f}; accX[tt] = (f32x4){0.f, 0.f, 0.f, 0.f}; }
#pragma unroll
        for (int ks = 0; ks < 2; ++ks) { const bf16x8 bv = tr_frag(VI, lane, wave, ks);
#pragma unroll
            for (int tt = 0; tt < 4; ++tt) { const bf16x8 a = *(const LAS bf16x8*)(P + (16 * tt + fr) * 144 + (32 * ks + 8 * fq) * 2); o[tt] = mfma16(a, bv, o[tt]); } }
#pragma unroll
        for (int kd = 0; kd < KD; ++kd)
#pragma unroll
            for (int tt = 0; tt < 4; ++tt) { const bf16x8 a = *(const LAS bf16x8*)(QB + (16 * tt + fr) * PITCH + (32 * kd + 8 * fq) * 2); accX[tt] = mfma16(a, sfr[kd], accX[tt]); }
#pragma unroll
        for (int tt = 0; tt < 4; ++tt) o[tt] = o[tt] + accX[tt];
    }
#pragma unroll
    for (int tt = 0; tt < 4; ++tt)
#pragma unroll
        for (int r = 0; r < 4; ++r) { float s = row16_sum(o[tt][r] * o[tt][r]);
#ifdef RED_ATOMIC
            if (fr == 0) __hip_atomic_fetch_add(RED + 16 * tt + 4 * fq + r, s, __ATOMIC_RELAXED, __HIP_MEMORY_SCOPE_WORKGROUP); }
    __syncthreads();
#else
            if (fr == 0) RED2[wave * 64 + 16 * tt + 4 * fq + r] = s; }
    __syncthreads();
    if (tid < 64) { float s = 0.f;
#pragma unroll
        for (int w = 0; w < 8; ++w) s += RED2[w * 64 + tid];
        RED[tid] = s; }
    __syncthreads();
#endif
#pragma unroll
    for (int tt = 0; tt < 4; ++tt)
#pragma unroll
        for (int r = 0; r < 4; r += 2) { const int t = 16 * tt + 4 * fq + r; const float rs0 = __builtin_amdgcn_rsqf(RED[t] * (1.f / 128.f) + EPS), rs1 = __builtin_amdgcn_rsqf(RED[t + 1] * (1.f / 128.f) + EPS);
            const unsigned w = pk2(o[tt][r] * rs0 * nwv, o[tt][r + 1] * rs1 * nwv);
            *(LAS unsigned short*)(OT + t * 272 + (16 * wave + fr) * 2) = (unsigned short)w; *(LAS unsigned short*)(OT + (t + 1) * 272 + (16 * wave + fr) * 2) = (unsigned short)(w >> 16); }
    __syncthreads();
    {
        const int ocol = (RET ? 0 : 512) + h * 128;
#pragma unroll
        for (int k = 0; k < 2; ++k) { const int row = (tid >> 4) + 32 * k, ch = tid & 15;
            const v4u ov = *(const LAS v4u*)(OT + row * 272 + ch * 16); const v4u gv = gate[k];
            const unsigned oo[4] = {ov.x, ov.y, ov.z, ov.w}, gg[4] = {gv.x, gv.y, gv.z, gv.w}; unsigned w[4];
#pragma unroll
            for (int e = 0; e < 4; ++e) w[e] = pk2(__builtin_bit_cast(float, oo[e] << 16) * __builtin_bit_cast(float, gg[e] << 16), __builtin_bit_cast(float, oo[e] & 0xffff0000u) * __builtin_bit_cast(float, gg[e] & 0xffff0000u));
            v4u wv; wv.x = w[0]; wv.y = w[1]; wv.z = w[2]; wv.w = w[3];
            *(v4u*)(O + (r0 + row) * 1024 + ocol + ch * 8) = wv; }
    }
}

template <int DK, bool RET>
__device__ __forceinline__ void mix_state_loop(LAS unsigned char* lds, const bf16* proj, bf16* ST, float* BL, int first, int step, int end, int tid_in) {
    int tid = tid_in; asm volatile("" : "+v"(tid));
    if (first >= end) return;
    StRegs<DK> cur; mix_state_load<DK, RET>(cur, proj, first, tid);
    for (int it = first; it < end; it += step) {
        StRegs<DK> nxt = cur;
        const bool more = it + step < end;
        if (more) mix_state_load<DK, RET>(nxt, proj, it + step, tid);
        mix_state_item<DK, RET>(lds, cur, ST, BL, it, tid);
        cur = nxt;
    }
}
template <int DK, bool RET>
__device__ __forceinline__ void mix_out_loop(LAS unsigned char* lds, const bf16* proj, const bf16* ST, const float* nw, bf16* O, int first, int step, int tid_in) {
    int tid = tid_in; asm volatile("" : "+v"(tid));
    if (first >= 1024) return;
    OutRegs<DK> cur; mix_out_load<DK, RET>(cur, proj, ST, nw, first, tid);
    for (int it = first; it < 1024; it += step) {
        mix_out_park<DK, RET>(lds, cur, tid);
        const v4u gate[2] = {cur.gate[0], cur.gate[1]}; bf16x8 sfr[DK / 32]; const float nwv = cur.nwv;
#pragma unroll
        for (int kd = 0; kd < DK / 32; ++kd) sfr[kd] = cur.s[kd];
#ifndef NO_PREFETCH
        if (it + step < 1024) mix_out_load<DK, RET>(cur, proj, ST, nw, it + step, tid);
#endif
        mix_out_item<DK, RET>(lds, gate, sfr, nwv, O, it, tid, proj);
#ifdef DUP_P4C
        __syncthreads(); if (tid < 64) ((LAS float*)(lds + 128000))[tid] = 0.f; __syncthreads();
        mix_out_item<DK, RET>(lds, gate, sfr, nwv, O, it, tid, proj);
#endif
#ifdef NO_PREFETCH
        __syncthreads();
        if (it + step < 1024) mix_out_load<DK, RET>(cur, proj, ST, nw, it + step, tid);
#endif
    }
}

#ifdef MIX_CHAIN
__device__ __forceinline__ void mix_state_both(LAS unsigned char* lds, const bf16* proj, bf16* STH, bf16* STR, float* BL, int first, int step, int end, int tid_in) {
    int tid = tid_in; asm volatile("" : "+v"(tid));
    if (first >= end) return;
    StRegs<128> ch; mix_state_load<128, false>(ch, proj, first, tid);
    StRegs<64> cr;
    for (int it = first; it < end; it += step) {
        StRegs<128> nxt = ch;
        if (it + step < end) mix_state_load<128, false>(nxt, proj, it + step, tid); else mix_state_load<64, true>(cr, proj, first, tid);
        mix_state_item<128, false>(lds, ch, STH, BL, it, tid);
        ch = nxt;
    }
    for (int it = first; it < end; it += step) {
        StRegs<64> nxt = cr;
        if (it + step < end) mix_state_load<64, true>(nxt, proj, it + step, tid);
        mix_state_item<64, true>(lds, cr, STR, BL, it, tid);
        cr = nxt;
    }
}
__device__ __forceinline__ void mix_out_both(LAS unsigned char* lds, const bf16* proj, const bf16* STH, const bf16* STR, const float* nwH, const float* nwR, bf16* O, int first, int step, int tid_in) {
    int tid = tid_in; asm volatile("" : "+v"(tid));
    if (first >= 1024) return;
    OutRegs<128> ch; mix_out_load<128, false>(ch, proj, STH, nwH, first, tid);
    OutRegs<64> cr;
    for (int it = first; it < 1024; it += step) {
        mix_out_park<128, false>(lds, ch, tid);
        const v4u gate[2] = {ch.gate[0], ch.gate[1]}; bf16x8 sfr[4]; const float nwv = ch.nwv;
#pragma unroll
        for (int kd = 0; kd < 4; ++kd) sfr[kd] = ch.s[kd];
        if (it + step < 1024) mix_out_load<128, false>(ch, proj, STH, nwH, it + step, tid); else mix_out_load<64, true>(cr, proj, STR, nwR, first, tid);
        mix_out_item<128, false>(lds, gate, sfr, nwv, O, it, tid, proj);
    }
    for (int it = first; it < 1024; it += step) {
        mix_out_park<64, true>(lds, cr, tid);
        const v4u gate[2] = {cr.gate[0], cr.gate[1]}; bf16x8 sfr[2]; const float nwv = cr.nwv;
#pragma unroll
        for (int kd = 0; kd < 2; ++kd) sfr[kd] = cr.s[kd];
        if (it + step < 1024) mix_out_load<64, true>(cr, proj, STR, nwR, it + step, tid);
        mix_out_item<64, true>(lds, gate, sfr, nwv, O, it, tid, proj);
    }
}
#endif

template <int DK, bool RET>
__device__ __forceinline__ void mix_state_item_v1(LAS unsigned char* lds, const bf16* proj, bf16* ST, float* BL, int it, int tid_in) {
    int tid = tid_in; asm volatile("" : "+v"(tid));
    constexpr int NSEG = 512 / DK, TS = 64 / NSEG;
    const int lane = tid & 63, wave = tid >> 6, d = tid % DK, seg = tid / DK;
    const int b = it >> 7, h = (it >> 5) & 3, c = it & 31;
    const size_t r0 = (size_t)b * 2048 + c * 64;
    LAS unsigned char* KT = lds; LAS unsigned char* VT = lds + 18432; LAS float* TOT = (LAS float*)(lds + 36864);
    {
        const int j = tid & 127, sg = tid >> 7;
        const bf16* src = proj + (r0 + 16 * sg) * 3584 + (RET ? 512 : 2560) + h * 128 + j;
        unsigned vv[16];
#pragma unroll
        for (int i = 0; i < 16; ++i) vv[i] = src[(size_t)i * 3584];
        v4u w0, w1; w0.x = vv[0] | (vv[1] << 16); w0.y = vv[2] | (vv[3] << 16); w0.z = vv[4] | (vv[5] << 16); w0.w = vv[6] | (vv[7] << 16);
        w1.x = vv[8] | (vv[9] << 16); w1.y = vv[10] | (vv[11] << 16); w1.z = vv[12] | (vv[13] << 16); w1.w = vv[14] | (vv[15] << 16);
        *(LAS v4u*)(VT + j * 144 + sg * 32) = w0; *(LAS v4u*)(VT + j * 144 + sg * 32 + 16) = w1;
    }
    float kp[TS];
    if (RET) {
        const float lg = __logf(1.f - exp2f(-5.f - (float)h));
        const bf16* src = proj + (r0 + seg * TS) * 3584 + 256 + h * 64 + d;
#pragma unroll
        for (int i = 0; i < TS; ++i) { const int t = seg * TS + i; kp[i] = bf2f(src[(size_t)i * 3584]) * __expf((float)(63 - t) * lg); }
    } else {
        const bf16* src = proj + (r0 + seg * TS) * 3584 + 2048 + h * 128 + d;
        float g[TS], bs[TS]; float run = 0.f;
#pragma unroll
        for (int i = 0; i < TS; ++i) { g[i] = h2f(src[(size_t)i * 3584]); run += g[i]; bs[i] = run; }
        TOT[seg * DK + d] = run;
        __syncthreads();
        float pre = 0.f, bl = 0.f;
#pragma unroll
        for (int s2 = 0; s2 < NSEG; ++s2) { const float t = TOT[s2 * DK + d]; bl += t; if (s2 < seg) pre += t; }
#pragma unroll
        for (int i = 0; i < TS; ++i) { const float bb = pre + bs[i]; kp[i] = (1.f - __expf(g[i])) * __expf(bl - bb); }
        if (seg == 0) BL[(size_t)it * 128 + d] = bl;
    }
    {
        unsigned pw[TS / 2];
#pragma unroll
        for (int i = 0; i < TS / 2; ++i) pw[i] = pk2(kp[2 * i], kp[2 * i + 1]);
#pragma unroll
        for (int i = 0; i < TS / 8; ++i) { v4u w; w.x = pw[4 * i]; w.y = pw[4 * i + 1]; w.z = pw[4 * i + 2]; w.w = pw[4 * i + 3]; *(LAS v4u*)(KT + d * 144 + seg * TS * 2 + 16 * i) = w; }
    }
    __syncthreads();
    {
        const int fr = lane & 15, fq = lane >> 4;
        bf16x8 bfr[2];
#pragma unroll
        for (int ks = 0; ks < 2; ++ks) bfr[ks] = *(const LAS bf16x8*)(VT + (16 * wave + fr) * 144 + (32 * ks + 8 * fq) * 2);
        bf16* dst = ST + (size_t)it * (128 * DK) + (size_t)(16 * wave + fr) * DK + 4 * fq;
#pragma unroll
        for (int dt = 0; dt < DK / 16; ++dt) {
            f32x4 acc = (f32x4){0.f, 0.f, 0.f, 0.f};
#pragma unroll
            for (int ks = 0; ks < 2; ++ks) { const bf16x8 a = *(const LAS bf16x8*)(KT + (16 * dt + fr) * 144 + (32 * ks + 8 * fq) * 2); acc = mfma16(a, bfr[ks], acc); }
            v2u w; w.x = pk2(acc[0], acc[1]); w.y = pk2(acc[2], acc[3]);
            *(v2u*)(dst + 16 * dt) = w;
        }
    }
    __syncthreads();
}

template <int DK, bool RET>
__device__ __forceinline__ void mix_out_item_v1(LAS unsigned char* lds, const bf16* proj, const bf16* ST, const float* nw, bf16* O, int it, int tid_in) {
    int tid = tid_in; asm volatile("" : "+v"(tid));
    constexpr int NSEG = 512 / DK, TS = 64 / NSEG, PITCH = DK * 2 + 16, KD = DK / 32;
    const int lane = tid & 63, wave = tid >> 6, d = tid % DK, seg = tid / DK, fr = lane & 15, fq = lane >> 4;
    const int tt = wave & 3, jh = wave >> 2;
    const int b = it >> 7, h = (it >> 5) & 3, c = it & 31;
    const size_t r0 = (size_t)b * 2048 + c * 64;
    LAS unsigned char* QA = lds; LAS unsigned char* KC = lds + 17408; LAS unsigned char* QB = lds + 34816; LAS unsigned char* VT = lds + 52224; LAS unsigned char* P = lds + 70656;
    LAS float* TOT = (LAS float*)(lds + 79872); LAS float* RED = (LAS float*)(lds + 83968);
    bf16x8 sfr[4][KD];
#pragma unroll
    for (int jt = 0; jt < 4; ++jt)
#pragma unroll
        for (int kd = 0; kd < KD; ++kd) sfr[jt][kd] = *(const bf16x8*)(ST + (size_t)it * (128 * DK) + (size_t)(64 * jh + 16 * jt + fr) * DK + 32 * kd + 8 * fq);
    {
        const int j = tid & 127, sg = tid >> 7;
        const bf16* src = proj + (r0 + 16 * sg) * 3584 + (RET ? 512 : 2560) + h * 128 + j;
        unsigned vv[16];
#pragma unroll
        for (int i = 0; i < 16; ++i) vv[i] = src[(size_t)i * 3584];
        v4u w0, w1; w0.x = vv[0] | (vv[1] << 16); w0.y = vv[2] | (vv[3] << 16); w0.z = vv[4] | (vv[5] << 16); w0.w = vv[6] | (vv[7] << 16);
        w1.x = vv[8] | (vv[9] << 16); w1.y = vv[10] | (vv[11] << 16); w1.z = vv[12] | (vv[13] << 16); w1.w = vv[14] | (vv[15] << 16);
        *(LAS v4u*)(VT + j * 144 + sg * 32) = w0; *(LAS v4u*)(VT + j * 144 + sg * 32 + 16) = w1;
    }
    float qa[TS], kc[TS], qb[TS];
    if (RET) {
        const float lg = __logf(1.f - exp2f(-5.f - (float)h));
        const bf16* qs = proj + (r0 + seg * TS) * 3584 + h * 64 + d;
#pragma unroll
        for (int i = 0; i < TS; ++i) { const int t = seg * TS + i; const float q = bf2f(qs[(size_t)i * 3584]), k = bf2f(qs[(size_t)i * 3584 + 256]);
            qa[i] = q * __expf((float)(t - 31) * lg); kc[i] = k * __expf((float)(31 - t) * lg); qb[i] = q * __expf((float)(t + 1) * lg); }
    } else {
        const bf16* src = proj + (r0 + seg * TS) * 3584 + 1536 + h * 128 + d;
        float g[TS], bs[TS], q[TS]; float run = 0.f;
#pragma unroll
        for (int i = 0; i < TS; ++i) { q[i] = bf2f(src[(size_t)i * 3584]); g[i] = h2f(src[(size_t)i * 3584 + 512]); run += g[i]; bs[i] = run; }
        TOT[seg * DK + d] = run;
        __syncthreads();
        float pre = 0.f, ref = 0.f;
#pragma unroll
        for (int s2 = 0; s2 < NSEG; ++s2) { const float t = TOT[s2 * DK + d]; if (s2 < NSEG / 2) ref += t; if (s2 < seg) pre += t; }
#pragma unroll
        for (int i = 0; i < TS; ++i) { const float bb = pre + bs[i]; const float e1 = fminf(fmaxf(bb - ref, -80.f), 80.f);
            qa[i] = q[i] * __expf(e1); kc[i] = (1.f - __expf(g[i])) * __expf(-e1); qb[i] = q[i] * __expf(bb); }
    }
#pragma unroll
    for (int i = 0; i < TS; ++i) { const int t = seg * TS + i;
        *(LAS unsigned short*)(QA + t * PITCH + d * 2) = (unsigned short)f2bf(qa[i]);
        *(LAS unsigned short*)(KC + t * PITCH + d * 2) = (unsigned short)f2bf(kc[i]);
        *(LAS unsigned short*)(QB + t * PITCH + d * 2) = (unsigned short)f2bf(qb[i]); }
    __syncthreads();
#pragma unroll
    for (int hh = 0; hh < 2; ++hh) {
        const int st = 2 * jh + hh;
        f32x4 acc = (f32x4){0.f, 0.f, 0.f, 0.f};
#pragma unroll
        for (int kd = 0; kd < KD; ++kd) { const bf16x8 a = *(const LAS bf16x8*)(KC + (16 * st + fr) * PITCH + (32 * kd + 8 * fq) * 2), bq = *(const LAS bf16x8*)(QA + (16 * tt + fr) * PITCH + (32 * kd + 8 * fq) * 2);
            acc = mfma16(a, bq, acc); }
        const int t = 16 * tt + fr, s0 = 16 * st + 4 * fq;
        const float p0 = (s0 + 0 <= t) ? acc[0] : 0.f, p1 = (s0 + 1 <= t) ? acc[1] : 0.f, p2 = (s0 + 2 <= t) ? acc[2] : 0.f, p3 = (s0 + 3 <= t) ? acc[3] : 0.f;
        v2u w; w.x = pk2(p0, p1); w.y = pk2(p2, p3);
        *(LAS v2u*)(P + t * 144 + s0 * 2) = w;
    }
    __syncthreads();
    f32x4 o[4];
    {
        f32x4 accI[4], accX[4];
#pragma unroll
        for (int jt = 0; jt < 4; ++jt) { accI[jt] = (f32x4){0.f, 0.f, 0.f, 0.f}; accX[jt] = (f32x4){0.f, 0.f, 0.f, 0.f}; }
#pragma unroll
        for (int ks = 0; ks < 2; ++ks) { const bf16x8 a = *(const LAS bf16x8*)(P + (16 * tt + fr) * 144 + (32 * ks + 8 * fq) * 2);
#pragma unroll
            for (int jt = 0; jt < 4; ++jt) { const bf16x8 bv = *(const LAS bf16x8*)(VT + (64 * jh + 16 * jt + fr) * 144 + (32 * ks + 8 * fq) * 2); accI[jt] = mfma16(a, bv, accI[jt]); } }
#pragma unroll
        for (int kd = 0; kd < KD; ++kd) { const bf16x8 a = *(const LAS bf16x8*)(QB + (16 * tt + fr) * PITCH + (32 * kd + 8 * fq) * 2);
#pragma unroll
            for (int jt = 0; jt < 4; ++jt) accX[jt] = mfma16(a, sfr[jt][kd], accX[jt]); }
#pragma unroll
        for (int jt = 0; jt < 4; ++jt) o[jt] = accI[jt] + accX[jt];
    }
    {
        float part[4];
#pragma unroll
        for (int r = 0; r < 4; ++r) { float s = 0.f;
#pragma unroll
            for (int jt = 0; jt < 4; ++jt) s += o[jt][r] * o[jt][r];
            part[r] = row16_sum(s); }
        if (fr == 0) {
#pragma unroll
            for (int r = 0; r < 4; ++r) RED[jh * 64 + 16 * tt + 4 * fq + r] = part[r];
        }
    }
    __syncthreads();
    {
        const int gcol = (RET ? 1024 : 3072) + h * 128, ocol = (RET ? 0 : 512) + h * 128;
        float rs[4];
#pragma unroll
        for (int r = 0; r < 4; ++r) { const int t = 16 * tt + 4 * fq + r; rs[r] = rsqrtf((RED[t] + RED[64 + t]) * (1.f / 128.f) + EPS); }
#pragma unroll
        for (int jt = 0; jt < 4; ++jt) { const int j = 64 * jh + 16 * jt + fr; const float wj = nw[h * 128 + j];
#pragma unroll
            for (int r = 0; r < 4; ++r) { const size_t row = r0 + 16 * tt + 4 * fq + r; const float gate = bf2f(proj[row * 3584 + gcol + j]);
                O[row * 1024 + ocol + j] = (bf16)f2bf(o[jt][r] * rs[r] * wj * gate); } }
    }
    __syncthreads();
}


#ifndef GEMM_SP2
#define GEMM_SP2 true
#endif
#ifndef GEMM_ALIGN
#define GEMM_ALIGN true
#endif
constexpr int I_IN = 16 * 112, I_OUT = 16 * 32, I_G = 16 * 88, I_DN = 44 * 32, I_LAYER = I_IN + I_OUT + 2 * I_G + I_DN;
#define TR_DECODE(T, IT) do { const int l_ = (IT) / I_LAYER; int r_ = (IT) % I_LAYER; bf16* Wl_ = (bf16*)(ws + WS_W + (size_t)l_ * W_LAYER); \
    if (r_ < I_IN) { T.W = w_in + (size_t)l_ * D * INW; T.WT = Wl_ + W_IN_OFF / 2; T.K = D; T.N = INW; T.item = r_; T.mode = 0; } \
    else if (r_ < I_IN + I_OUT) { T.W = w_out + (size_t)l_ * D * D; T.WT = Wl_ + W_OUT_OFF / 2; T.K = D; T.N = D; T.item = r_ - I_IN; T.mode = 0; } \
    else if (r_ < I_IN + I_OUT + I_G) { T.W = w_gate + (size_t)l_ * D * DFF; T.WT = Wl_ + W_GU_OFF / 2; T.K = D; T.N = DFF; T.item = r_ - I_IN - I_OUT; T.mode = 1; } \
    else if (r_ < I_IN + I_OUT + 2 * I_G) { T.W = w_up + (size_t)l_ * D * DFF; T.WT = Wl_ + W_GU_OFF / 2; T.K = D; T.N = DFF; T.item = r_ - I_IN - I_OUT - I_G; T.mode = 2; } \
    else { T.W = w_down + (size_t)l_ * DFF * D; T.WT = Wl_ + W_DN_OFF / 2; T.K = DFF; T.N = D; T.item = r_ - I_IN - I_OUT - 2 * I_G; T.mode = 0; } } while (0)
#define TRANSPOSE_RANGE(IT0, IT1, WIDX, NW) do { LAS float* scr_ = (LAS float*)(lds + wave * 16384); int it_ = (IT0) + (WIDX); \
    if (it_ < (IT1)) { TrItem cur_; TR_DECODE(cur_, it_); f32x4 v_[8]; transpose_load(v_, cur_, lane); \
        for (;;) { const int nx_ = it_ + (NW); const bool more_ = nx_ < (IT1); TrItem nt_ = cur_; f32x4 vn_[8]; \
            if (more_) { TR_DECODE(nt_, nx_); transpose_load(vn_, nt_, lane); } \
            transpose_store(v_, cur_, scr_, lane); \
            if (!more_) break; \
            cur_ = nt_; it_ = nx_; \
            _Pragma("unroll") for (int i_ = 0; i_ < 8; ++i_) v_[i_] = vn_[i_]; } } } while (0)
#define TRANSPOSE_RANGE_SIMPLE(IT0, IT1, WIDX, NW) do { LAS float* scr_ = (LAS float*)(lds + wave * 16384); \
    for (int it_ = (IT0) + (WIDX); it_ < (IT1); it_ += (NW)) { TrItem cur_; TR_DECODE(cur_, it_); f32x4 v_[8]; transpose_load(v_, cur_, lane); transpose_store(v_, cur_, scr_, lane); } } while (0)
#ifndef SHW_MFMA
#define SHW_RANGE(R0, R1, WIDX, NW) do { LAS float* shl_ = (LAS float*)lds; __syncthreads(); \
    for (int i_ = tid; i_ < 4 * BATCH * (D / 4); i_ += NWAVES * 64) { const int grp_ = i_ >> 11, rem_ = i_ & 2047, b_ = rem_ >> 8, c4_ = rem_ & 255; \
        *(LAS f32x4*)(shl_ + (size_t)i_ * 4) = *(const f32x4*)(MOD + ((size_t)(grp_ >> 1) * BATCH + b_) * (NMOD * D) + ((grp_ & 1) ? 3 * D : 0) + c4_ * 4); } \
    __syncthreads(); \
    for (int rb_ = (R0) + (WIDX); rb_ < (R1); rb_ += 2 * (NW)) { bf16x8 w0_[2], w1_[2]; \
        _Pragma("unroll") for (int i_ = 0; i_ < 2; ++i_) { const int r_ = rb_ + i_ * (NW); if (r_ < (R1)) { const int l_ = r_ / 9216, rr_ = r_ % 9216, type_ = rr_ >= INW ? 1 : 0, np_ = type_ ? rr_ - INW : rr_; \
            const bf16* wrow_ = (const bf16*)(ws + WS_W + (size_t)l_ * W_LAYER + (type_ ? W_GU_OFF : W_IN_OFF)) + (size_t)np_ * D; \
            w0_[i_] = *(const bf16x8*)(wrow_ + 8 * lane); w1_[i_] = *(const bf16x8*)(wrow_ + 512 + 8 * lane); } } \
        _Pragma("unroll") for (int i_ = 0; i_ < 2; ++i_) { const int r_ = rb_ + i_ * (NW); if (r_ < (R1)) { const int l_ = r_ / 9216, rr_ = r_ % 9216, type_ = rr_ >= INW ? 1 : 0, np_ = type_ ? rr_ - INW : rr_; \
            float wf_[16]; \
            _Pragma("unroll") for (int j_ = 0; j_ < 8; ++j_) { wf_[j_] = bf2f((unsigned short)w0_[i_][j_]); wf_[8 + j_] = bf2f((unsigned short)w1_[i_][j_]); } \
            float keep_ = 0.f; \
            _Pragma("unroll") for (int b_ = 0; b_ < BATCH; ++b_) { const LAS float* sh_ = shl_ + ((l_ * 2 + type_) * BATCH + b_) * D; \
                const f32x4 a0_ = *(const LAS f32x4*)(sh_ + 8 * lane), a1_ = *(const LAS f32x4*)(sh_ + 8 * lane + 4), a2_ = *(const LAS f32x4*)(sh_ + 512 + 8 * lane), a3_ = *(const LAS f32x4*)(sh_ + 512 + 8 * lane + 4); \
                float s_ = wf_[0] * a0_[0] + wf_[1] * a0_[1] + wf_[2] * a0_[2] + wf_[3] * a0_[3] + wf_[4] * a1_[0] + wf_[5] * a1_[1] + wf_[6] * a1_[2] + wf_[7] * a1_[3] \
                         + wf_[8] * a2_[0] + wf_[9] * a2_[1] + wf_[10] * a2_[2] + wf_[11] * a2_[3] + wf_[12] * a3_[0] + wf_[13] * a3_[1] + wf_[14] * a3_[2] + wf_[15] * a3_[3]; \
                s_ = wave_sum(s_); if (lane == b_) keep_ = s_; } \
            if (lane < BATCH) { if (type_) SHW2[((size_t)l_ * BATCH + lane) * 5632 + np_] = keep_; else SHW1[((size_t)l_ * BATCH + lane) * INW + np_] = keep_; } } } } } while (0)
#endif
#define SHW_MFMA_ALL() do { __syncthreads(); \
    for (int i_ = tid; i_ < 4 * BATCH * 128; i_ += NWAVES * 64) { const int grp_ = i_ >> 10, b_ = (i_ >> 7) & 7, ch_ = i_ & 127; \
        const float* src_ = MOD + ((size_t)(grp_ >> 1) * BATCH + b_) * (NMOD * D) + ((grp_ & 1) ? 3 * D : 0) + ch_ * 8; \
        const f32x4 a_ = *(const f32x4*)src_, c_ = *(const f32x4*)(src_ + 4); \
        v4u hi_, lo_; hi_.x = pk2(a_[0], a_[1]); hi_.y = pk2(a_[2], a_[3]); hi_.z = pk2(c_[0], c_[1]); hi_.w = pk2(c_[2], c_[3]); \
        lo_.x = pk2(a_[0] - __builtin_bit_cast(float, hi_.x << 16), a_[1] - __builtin_bit_cast(float, hi_.x & 0xffff0000u)); lo_.y = pk2(a_[2] - __builtin_bit_cast(float, hi_.y << 16), a_[3] - __builtin_bit_cast(float, hi_.y & 0xffff0000u)); \
        lo_.z = pk2(c_[0] - __builtin_bit_cast(float, hi_.z << 16), c_[1] - __builtin_bit_cast(float, hi_.z & 0xffff0000u)); lo_.w = pk2(c_[2] - __builtin_bit_cast(float, hi_.w << 16), c_[3] - __builtin_bit_cast(float, hi_.w & 0xffff0000u)); \
        *(LAS v4u*)(lds + grp_ * 32768 + b_ * 2048 + ((ch_ ^ b_) << 4)) = hi_; *(LAS v4u*)(lds + grp_ * 32768 + (8 + b_) * 2048 + ((ch_ ^ (8 + b_)) << 4)) = lo_; } \
    __syncthreads(); \
    for (int it_ = wave * G + vcu; it_ < DEPTH * 9216 / 16; it_ += NWAVES * G) { \
        const int r0_ = it_ * 16, l_ = r0_ / 9216, rr_ = r0_ % 9216, type_ = rr_ >= INW ? 1 : 0, np0_ = type_ ? rr_ - INW : rr_, fr_ = lane & 15, fq_ = lane >> 4; \
        const bf16* wrow_ = (const bf16*)(ws + WS_W + (size_t)l_ * W_LAYER + (type_ ? W_GU_OFF : W_IN_OFF)) + (size_t)(np0_ + fr_) * D + 8 * fq_; \
        LAS unsigned char* ab_ = lds + (l_ * 2 + type_) * 32768 + fr_ * 2048; \
        f32x4 c_ = {0.f, 0.f, 0.f, 0.f}; \
        { bf16x8 bw_[32];                                     \
            _Pragma("unroll") for (int j_ = 0; j_ < 32; ++j_) bw_[j_] = *(const bf16x8*)(wrow_ + j_ * 32); \
            _Pragma("unroll") for (int j_ = 0; j_ < 32; ++j_) { const int ch_ = 4 * j_ + fq_; c_ = mfma16(*(const LAS bf16x8*)(ab_ + ((ch_ ^ fr_) << 4)), bw_[j_], c_); } } \
        _Pragma("unroll") for (int r_ = 0; r_ < 4; ++r_) { const float t_ = c_[r_] + __shfl_xor(c_[r_], 32); \
            if (lane < 32) { const int bt_ = 4 * fq_ + r_; if (type_) SHW2[((size_t)l_ * BATCH + bt_) * 5632 + np0_ + fr_] = t_; else SHW1[((size_t)l_ * BATCH + bt_) * INW + np0_ + fr_] = t_; } } } } while (0)
#ifndef A0_ROWS
#define A0_ROWS 8
#endif
struct Args { const float* in[15]; float* out; unsigned char* ws; };
__global__ void __launch_bounds__(NWAVES * 64, 2) fwd_kernel(Args args) {
    extern __shared__ __attribute__((aligned(16))) unsigned char lds_raw[];
    LAS unsigned char* lds = (LAS unsigned char*)lds_raw;
    volatile LAS unsigned* MISC = (volatile LAS unsigned*)(lds + MISC_OFF);
    const int tid = threadIdx.x, lane = tid & 63, wave = __builtin_amdgcn_readfirstlane(tid >> 6);
    const int G = gridDim.x, bx = blockIdx.x;
    const int vcu = (G % 8 == 0) ? (bx % 8) * (G / 8) + bx / 8 : bx;
    const int gw = vcu * NWAVES + wave, NGW = G * NWAVES;
    unsigned char* ws = args.ws;
    const float* x = args.in[0]; const float* cvec = args.in[1]; const float* w_ada = args.in[2]; const float* b_ada = args.in[3];
    const float* norm_mix_w = args.in[4]; const float* w_in = args.in[5]; const float* ret_norm_w = args.in[6]; const float* hg_lb = args.in[7];
    const float* hg_norm_w = args.in[8]; const float* w_out = args.in[9]; const float* norm_ffn_w = args.in[10]; const float* w_gate = args.in[11];
    const float* w_up = args.in[12]; const float* w_down = args.in[13]; const float* final_w = args.in[14];
    float* out = args.out; bf16* X16 = (bf16*)args.out;
    gu32* ctl = (gu32*)(ws + WS_CTL);
    float* MOD = (float*)(ws + WS_MOD); float* SSUM = (float*)(ws + WS_SSUM); float2* TAB = (float2*)(ws + WS_TAB);
    float* SHW1 = (float*)(ws + WS_SHW1); float* SHW2 = (float*)(ws + WS_SHW2); float* BL = (float*)(ws + WS_BL);
    bf16* ABUF = (bf16*)(ws + WS_A); bf16* PROJ = (bf16*)(ws + WS_PROJ); bf16* URET = (bf16*)(ws + WS_URET); bf16* UHG = (bf16*)(ws + WS_UHG); bf16* A2 = (bf16*)(ws + WS_A2);

    for (int u = tid; u < (LDS_BYTES - LDSCTL_OFF) / 4; u += NWAVES * 64) ((LAS unsigned*)(lds + LDSCTL_OFF))[u] = 0u;
    __syncthreads();
    XcdBarrier bar = xcd_barrier_post((unsigned*)(ctl + CW_BAR), MISC + 8);
#ifdef PROBE_A
    unsigned long long tprev = __builtin_amdgcn_s_memrealtime(); float TA = 0.f, TB = 0.f; int pidx = 0;
#define GRID_BAR() do { xcd_barrier(bar); const unsigned long long tn = __builtin_amdgcn_s_memrealtime(); const float dt = (float)(tn - tprev) * 0.01f; if ((PROBE_A >> pidx) & 1) TA += dt; if ((PROBE_B >> pidx) & 1) TB += dt; tprev = tn; ++pidx; } while (0)
#else
#ifdef DUP_BAR
#define GRID_BAR() do { xcd_barrier(bar); xcd_barrier(bar); } while (0)
#else
#define GRID_BAR() xcd_barrier(bar)
#endif
#endif

    {
        LAS float* cs = (LAS float*)lds;
#ifdef ADA_CS8
        for (int i = tid; i < BATCH * D; i += NWAVES * 64) cs[(i & (D - 1)) * BATCH + (i >> 10)] = pg8::silu_f(cvec[i]);
#else
        for (int i = tid; i < BATCH * D; i += NWAVES * 64) cs[i] = pg8::silu_f(cvec[i]);
#endif
        __syncthreads();
#ifdef DUP_ADA
        for (int rep_ = 0; rep_ < 2; ++rep_)
#else
        const int rep_ = 1;
#endif
        for (int uidx = vcu; uidx < 240; uidx += G) {
            const int l = uidx / 120, r = uidx % 120, cg = r / 10, ks = r % 10, k0 = (ks * 1024) / 10, k1 = ((ks + 1) * 1024) / 10, n = cg * 512 + tid;
            float acc[BATCH];
#pragma unroll
            for (int b = 0; b < BATCH; ++b) acc[b] = 0.f;
            const float* w = w_ada + (size_t)l * D * (NMOD * D) + n;
#pragma unroll 17
            for (int k = k0; k < k1; ++k) { const float wv = LD_ONCE(w + (size_t)k * (NMOD * D));
#ifdef ADA_CS8
                const f32x4 c0 = *(const LAS f32x4*)(cs + k * 8), c1 = *(const LAS f32x4*)(cs + k * 8 + 4);
                acc[0] += c0[0] * wv; acc[1] += c0[1] * wv; acc[2] += c0[2] * wv; acc[3] += c0[3] * wv; acc[4] += c1[0] * wv; acc[5] += c1[1] * wv; acc[6] += c1[2] * wv; acc[7] += c1[3] * wv; }
#else
#pragma unroll
                for (int b = 0; b < BATCH; ++b) acc[b] += cs[b * D + k] * wv; }
#endif
            const float bb = ks == 0 ? b_ada[l * NMOD * D + n] : 0.f;
#pragma unroll
            for (int b = 0; b < BATCH; ++b) atomicAdd((rep_ == 1 ? MOD : (float*)(ws + WS_URET)) + ((size_t)l * BATCH + b) * (NMOD * D) + n, acc[b] + bb);
        }
        __syncthreads();
        TRANSPOSE_RANGE(0, DEPTH * I_LAYER, gw, NGW);
#ifdef DUP_P0A
        TRANSPOSE_RANGE(0, DEPTH * I_LAYER, gw, NGW);
#endif
        for (int idx = vcu * (NWAVES * 64) + tid; idx < SEQ * 32; idx += G * NWAVES * 64) {
            const int pos = idx >> 5, i = idx & 31;
            const float lin = (float)i / 31.0f;
            const float inv = (float)exp(-(double)lin * 9.210340371976184);
            const float theta = (float)pos * inv;
            const double rev = (double)theta * 0.15915494309189535;
            const double ang = (rev - rint(rev)) * 6.283185307179586;
            TAB[idx] = make_float2((float)cos(ang), (float)sin(ang));
        }
    }
    GRID_BAR();
#ifdef DUP_P0B
    for (int rep = 0; rep < 2; ++rep)
#endif
    {
        for (int rg = gw; rg < M / A0_ROWS; rg += NGW) {
            const int row0 = rg * A0_ROWS, b = row0 >> 11;
            f32x4 v[A0_ROWS][4];
#pragma unroll
            for (int r = 0; r < A0_ROWS; ++r)
#pragma unroll
                for (int j = 0; j < 4; ++j) v[r][j] = LD_ONCE((const f32x4*)(x + (size_t)(row0 + r) * D) + lane + 64 * j);
            f32x4 wm[4];
#pragma unroll
            for (int j = 0; j < 4; ++j) { const int col = (lane + 64 * j) * 4; wm[j] = (*(const f32x4*)(norm_mix_w + col)) * (1.f + *(const f32x4*)(MOD + (size_t)b * (NMOD * D) + D + col)); }
#pragma unroll
            for (int r = 0; r < A0_ROWS; ++r) {
                float s = 0.f;
#pragma unroll
                for (int j = 0; j < 4; ++j) s += (v[r][j][0] * v[r][j][0] + v[r][j][1] * v[r][j][1]) + (v[r][j][2] * v[r][j][2] + v[r][j][3] * v[r][j][3]);
                s = wave_sum(s);
                if (lane == 0) SSUM[row0 + r] = s;
                v2u* o8 = (v2u*)(ABUF + (size_t)(row0 + r) * D) + lane;
#pragma unroll
                for (int j = 0; j < 4; ++j) { const f32x4 a = v[r][j] * wm[j]; v2u w; w.x = pk2(a[0], a[1]); w.y = pk2(a[2], a[3]); o8[64 * j] = w; }
            }
        }
#ifdef SHW_MFMA
        SHW_MFMA_ALL();
#else
        SHW_RANGE(0, DEPTH * 9216, gw, NGW);
#endif
    }
    GRID_BAR();
    for (int l = 0; l < DEPTH; ++l) {
        const bf16* Wl = (const bf16*)(ws + WS_W + (size_t)l * W_LAYER);
        const float* modl = MOD + (size_t)l * BATCH * (NMOD * D);
        {
            const int nM = M / 256;
            const bool split = (nM * 12) % G == 0 && nM * 4 == G;
            for (int part = 0; part < 2; ++part) {
                const int t0 = part == 0 ? 0 : (split ? 12 : 14), ntl = part == 0 ? (split ? 12 : 14) : (split ? 2 : 0);
                pg8::Gemm g{ABUF, Wl + W_IN_OFF / 2 + (size_t)t0 * 256 * D, M, ntl * 256, D}; pg8::StaticOrder S; S.init(M, ntl * 256, G, bx);
                pg8::EpiWin E{PROJ, SSUM + (size_t)(2 * l) * M, SHW1 + (size_t)l * BATCH * INW, TAB, hg_lb, l, lds + STAGE_OFF, t0};
                pg8::gemm_phase<pg8::EpiWin, pg8::StaticOrder, GEMM_ALIGN, GEMM_SP2>(lds, g, S, E);
                if (part == 0) GRID_BAR();
            }
            int first = bx, step = G;
            if (split) { const int nb = nM * 2; if (bx < nb) { first = bx; step = 1024; } else { first = bx; step = G - nb; } }
#if defined(MIX_CHAIN) && !defined(MIX_CHAIN_P4ONLY)
            mix_state_both(lds, PROJ, UHG, URET, BL, first, step, 1024, tid);
#else
            mix_state_loop<128, false>(lds, PROJ, UHG, BL, first, step, 1024, tid);
            mix_state_loop<64, true>(lds, PROJ, URET, BL, first, step, 1024, tid);
#endif
        }
        GRID_BAR();
#ifdef DUP_P3
        for (int rep = 0; rep < 2; ++rep)
#else
        const int rep = 1;
#endif
        {
            int tid3 = threadIdx.x; asm volatile("" : "+v"(tid3));
            for (int w = bx * (NWAVES * 64) + tid3; w < 32768; w += G * NWAVES * 64) {
                const int bh = w >> 10; bf16* base = URET + (size_t)bh * 32 * 8192 + (size_t)(w & 1023) * 8;
                const float dret = __builtin_amdgcn_exp2f(64.f * __log2f(1.f - exp2f(-5.f - (float)(bh & 3))));
                float S[8];
#pragma unroll
                for (int e = 0; e < 8; ++e) S[e] = 0.f;
                for (int cb = 0; cb < NCH; cb += 8) {
                    v4u uv[8];
#pragma unroll
                    for (int k = 0; k < 8; ++k) uv[k] = *(const v4u*)(base + (size_t)(cb + k) * 8192);
#pragma unroll
                    for (int k = 0; k < 8; ++k) {
                        v4u sv; sv.x = pk2(S[0], S[1]); sv.y = pk2(S[2], S[3]); sv.z = pk2(S[4], S[5]); sv.w = pk2(S[6], S[7]);
                        *(v4u*)(base + (size_t)(cb + k) * 8192) = sv;
                        const unsigned uu[4] = {uv[k].x, uv[k].y, uv[k].z, uv[k].w};
#pragma unroll
                        for (int e = 0; e < 4; ++e) { S[2 * e] = dret * S[2 * e] + __builtin_bit_cast(float, uu[e] << 16); S[2 * e + 1] = dret * S[2 * e + 1] + __builtin_bit_cast(float, uu[e] & 0xffff0000u); }
                    }
                }
            }
            for (int w2 = bx * (NWAVES * 64) + tid3; w2 < 65536; w2 += G * NWAVES * 64) {
                const int bh = w2 >> 11, d0 = (w2 & 15) * 8; bf16* base = UHG + (size_t)bh * 32 * 16384 + (size_t)(w2 & 2047) * 8; const float* blp = BL + (size_t)bh * 32 * 128 + d0;
                float S[8];
#pragma unroll
                for (int e = 0; e < 8; ++e) S[e] = 0.f;
                for (int cb = 0; cb < NCH; cb += 4) {
                    v4u uv[4]; f32x4 bl0[4], bl1[4];
#pragma unroll
                    for (int k = 0; k < 4; ++k) { uv[k] = *(const v4u*)(base + (size_t)(cb + k) * 16384); bl0[k] = *(const f32x4*)(blp + (cb + k) * 128); bl1[k] = *(const f32x4*)(blp + (cb + k) * 128 + 4); }
#pragma unroll
                    for (int k = 0; k < 4; ++k) {
                        float dec[8];
#pragma unroll
                        for (int e = 0; e < 4; ++e) { dec[e] = __builtin_amdgcn_exp2f(bl0[k][e]); dec[4 + e] = __builtin_amdgcn_exp2f(bl1[k][e]); }
                        v4u sv; sv.x = pk2(S[0], S[1]); sv.y = pk2(S[2], S[3]); sv.z = pk2(S[4], S[5]); sv.w = pk2(S[6], S[7]);
                        *(v4u*)(base + (size_t)(cb + k) * 16384) = sv;
                        const unsigned uu[4] = {uv[k].x, uv[k].y, uv[k].z, uv[k].w};
#pragma unroll
                        for (int e = 0; e < 4; ++e) { S[2 * e] = dec[2 * e] * S[2 * e] + __builtin_bit_cast(float, uu[e] << 16); S[2 * e + 1] = dec[2 * e + 1] * S[2 * e + 1] + __builtin_bit_cast(float, uu[e] & 0xffff0000u); }
                    }
                }
            }
        }
        GRID_BAR();
#ifdef DUP_P4
        for (int rep = 0; rep < 2; ++rep)
#endif
        {
#if defined(OLD_P4)
            for (int i = bx; i < 2048; i += G) { if (i < 1024) mix_out_item_v1<128, false>(lds, PROJ, UHG, hg_norm_w + l * 512, ABUF, i, tid); else mix_out_item_v1<64, true>(lds, PROJ, URET, ret_norm_w + l * 512, ABUF, i - 1024, tid); }
#elif defined(OLD_P4_RET)
#ifdef DUP_P4HG
            mix_out_loop<128, false>(lds, PROJ, UHG, hg_norm_w + l * 512, ABUF, bx, G, tid);
            __syncthreads();
#endif
            mix_out_loop<128, false>(lds, PROJ, UHG, hg_norm_w + l * 512, ABUF, bx, G, tid);
            __syncthreads();
#ifdef DUP_P4RET
            for (int i = bx; i < 1024; i += G) mix_out_item_v1<64, true>(lds, PROJ, URET, ret_norm_w + l * 512, ABUF, i, tid);
#endif
            for (int i = bx; i < 1024; i += G) mix_out_item_v1<64, true>(lds, PROJ, URET, ret_norm_w + l * 512, ABUF, i, tid);
#elif defined(OLD_P4_HG)
            for (int i = bx; i < 1024; i += G) mix_out_item_v1<128, false>(lds, PROJ, UHG, hg_norm_w + l * 512, ABUF, i, tid);
            mix_out_loop<64, true>(lds, PROJ, URET, ret_norm_w + l * 512, ABUF, bx, G, tid);
#elif defined(RET_NEW_LAYER)
            mix_out_loop<128, false>(lds, PROJ, UHG, hg_norm_w + l * 512, ABUF, bx, G, tid);
            __syncthreads();
            if (l == RET_NEW_LAYER) mix_out_loop<64, true>(lds, PROJ, URET, ret_norm_w + l * 512, ABUF, bx, G, tid);
            else for (int i = bx; i < 1024; i += G) mix_out_item_v1<64, true>(lds, PROJ, URET, ret_norm_w + l * 512, ABUF, i, tid);
#elif defined(RET_FIRST)
            mix_out_loop<64, true>(lds, PROJ, URET, ret_norm_w + l * 512, ABUF, bx, G, tid);
            __syncthreads();
            mix_out_loop<128, false>(lds, PROJ, UHG, hg_norm_w + l * 512, ABUF, bx, G, tid);
#else
#ifdef DUP_P4N
            for (int rep = 0; rep < 2; ++rep)
#endif
#ifdef MIX_CHAIN
            { mix_out_both(lds, PROJ, UHG, URET, hg_norm_w + l * 512, ret_norm_w + l * 512, ABUF, bx, G, tid); __syncthreads(); }
#else
            { mix_out_loop<128, false>(lds, PROJ, UHG, hg_norm_w + l * 512, ABUF, bx, G, tid);
            mix_out_loop<64, true>(lds, PROJ, URET, ret_norm_w + l * 512, ABUF, bx, G, tid); __syncthreads(); }
#endif
#endif
        }
        GRID_BAR();
#ifdef DIFF_RET
        if (l == 0) {
            bf16* O2 = (bf16*)out;
            for (int i2 = bx; i2 < 1024; i2 += G) mix_out_item_v1<64, true>(lds, PROJ, URET, ret_norm_w + l * 512, O2, i2, tid);
            GRID_BAR();
            unsigned* PRBU = (unsigned*)(ws + 33792);
            unsigned cnt = 0; unsigned long long best = 0ull;
            for (int idx = bx * 512 + tid; idx < M * 512; idx += G * 512) { const int row = idx >> 9, col = idx & 511;
                const float a = bf2f(ABUF[(size_t)row * 1024 + col]), bq = bf2f(O2[(size_t)row * 1024 + col]); const float df = fabsf(a - bq);
                if (df > 0.05f + 0.05f * fabsf(bq)) { ++cnt; const unsigned long long key = ((unsigned long long)__builtin_bit_cast(unsigned, df) << 32) | (unsigned)idx; if (key > best) best = key; } }
            if (cnt) atomicAdd(PRBU, cnt);
            if (best) atomicMax((unsigned long long*)(PRBU + 2), best);
            GRID_BAR();
        }
#endif
        {
            pg8::Gemm g{ABUF, Wl + W_OUT_OFF / 2, M, D, D}; pg8::StaticOrder S; S.init(M, D, G, bx);
            if (l == 0) { pg8::EpiRes<true> E{x, X16, modl + 2 * D, norm_ffn_w + l * D, modl + 4 * D, A2, SSUM + (size_t)(2 * l + 1) * M};
                pg8::gemm_phase<pg8::EpiRes<true>, pg8::StaticOrder, true, GEMM_SP2>(lds, g, S, E); }
            else { pg8::EpiRes<false> E{X16, X16, modl + 2 * D, norm_ffn_w + l * D, modl + 4 * D, A2, SSUM + (size_t)(2 * l + 1) * M};
                pg8::gemm_phase<pg8::EpiRes<false>, pg8::StaticOrder, true, GEMM_SP2>(lds, g, S, E); }
        }
        GRID_BAR();
        {
            pg8::Gemm g{A2, Wl + W_GU_OFF / 2, M, 2 * DFF, D}; pg8::StaticOrder S; S.init(M, 2 * DFF, G, bx);
            pg8::EpiFfn E{PROJ, SSUM + (size_t)(2 * l + 1) * M, SHW2 + (size_t)l * BATCH * 5632, lds + STAGE_OFF};
#ifdef STAGGER_P6
            {
                const int rem6 = ((M / 256) * (2 * DFF / 256)) % G;
                if (rem6 != 0 && bx >= rem6) { const unsigned long long t0 = __builtin_amdgcn_s_memrealtime(); while (__builtin_amdgcn_s_memrealtime() - t0 < (unsigned long long)(STAGGER_P6)) __builtin_amdgcn_s_sleep(8); }
            }
#endif
            pg8::gemm_phase<pg8::EpiFfn, pg8::StaticOrder, GEMM_ALIGN, GEMM_SP2>(lds, g, S, E);
#ifdef DUP_P6
            __syncthreads(); pg8::gemm_phase<pg8::EpiFfn, pg8::StaticOrder, GEMM_ALIGN, GEMM_SP2>(lds, g, S, E);
#endif
        }
        GRID_BAR();
        const bool has_next = (l + 1 < DEPTH);
        const bool fuse_final = !has_next && (M / 256) * (D / 256) == G;
        {
            pg8::Gemm g{PROJ, Wl + W_DN_OFF / 2, M, D, DFF}; pg8::StaticOrder S; S.init(M, D, G, bx);
            if (fuse_final) {
                pg8::EpiFinal E{X16, out, modl + 5 * D, final_w, SSUM + (size_t)(2 * l + 2) * M, &bar};
                pg8::gemm_phase<pg8::EpiFinal, pg8::StaticOrder, false, GEMM_SP2>(lds, g, S, E);
            } else {
                pg8::EpiRes<false> E{X16, X16, modl + 5 * D, has_next ? norm_mix_w + (l + 1) * D : nullptr, modl + BATCH * (NMOD * D) + D, ABUF, SSUM + (size_t)(2 * l + 2) * M};
                pg8::gemm_phase<pg8::EpiRes<false>, pg8::StaticOrder, true, GEMM_SP2>(lds, g, S, E);
            }
        }
        if (fuse_final) return;
        GRID_BAR();
    }
    {
        int tid_f = threadIdx.x; asm volatile("" : "+v"(tid_f)); const int lane_f = tid_f & 63;
        v4u hold[16][2];
#pragma unroll
        for (int i = 0; i < 16; ++i) { const int row = gw + i * NGW; if (row < M) { hold[i][0] = *((const v4u*)(X16 + (size_t)row * D) + lane_f * 2); hold[i][1] = *((const v4u*)(X16 + (size_t)row * D) + lane_f * 2 + 1); } }
        GRID_BAR();
#pragma unroll
        for (int i = 0; i < 16; ++i) { const int row = gw + i * NGW; if (row < M) {
            const float rs = __builtin_amdgcn_rsqf(SSUM[(size_t)4 * M + row] * (1.f / D) + EPS);
#pragma unroll
            for (int hh = 0; hh < 2; ++hh) { const unsigned w4[4] = {hold[i][hh].x, hold[i][hh].y, hold[i][hh].z, hold[i][hh].w};
#pragma unroll
                for (int q = 0; q < 2; ++q) { const int col = lane_f * 16 + hh * 8 + q * 4; const f32x4 fwv = *(const f32x4*)(final_w + col);
                    f32x4 o; o[0] = pg8::f16lo(w4[2 * q]); o[1] = pg8::f16hi(w4[2 * q]); o[2] = pg8::f16lo(w4[2 * q + 1]); o[3] = pg8::f16hi(w4[2 * q + 1]);
                    *(f32x4*)(out + (size_t)row * D + col) = o * rs * fwv; } } } }
    }
}

extern "C" void kernel_launch(void* const* d_in, const int* in_sizes, int n_in, void* d_out, int out_size, void* d_ws, size_t ws_size, hipStream_t stream) {
    static int grid = 0;
    if (grid == 0) {
        if (n_in != 15 || in_sizes[0] != M * D || out_size != M * D || ws_size < WS_END) { fprintf(stderr, "kernel_launch: unexpected shapes (n_in %d, in0 %d, out %d, ws %zu); nothing launched\n", n_in, n_in > 0 ? in_sizes[0] : -1, out_size, ws_size); grid = -1; return; }
        int dev = 0, cus = 0, per_cu = 0;
        if (hipGetDevice(&dev) != hipSuccess || hipDeviceGetAttribute(&cus, hipDeviceAttributeMultiprocessorCount, dev) != hipSuccess) { fprintf(stderr, "kernel_launch: device query failed\n"); grid = -1; return; }
        if (hipFuncSetAttribute((const void*)fwd_kernel, hipFuncAttributeMaxDynamicSharedMemorySize, LDS_BYTES) != hipSuccess) { fprintf(stderr, "kernel_launch: hipFuncSetAttribute failed\n"); grid = -1; return; }
        if (hipOccupancyMaxActiveBlocksPerMultiprocessor(&per_cu, (const void*)fwd_kernel, NWAVES * 64, LDS_BYTES) != hipSuccess || per_cu < 1)
            fprintf(stderr, "kernel_launch: note: occupancy query reports %d workgroups per CU\n", per_cu);
        (void)hipGetLastError();
        grid = cus;
    }
    if (grid < 0) return;
    if (hipMemsetAsync((char*)d_ws + WS_CTL, 0, CTL_ZERO_BYTES, stream) != hipSuccess) { fprintf(stderr, "kernel_launch: hipMemsetAsync failed\n"); return; }
    Args a{};
    for (int i = 0; i < 15; ++i) a.in[i] = (const float*)d_in[i];
    a.out = (float*)d_out; a.ws = (unsigned char*)d_ws;
    hipLaunchKernelGGL(fwd_kernel, dim3(grid), dim3(NWAVES * 64), LDS_BYTES, stream, a);
    const hipError_t le = hipPeekAtLastError();
    if (le != hipSuccess) fprintf(stderr, "kernel_launch: launch failed: %s\n", hipGetErrorName(le));
}
```

```cpp
#include <hip/hip_runtime.h>
#include <cstdio>
#include <cstdint>
#define LAS __attribute__((address_space(3)))


#define XB_TMO      128
#define XB_XCNT(j)  (256  + 64 * (j))
#define XB_XSUB(j)  (1280 + 64 * (j))
#define XB_XGEN(j)  (2304 + 64 * (j))
#define XB_TOP      3328
#define XB_TOPGEN   3392
#define XCD_BAR_WORDS 3456
#define XB_SPIN_CAP (1u << 18)

__device__ __forceinline__ unsigned xb_ld(unsigned* p)              { return __hip_atomic_load(p, __ATOMIC_RELAXED, __HIP_MEMORY_SCOPE_AGENT); }
__device__ __forceinline__ unsigned xb_add(unsigned* p, unsigned v) { return __hip_atomic_fetch_add(p, v, __ATOMIC_RELAXED, __HIP_MEMORY_SCOPE_AGENT); }
__device__ __forceinline__ unsigned xb_xcc_id() { return (unsigned)__builtin_amdgcn_s_getreg((3 << 11) | 20) & 0xFu; }
#define XB_SPIN(cond, bar) do { unsigned _sp = 0; while (cond) { __builtin_amdgcn_s_sleep(1); \
    if ((++_sp & 255u) == 0u) { if (xb_ld(&(bar)[XB_TMO])) break; if (_sp > XB_SPIN_CAP) { atomicAdd(&(bar)[XB_TMO], 1u); break; } } } } while (0)

struct XcdBarrier {
    unsigned* bar; unsigned x;
    volatile LAS unsigned* st;
};

__device__ __forceinline__ XcdBarrier xcd_barrier_post(unsigned* bar, volatile LAS unsigned* st) {
    XcdBarrier b; b.bar = bar; b.x = xb_xcc_id(); b.st = st;
    if (threadIdx.x == 0) (void)xb_add(&bar[XB_XCNT(b.x)], 1u);
    return b;
}
__device__ __forceinline__ void xcd_barrier_complete(unsigned* bar, unsigned x, unsigned& nloc, unsigned& nx) {
    const unsigned G = gridDim.x * gridDim.y * gridDim.z;
    unsigned sum, cnt, mine, sp = 0u;
    for (;;) {
        sum = 0u; cnt = 0u; mine = 0u;
#pragma unroll
        for (unsigned j = 0; j < 16; ++j) { const unsigned c = xb_ld(&bar[XB_XCNT(j)]); sum += c; cnt += (c > 0u) ? 1u : 0u; mine = (j == x) ? c : mine; }
        if (sum == G) break;
        __builtin_amdgcn_s_sleep(1);
        if ((++sp & 255u) == 0u) { if (xb_ld(&bar[XB_TMO])) break; if (sp > XB_SPIN_CAP) { atomicAdd(&bar[XB_TMO], 1u); break; } }
    }
    nloc = mine > 0u ? mine : 1u; nx = cnt > 0u ? cnt : 1u;
}

__device__ __forceinline__ void xcd_barrier(const XcdBarrier& b) {
    asm volatile("s_waitcnt vmcnt(0)" ::: "memory");
    __syncthreads();
    if (threadIdx.x == 0) {
        unsigned* bar = b.bar; const unsigned bx_ = xb_xcc_id();
        __builtin_amdgcn_s_waitcnt(0);
        unsigned nloc = b.st[0], nx = b.st[1];
        if (nloc == 0u) { xcd_barrier_complete(bar, bx_, nloc, nx); b.st[0] = nloc; b.st[1] = nx; }
        const unsigned old = xb_add(&bar[XB_XSUB(bx_)], 1u);
        const unsigned gen = old / nloc;
        if (old + 1u == (gen + 1u) * nloc) {
            __builtin_amdgcn_fence(__ATOMIC_RELEASE, "agent");
            asm volatile("s_waitcnt vmcnt(0)" ::: "memory");
            const unsigned og = xb_add(&bar[XB_TOP], 1u);
            const unsigned tg = og / nx;
            if (og + 1u == (tg + 1u) * nx) xb_add(&bar[XB_TOPGEN], 1u);
            else XB_SPIN(xb_ld(&bar[XB_TOPGEN]) == tg, bar);
            __builtin_amdgcn_fence(__ATOMIC_ACQUIRE, "agent");
            xb_add(&bar[XB_XGEN(bx_)], 1u);
            asm volatile("s_waitcnt vmcnt(0)" ::: "memory");
        } else {
            XB_SPIN(xb_ld(&bar[XB_XGEN(bx_)]) == gen, bar);
            __builtin_amdgcn_fence(__ATOMIC_ACQUIRE, "agent");
            asm volatile("s_waitcnt vmcnt(0)" ::: "memory");
        }
    }
    __syncthreads();
}

namespace pg8 {
#define PG8_LAS __attribute__((address_space(3)))
typedef unsigned short bf16_t;
typedef short bf16x8 __attribute__((ext_vector_type(8)));
typedef float f32x4 __attribute__((ext_vector_type(4)));
typedef unsigned u32x4 __attribute__((ext_vector_type(4)));
constexpr int BM = 256, BK = 64, HALF = 128, HTB = HALF * BK * 2  , STAGE_BYTES = 8 * HTB, NXCD = 8;
constexpr int WGM = 2;

__host__ __device__ __forceinline__ int lds_byte(int r, int c) { const int st = (r >> 4) * 2 + (c >> 5), rr = r & 15, cc = c & 31, ob = rr * 64 + cc * 2; return st * 1024 + (ob ^ (((ob >> 9) & 1) << 5)); }
__host__ __device__ __forceinline__ void stage_rc(int b, int& R, int& C) { const int st = b / 1024, sb = b % 1024, swz = sb ^ (((sb >> 9) & 1) << 5); R = (st >> 1) * 16 + swz / 64; C = (st & 1) * 32 + (swz % 64) / 2; }
__host__ __device__ __forceinline__ int perm32(int rho) { const int n = rho >> 4, i = rho & 15; return 8 * (i >> 2) + 4 * n + (i & 3); }

struct Unit { int pm, pn; };
struct Gemm { const bf16_t* A; const bf16_t* Bt; int M, N, K; };

struct StaticOrder {
    int nM, nN, nwg, G, c;
    __host__ __device__ void init(int M, int N, int G_, int c_) { nM = M / BM; nN = N / BM; nwg = nM * nN; G = G_; c = c_; }
    __host__ __device__ bool next(int i, Unit& u) const {
        const long L = (long)i * G + c; if (L >= nwg) return false;
        int wgid = (int)L; { const int q = nwg / NXCD, r = nwg % NXCD, xcd = wgid % NXCD, off = wgid / NXCD; wgid = (xcd < r ? xcd * (q + 1) : r * (q + 1) + (xcd - r) * q) + off; }
        const int nig = WGM * nN, gid = wgid / nig, fm = gid * WGM, gsz = (nM - fm) < WGM ? (nM - fm) : WGM;
        u.pm = fm + ((wgid % nig) % gsz); u.pn = (wgid % nig) / gsz; return true;
    }
    __device__ __forceinline__ void a_ready(const Unit&) const {}
    __device__ __forceinline__ void done(const Unit&) const {}
};

typedef float f32x2c_t __attribute__((ext_vector_type(2))); typedef __bf16 bf16x2c_t __attribute__((ext_vector_type(2)));
__device__ __forceinline__ unsigned cvt_pk_bf16(float lo, float hi) { const f32x2c_t v = {lo, hi}; const bf16x2c_t b = __builtin_convertvector(v, bf16x2c_t); return __builtin_bit_cast(unsigned, b); }
typedef float f32x2 __attribute__((ext_vector_type(2)));


constexpr float K_EPS = 1e-6f;
#define PG8_LD1(p) (*(p))
#define PG8_ST(T, p, v) (*(T*)(p) = (v))
__device__ __forceinline__ float silu_f(float v) { return v * __builtin_amdgcn_rcpf(1.f + __expf(-v)); }
__device__ __forceinline__ unsigned pk_f16(float lo, float hi) { const _Float16 a = (_Float16)lo, b = (_Float16)hi; return (unsigned)__builtin_bit_cast(unsigned short, a) | ((unsigned)__builtin_bit_cast(unsigned short, b) << 16); }

struct EpiWin {
    static constexpr bool PERM = true, AFTER_DRAIN = false, STAGED = true; static constexpr int NSTORE = 16;
    bf16_t* proj;
    const float* ssum;
    const float* shw;
    const float2* tab;
    const float* lbw;
    int layer;
    PG8_LAS unsigned char* stage;
    int pn_off;
    __device__ __forceinline__ void prefetch(const Unit& u, int ui, int wid, int lane) const {
        const float* src = wid < 4 ? ssum + u.pm * BM + 64 * wid + lane : shw + (size_t)(u.pm >> 3) * 3584 + (u.pn + pn_off) * BM + 64 * (wid - 4) + lane;
        __builtin_amdgcn_global_load_lds((const unsigned*)src, (PG8_LAS unsigned*)(stage + (ui & 1) * 2048 + wid * 256), 4, 0, 0);
    }
    __device__ __forceinline__ void operator()(const f32x4 (&acc)[2][2][4][2], const Unit& u, int wr, int wc, int fr_in, int fq_in, int ui) const {
        int fr = fr_in, fq = fq_in; asm volatile("" : "+v"(fr), "+v"(fq));
        const int b = u.pm >> 3, pn = u.pn + pn_off;
        const int colb = pn * BM + wc * 32 + 8 * fq;
        const PG8_LAS float* SS = (const PG8_LAS float*)(stage + (ui & 1) * 2048); const PG8_LAS float* SV = SS + 256;
        const int type = pn == 0 ? 0 : pn == 1 ? 1 : (pn == 2 || pn == 3 || pn == 10 || pn == 11) ? 2 : (pn == 8 || pn == 9) ? 4 : 3;
        f32x4 sv[2][2];
#pragma unroll
        for (int bj = 0; bj < 2; ++bj)
#pragma unroll
            for (int n = 0; n < 2; ++n) sv[bj][n] = *(const PG8_LAS f32x4*)(SV + bj * HALF + wc * 32 + 8 * fq + 4 * n);
        float lb[2][8];
#pragma unroll
        for (int bj = 0; bj < 2; ++bj)
#pragma unroll
            for (int i = 0; i < 8; ++i) lb[bj][i] = 0.f;
        if (type == 4 && layer != 0) {
#pragma unroll
            for (int bj = 0; bj < 2; ++bj)
#pragma unroll
                for (int i = 0; i < 8; ++i) { const int c = colb + bj * HALF + i - 2048; lb[bj][i] = __builtin_amdgcn_rcpf(1.f + __expf(lbw[c] - lbw[512 + c])); }
        }
        if (type <= 1) {
            const float sc = type == 1 ? 0.125f : 1.f;
#pragma unroll
            for (int ap = 0; ap < 4; ++ap) { const int ai = ap >> 1, m0 = (ap & 1) * 2;
                f32x4 tb[2][2][2];
#pragma unroll
                for (int mm = 0; mm < 2; ++mm)
#pragma unroll
                    for (int bj = 0; bj < 2; ++bj) { const int pos = (u.pm * BM + ai * HALF + wr * 64 + (m0 + mm) * 16 + fr) & 2047, i0 = ((colb + bj * HALF) & 63) >> 1;
                        tb[mm][bj][0] = *(const f32x4*)(tab + pos * 32 + i0); tb[mm][bj][1] = *(const f32x4*)(tab + pos * 32 + i0 + 2); }
#pragma unroll
                for (int mm = 0; mm < 2; ++mm) { const int m = m0 + mm; const int row = u.pm * BM + ai * HALF + wr * 64 + m * 16 + fr;
                    const float rs = __builtin_amdgcn_rsqf(SS[ai * HALF + wr * 64 + m * 16 + fr] * (1.f / 1024.f) + K_EPS);
#pragma unroll
                    for (int bj = 0; bj < 2; ++bj) {
                        const f32x4 v0 = acc[ai][bj][m][0] * rs + sv[bj][0], v1 = acc[ai][bj][m][1] * rs + sv[bj][1];
                        const f32x4 t0 = tb[mm][bj][0], t1 = tb[mm][bj][1];
                        float o[8];
                        o[0] = (v0[0] * t0[0] - v0[1] * t0[1]) * sc; o[1] = (v0[0] * t0[1] + v0[1] * t0[0]) * sc;
                        o[2] = (v0[2] * t0[2] - v0[3] * t0[3]) * sc; o[3] = (v0[2] * t0[3] + v0[3] * t0[2]) * sc;
                        o[4] = (v1[0] * t1[0] - v1[1] * t1[1]) * sc; o[5] = (v1[0] * t1[1] + v1[1] * t1[0]) * sc;
                        o[6] = (v1[2] * t1[2] - v1[3] * t1[3]) * sc; o[7] = (v1[2] * t1[3] + v1[3] * t1[2]) * sc;
                        u32x4 w; w.x = cvt_pk_bf16(o[0], o[1]); w.y = cvt_pk_bf16(o[2], o[3]); w.z = cvt_pk_bf16(o[4], o[5]); w.w = cvt_pk_bf16(o[6], o[7]);
                        PG8_ST(u32x4, proj + (size_t)row * 3584 + colb + bj * HALF, w);
                    }
                }
                asm volatile("" ::: "memory");
            }
            return;
        }
#pragma unroll
        for (int ai = 0; ai < 2; ++ai)
#pragma unroll
            for (int m = 0; m < 4; ++m) {
                const int row = u.pm * BM + ai * HALF + wr * 64 + m * 16 + fr;
                const float rs = __builtin_amdgcn_rsqf(SS[ai * HALF + wr * 64 + m * 16 + fr] * (1.f / 1024.f) + K_EPS);
                const int pos = row & 2047;
#pragma unroll
                for (int bj = 0; bj < 2; ++bj) {
                    float v[8];
                    {   const f32x4 v0 = acc[ai][bj][m][0] * rs + sv[bj][0], v1 = acc[ai][bj][m][1] * rs + sv[bj][1];
                        v[0] = v0[0]; v[1] = v0[1]; v[2] = v0[2]; v[3] = v0[3]; v[4] = v1[0]; v[5] = v1[1]; v[6] = v1[2]; v[7] = v1[3]; }
                    u32x4 w;
                    if (type == 2) {
                        w.x = cvt_pk_bf16(v[0], v[1]); w.y = cvt_pk_bf16(v[2], v[3]); w.z = cvt_pk_bf16(v[4], v[5]); w.w = cvt_pk_bf16(v[6], v[7]);
                    } else if (type == 3) {
                        unsigned wv[4];
#pragma unroll
                        for (int q = 0; q < 4; ++q) { const f32x2 x = (f32x2){v[2 * q], v[2 * q + 1]}, xn = x * (-1.44269504089f);
                            f32x2 e; e.x = __builtin_amdgcn_exp2f(xn.x); e.y = __builtin_amdgcn_exp2f(xn.y);
                            const f32x2 d = e + 1.0f; f32x2 r; r.x = __builtin_amdgcn_rcpf(d.x); r.y = __builtin_amdgcn_rcpf(d.y);
                            const f32x2 o = x * r; wv[q] = cvt_pk_bf16(o.x, o.y); }
                        w.x = wv[0]; w.y = wv[1]; w.z = wv[2]; w.w = wv[3];
                    } else {
                        float g[8];
                        if (layer == 0) {
#pragma unroll
                            for (int i = 0; i < 8; ++i) g[i] = fminf(v[i], 0.f) - __logf(1.f + __expf(-fabsf(v[i])));
                        } else {
#pragma unroll
                            for (int i = 0; i < 8; ++i) { const float s = __builtin_amdgcn_rcpf(1.f + __expf(-v[i])); g[i] = __logf(lb[bj][i] + (1.f - lb[bj][i]) * s); }
                        }
                        w.x = pk_f16(g[0], g[1]); w.y = pk_f16(g[2], g[3]); w.z = pk_f16(g[4], g[5]); w.w = pk_f16(g[6], g[7]);
                    }
                    PG8_ST(u32x4, proj + (size_t)row * 3584 + colb + bj * HALF, w);
                }
            }
    }
};

__device__ __forceinline__ float f16lo(unsigned w) { return (float)__builtin_bit_cast(_Float16, (unsigned short)(w & 0xffffu)); }
__device__ __forceinline__ float f16hi(unsigned w) { return (float)__builtin_bit_cast(_Float16, (unsigned short)(w >> 16)); }
template <bool XF32> struct EpiRes {
    static constexpr bool PERM = true, AFTER_DRAIN = false, STAGED = false; static constexpr int NSTORE = 0;
    const void* xres; bf16_t* xout;
    const float* gvec;
    const float* nw; const float* scv;
    bf16_t* anext;
    float* ssum;
    __device__ __forceinline__ void operator()(const f32x4 (&acc)[2][2][4][2], const Unit& u, int wr, int wc, int fr_in, int fq_in) const {
        int fr = fr_in, fq = fq_in; asm volatile("" : "+v"(fr), "+v"(fq));
        const int b = u.pm >> 3;
        const int colb = u.pn * BM + wc * 32 + 8 * fq;
        f32x4 gv[2][2], wm[2][2];
#pragma unroll
        for (int bj = 0; bj < 2; ++bj)
#pragma unroll
            for (int n = 0; n < 2; ++n) {
                const int c = colb + bj * HALF + 4 * n;
                gv[bj][n] = *(const f32x4*)(gvec + (size_t)b * 6144 + c);
                wm[bj][n] = nw ? (*(const f32x4*)(nw + c)) * (1.f + *(const f32x4*)(scv + (size_t)b * 6144 + c)) : (f32x4){0.f, 0.f, 0.f, 0.f};
            }
#pragma unroll
        for (int ap = 0; ap < 4; ++ap) { const int ai = ap >> 1, m0 = (ap & 1) * 2;
            f32x4 pre[2][2][2];
#pragma unroll
            for (int mm = 0; mm < 2; ++mm)
#pragma unroll
                for (int bj = 0; bj < 2; ++bj) { const size_t off = (size_t)(u.pm * BM + ai * HALF + wr * 64 + (m0 + mm) * 16 + fr) * 1024 + colb + bj * HALF;
                    if constexpr (XF32) { pre[mm][bj][0] = *(const f32x4*)((const float*)xres + off); pre[mm][bj][1] = *(const f32x4*)((const float*)xres + off + 4); }
                    else { const u32x4 h = *(const u32x4*)((const bf16_t*)xres + off); pre[mm][bj][0] = __builtin_bit_cast(f32x4, h); } }
#pragma unroll
            for (int mm = 0; mm < 2; ++mm) { const int m = m0 + mm;
                const int row = u.pm * BM + ai * HALF + wr * 64 + m * 16 + fr;
                float ss = 0.f;
#pragma unroll
                for (int bj = 0; bj < 2; ++bj) {
                    const size_t off = (size_t)row * 1024 + colb + bj * HALF;
                    f32x4 r0, r1;
                    if constexpr (XF32) { r0 = pre[mm][bj][0]; r1 = pre[mm][bj][1]; }
                    else { const u32x4 h = __builtin_bit_cast(u32x4, pre[mm][bj][0]); r0 = (f32x4){f16lo(h.x), f16hi(h.x), f16lo(h.y), f16hi(h.y)}; r1 = (f32x4){f16lo(h.z), f16hi(h.z), f16lo(h.w), f16hi(h.w)}; }
                    const f32x4 x0 = r0 + gv[bj][0] * acc[ai][bj][m][0], x1 = r1 + gv[bj][1] * acc[ai][bj][m][1];
                    { u32x4 hx; hx.x = pk_f16(x0[0], x0[1]); hx.y = pk_f16(x0[2], x0[3]); hx.z = pk_f16(x1[0], x1[1]); hx.w = pk_f16(x1[2], x1[3]); PG8_ST(u32x4, xout + off, hx); }
                    ss += (x0[0] * x0[0] + x0[1] * x0[1]) + (x0[2] * x0[2] + x0[3] * x0[3]) + (x1[0] * x1[0] + x1[1] * x1[1]) + (x1[2] * x1[2] + x1[3] * x1[3]);
                    if (nw) { const f32x4 a0 = x0 * wm[bj][0], a1 = x1 * wm[bj][1]; u32x4 w; w.x = cvt_pk_bf16(a0[0], a0[1]); w.y = cvt_pk_bf16(a0[2], a0[3]); w.z = cvt_pk_bf16(a1[0], a1[1]); w.w = cvt_pk_bf16(a1[2], a1[3]);
                        PG8_ST(u32x4, anext + off, w); }
                }
                ss += __shfl_xor(ss, 16); ss += __shfl_xor(ss, 32);
                if (fq == 0) atomicAdd(ssum + row, ss);
            }
            asm volatile("" ::: "memory");
        }
    }
};

struct EpiFinal {
    static constexpr bool PERM = true, AFTER_DRAIN = true, STAGED = false; static constexpr int NSTORE = 0;
    const bf16_t* xres; float* out; const float* gvec; const float* fw; float* ssum; const XcdBarrier* bar;
    __device__ __forceinline__ void fused(f32x4 (&acc)[2][2][4][2], const Unit& u, int wr, int wc, int fr_in, int fq_in, PG8_LAS unsigned char* lds, int wid, int lane) const {
        int fr = fr_in, fq = fq_in; asm volatile("" : "+v"(fr), "+v"(fq));
        const int b = u.pm >> 3;
        const int colb = u.pn * BM + wc * 32 + 8 * fq;
        {
            f32x4 gv[2][2];
#pragma unroll
            for (int bj = 0; bj < 2; ++bj)
#pragma unroll
                for (int n = 0; n < 2; ++n) gv[bj][n] = *(const f32x4*)(gvec + (size_t)b * 6144 + colb + bj * HALF + 4 * n);
#pragma unroll
            for (int ai = 0; ai < 2; ++ai) {
                u32x4 pre[4][2];
#pragma unroll
                for (int m = 0; m < 4; ++m)
#pragma unroll
                    for (int bj = 0; bj < 2; ++bj) pre[m][bj] = *(const u32x4*)(xres + (size_t)(u.pm * BM + ai * HALF + wr * 64 + m * 16 + fr) * 1024 + colb + bj * HALF);
#pragma unroll
                for (int m = 0; m < 4; ++m) {
                    const int row = u.pm * BM + ai * HALF + wr * 64 + m * 16 + fr;
                    float ss = 0.f;
#pragma unroll
                    for (int bj = 0; bj < 2; ++bj) {
                        const u32x4 h = pre[m][bj];
                        const f32x4 r0 = (f32x4){f16lo(h.x), f16hi(h.x), f16lo(h.y), f16hi(h.y)}, r1 = (f32x4){f16lo(h.z), f16hi(h.z), f16lo(h.w), f16hi(h.w)};
                        const f32x4 x0 = r0 + gv[bj][0] * acc[ai][bj][m][0], x1 = r1 + gv[bj][1] * acc[ai][bj][m][1];
                        acc[ai][bj][m][0] = x0; acc[ai][bj][m][1] = x1;
                        ss += (x0[0] * x0[0] + x0[1] * x0[1]) + (x0[2] * x0[2] + x0[3] * x0[3]) + (x1[0] * x1[0] + x1[1] * x1[1]) + (x1[2] * x1[2] + x1[3] * x1[3]);
                    }
                    ss += __shfl_xor(ss, 16); ss += __shfl_xor(ss, 32);
                    if (fq == 0) atomicAdd(ssum + row, ss);
                }
                asm volatile("" ::: "memory");
            }
        }
        xcd_barrier(*bar);
        f32x4 fv[2][2];
#pragma unroll
        for (int bj = 0; bj < 2; ++bj)
#pragma unroll
            for (int n = 0; n < 2; ++n) fv[bj][n] = *(const f32x4*)(fw + colb + bj * HALF + 4 * n);
        float sq[2][4];
#pragma unroll
        for (int ai = 0; ai < 2; ++ai)
#pragma unroll
            for (int m = 0; m < 4; ++m) sq[ai][m] = __hip_atomic_load(ssum + u.pm * BM + ai * HALF + wr * 64 + m * 16 + fr, __ATOMIC_RELAXED, __HIP_MEMORY_SCOPE_AGENT);
#pragma unroll
        for (int ai = 0; ai < 2; ++ai)
#pragma unroll
            for (int m = 0; m < 4; ++m) {
                const int row = u.pm * BM + ai * HALF + wr * 64 + m * 16 + fr;
                const float rs = __builtin_amdgcn_rsqf(sq[ai][m] * (1.f / 1024.f) + K_EPS);
#pragma unroll
                for (int bj = 0; bj < 2; ++bj) {
                    const size_t off = (size_t)row * 1024 + colb + bj * HALF;
                    *(f32x4*)(out + off) = acc[ai][bj][m][0] * rs * fv[bj][0]; *(f32x4*)(out + off + 4) = acc[ai][bj][m][1] * rs * fv[bj][1];
                }
            }
    }
};

struct EpiFfn {
    static constexpr bool PERM = true, AFTER_DRAIN = false, STAGED = true; static constexpr int NSTORE = 8;
    bf16_t* act; const float* ssum; const float* shw;
    PG8_LAS unsigned char* stage;
    __device__ __forceinline__ void prefetch(const Unit& u, int ui, int wid, int lane) const {
        const float* src = wid < 4 ? ssum + u.pm * BM + 64 * wid + lane : shw + (size_t)(u.pm >> 3) * 5632 + u.pn * BM + 64 * (wid - 4) + lane;
        __builtin_amdgcn_global_load_lds((const unsigned*)src, (PG8_LAS unsigned*)(stage + (ui & 1) * 2048 + wid * 256), 4, 0, 0);
    }
    __device__ __forceinline__ void operator()(const f32x4 (&acc)[2][2][4][2], const Unit& u, int wr, int wc, int fr_in, int fq_in, int ui) const {
        int fr = fr_in, fq = fq_in; asm volatile("" : "+v"(fr), "+v"(fq));
        const int cl = wc * 32 + 8 * fq;
        const PG8_LAS float* SS = (const PG8_LAS float*)(stage + (ui & 1) * 2048); const PG8_LAS float* SV = SS + 256;
        f32x2 sg[4], sgn[4], su[4];
#pragma unroll
        for (int n = 0; n < 2; ++n) { const f32x4 a = *(const PG8_LAS f32x4*)(SV + cl + 4 * n), c = *(const PG8_LAS f32x4*)(SV + HALF + cl + 4 * n);
            sg[2 * n] = (f32x2){a[0], a[1]}; sg[2 * n + 1] = (f32x2){a[2], a[3]}; su[2 * n] = (f32x2){c[0], c[1]}; su[2 * n + 1] = (f32x2){c[2], c[3]}; }
#pragma unroll
        for (int q = 0; q < 4; ++q) sgn[q] = sg[q] * (-1.44269504089f);
#pragma unroll
        for (int ai = 0; ai < 2; ++ai)
#pragma unroll
            for (int m = 0; m < 4; ++m) {
                const int row = u.pm * BM + ai * HALF + wr * 64 + m * 16 + fr;
                const float rs = __builtin_amdgcn_rsqf(SS[ai * HALF + wr * 64 + m * 16 + fr] * (1.f / 1024.f) + K_EPS), nrs = rs * (-1.44269504089f);
                unsigned wv[4];
#pragma unroll
                for (int q = 0; q < 4; ++q) {
                    const f32x4 ag4 = acc[ai][0][m][q >> 1], au4 = acc[ai][1][m][q >> 1];
                    const f32x2 ag = (q & 1) ? (f32x2){ag4[2], ag4[3]} : (f32x2){ag4[0], ag4[1]}, au = (q & 1) ? (f32x2){au4[2], au4[3]} : (f32x2){au4[0], au4[1]};
                    const f32x2 g = ag * rs + sg[q], gn = ag * nrs + sgn[q], uu = au * rs + su[q];
                    f32x2 e; e.x = __builtin_amdgcn_exp2f(gn.x); e.y = __builtin_amdgcn_exp2f(gn.y);
                    const f32x2 d = e + 1.0f;
                    f32x2 r; r.x = __builtin_amdgcn_rcpf(d.x); r.y = __builtin_amdgcn_rcpf(d.y);
                    const f32x2 o = (g * uu) * r;
                    wv[q] = cvt_pk_bf16(o.x, o.y);
                }
                u32x4 w; w.x = wv[0]; w.y = wv[1]; w.z = wv[2]; w.w = wv[3];
                PG8_ST(u32x4, act + (size_t)row * 2816 + u.pn * HALF + cl, w);
            }
    }
};


template <class Epi, class Sched, bool ALIGN_EPI = false, bool SP2 = false>
__device__ __forceinline__ void gemm_phase(PG8_LAS unsigned char* lds, const Gemm g, const Sched& S, const Epi& E) {
    int tid_l = threadIdx.x; asm volatile("" : "+v"(tid_l));
    const int tid = tid_l, wid = __builtin_amdgcn_readfirstlane(tid >> 6), lane = tid & 63, wr = wid >> 2, wc = wid & 3, fr = lane & 15, fq = lane >> 4;
    const int K = g.K, nt = K / BK;
#define PG8_TW(t) (t)
    unsigned voffA[2], voffB[2];
#pragma unroll
    for (int i = 0; i < 2; ++i) { int R, C; stage_rc(tid * 16 + i * 8192, R, C); const int Rb = Epi::PERM ? ((R & ~31) + perm32(R & 31)) : R;
        voffA[i] = (unsigned)(R * K + C) * 2u; voffB[i] = (unsigned)(Rb * K + C) * 2u; }
    const size_t kstep = (size_t)(BK * 2);
    const size_t hstep = (size_t)HALF * K * 2;
    const size_t tstep = 2 * hstep;
    const unsigned ldsw = (unsigned)wid * 1024u;
    const int aoff = lds_byte(wr * 64 + fr, fq * 8), boff = lds_byte(wc * 32 + fr, fq * 8);
#define PG8_SA(b, h) (((b) * 2 + (h)) * HTB)
#define PG8_SB(b, h) ((4 + (b) * 2 + (h)) * HTB)
#define PG8_STAGE(bufoff, gbase, voff) do { _Pragma("unroll") for (int _i = 0; _i < 2; ++_i) \
        __builtin_amdgcn_global_load_lds((const unsigned*)((const char*)(gbase) + (voff)[_i]), (PG8_LAS unsigned*)(lds + (bufoff) + ldsw + _i * 8192), 16, 0, 0); } while (0)
#define PG8_LDA(dst, b, h) do { _Pragma("unroll") for (int m = 0; m < 4; ++m) _Pragma("unroll") for (int k = 0; k < 2; ++k) dst[m][k] = *(const PG8_LAS bf16x8*)(lds + PG8_SA(b, h) + aoff + m * 2048 + k * 1024); } while (0)
#define PG8_LDB(dst, b, h) do { _Pragma("unroll") for (int n = 0; n < 2; ++n) _Pragma("unroll") for (int k = 0; k < 2; ++k) dst[n][k] = *(const PG8_LAS bf16x8*)(lds + PG8_SB(b, h) + boff + n * 2048 + k * 1024); } while (0)
#define PG8_MMA(ai, bj, At, Bt) do { __builtin_amdgcn_s_setprio(1); _Pragma("unroll") for (int m = 0; m < 4; ++m) _Pragma("unroll") for (int n = 0; n < 2; ++n) _Pragma("unroll") for (int k = 0; k < 2; ++k) \
        acc[ai][bj][m][n] = __builtin_amdgcn_mfma_f32_16x16x32_bf16(Bt[n][k], At[m][k], acc[ai][bj][m][n], 0, 0, 0); __builtin_amdgcn_s_setprio(0); } while (0)
#define PG8_WAIT_V(n) asm volatile("s_waitcnt vmcnt(" #n ")" ::: "memory")
#define PG8_WAIT_L(n) asm volatile("s_waitcnt lgkmcnt(" #n ")" ::: "memory")
#define PG8_BAR __builtin_amdgcn_s_barrier()
#define PG8_SCHED __builtin_amdgcn_sched_barrier(0)
    Unit cur, nxt; int ui = 0;
    if (!S.next(0, cur)) return;
    f32x4 acc[2][2][4][2];
#pragma unroll
    for (int a = 0; a < 2; ++a)
#pragma unroll
        for (int b = 0; b < 2; ++b)
#pragma unroll
            for (int m = 0; m < 4; ++m)
#pragma unroll
                for (int n = 0; n < 2; ++n) acc[a][b][m][n] = (f32x4){0.f, 0.f, 0.f, 0.f};
    bf16x8 At[4][2], B0[2][2], B1[2][2];
    const char* cA = (const char*)g.A + (size_t)cur.pm * tstep; const char* cB = (const char*)g.Bt + (size_t)cur.pn * tstep;
    S.a_ready(cur);
    if constexpr (SP2) {
        PG8_STAGE(PG8_SB(0, 0), cB, voffB); PG8_STAGE(PG8_SB(0, 1), cB + hstep, voffB); PG8_STAGE(PG8_SA(0, 0), cA, voffA); PG8_STAGE(PG8_SA(0, 1), cA + hstep, voffA);
        if (wr == 1) PG8_BAR;
        PG8_WAIT_V(2); PG8_BAR;
        PG8_STAGE(PG8_SB(1, 0), cB + kstep, voffB); PG8_STAGE(PG8_SA(1, 0), cA + kstep, voffA); PG8_STAGE(PG8_SB(1, 1), cB + hstep + kstep, voffB);
        PG8_WAIT_V(6); PG8_BAR;
    } else {
        PG8_STAGE(PG8_SB(0, 0), cB, voffB); PG8_STAGE(PG8_SA(0, 0), cA, voffA); PG8_STAGE(PG8_SB(0, 1), cB + hstep, voffB); PG8_STAGE(PG8_SA(0, 1), cA + hstep, voffA);
        if (wr == 1) PG8_BAR;
        PG8_WAIT_V(4); PG8_BAR;
        PG8_STAGE(PG8_SB(1, 0), cB + kstep, voffB); PG8_STAGE(PG8_SA(1, 0), cA + kstep, voffA); PG8_STAGE(PG8_SB(1, 1), cB + hstep + kstep, voffB);
        PG8_WAIT_V(6); PG8_BAR;
    }
    for (;;) {
        const bool has_next = S.next(ui + 1, nxt);
        const char* nA = has_next ? (const char*)g.A + (size_t)nxt.pm * tstep : cA; const char* nB = has_next ? (const char*)g.Bt + (size_t)nxt.pn * tstep : cB;
        if constexpr (Epi::STAGED) E.prefetch(cur, ui, wid, lane);
        for (int t = 0; t < nt; t += 2) {
            const bool last = (t == nt - 2);
            const char* a1 = cA + (size_t)PG8_TW(t + 1) * kstep;
            const char* a2 = last ? nA : cA + (size_t)PG8_TW(t + 2) * kstep; const char* b2 = last ? nB : cB + (size_t)PG8_TW(t + 2) * kstep;
            const char* a3 = a2 + kstep; const char* b3 = b2 + kstep;
            if (last && has_next) S.a_ready(nxt);
            if constexpr (SP2) {
            PG8_LDB(B0, 0, 0); PG8_LDB(B1, 0, 1); PG8_SCHED; PG8_LDA(At, 0, 0); PG8_STAGE(PG8_SA(1, 1), a1 + hstep, voffA);
            PG8_WAIT_V(8); PG8_WAIT_L(0); PG8_BAR; PG8_MMA(0, 0, At, B0); PG8_MMA(0, 1, At, B1); PG8_BAR; PG8_SCHED;
            PG8_LDA(At, 0, 1); PG8_STAGE(PG8_SB(0, 0), b2, voffB); PG8_STAGE(PG8_SB(0, 1), b2 + hstep, voffB); PG8_STAGE(PG8_SA(0, 0), a2, voffA);
            PG8_WAIT_V(8); PG8_WAIT_L(0); PG8_BAR; PG8_MMA(1, 0, At, B0); PG8_MMA(1, 1, At, B1); PG8_BAR; PG8_SCHED;
            PG8_LDB(B0, 1, 0); PG8_LDB(B1, 1, 1); PG8_SCHED; PG8_LDA(At, 1, 0); PG8_STAGE(PG8_SA(0, 1), a2 + hstep, voffA);
            PG8_WAIT_V(8); PG8_WAIT_L(0); PG8_BAR; PG8_MMA(0, 0, At, B0); PG8_MMA(0, 1, At, B1); PG8_BAR; PG8_SCHED;
            PG8_LDA(At, 1, 1); PG8_STAGE(PG8_SB(1, 0), b3, voffB); PG8_STAGE(PG8_SB(1, 1), b3 + hstep, voffB); PG8_STAGE(PG8_SA(1, 0), a3, voffA);
            PG8_WAIT_V(8); PG8_WAIT_L(0); PG8_BAR; PG8_MMA(1, 0, At, B0); PG8_MMA(1, 1, At, B1); PG8_BAR; PG8_SCHED;
            } else {
            PG8_LDB(B0, 0, 0); PG8_SCHED; PG8_LDA(At, 0, 0); PG8_STAGE(PG8_SA(1, 1), a1 + hstep, voffA);
            PG8_WAIT_L(8); PG8_BAR; PG8_WAIT_L(0); PG8_MMA(0, 0, At, B0); PG8_BAR; PG8_SCHED;
            PG8_LDB(B1, 0, 1); PG8_STAGE(PG8_SB(0, 0), b2, voffB);
            PG8_BAR; PG8_WAIT_L(0); PG8_MMA(0, 1, At, B1); PG8_BAR;
            PG8_LDA(At, 0, 1); PG8_STAGE(PG8_SA(0, 0), a2, voffA);
            PG8_BAR; PG8_WAIT_L(0); PG8_MMA(1, 0, At, B0); PG8_BAR; PG8_SCHED;
            PG8_STAGE(PG8_SB(0, 1), b2 + hstep, voffB);
            PG8_WAIT_V(6); PG8_BAR; PG8_MMA(1, 1, At, B1); PG8_BAR;
            PG8_LDB(B0, 1, 0); PG8_SCHED; PG8_LDA(At, 1, 0); PG8_STAGE(PG8_SA(0, 1), a2 + hstep, voffA);
            PG8_WAIT_L(8); PG8_BAR; PG8_WAIT_L(0); PG8_MMA(0, 0, At, B0); PG8_BAR; PG8_SCHED;
            PG8_LDB(B1, 1, 1); PG8_STAGE(PG8_SB(1, 0), b3, voffB);
            PG8_BAR; PG8_WAIT_L(0); PG8_MMA(0, 1, At, B1); PG8_BAR;
            PG8_LDA(At, 1, 1); PG8_STAGE(PG8_SA(1, 0), a3, voffA);
            PG8_BAR; PG8_WAIT_L(0); PG8_MMA(1, 0, At, B0); PG8_BAR; PG8_SCHED;
            PG8_STAGE(PG8_SB(1, 1), b3 + hstep, voffB);
            PG8_WAIT_V(6); PG8_BAR; PG8_MMA(1, 1, At, B1); PG8_BAR;
            }
        }
        if constexpr (ALIGN_EPI) { if (wr == 0) PG8_BAR; }
        if constexpr (!Epi::AFTER_DRAIN) { if constexpr (Epi::STAGED) E(acc, cur, wr, wc, fr, fq, ui); else E(acc, cur, wr, wc, fr, fq); S.done(cur); }
        if (!has_next) break;
#pragma unroll
        for (int a = 0; a < 2; ++a)
#pragma unroll
            for (int b = 0; b < 2; ++b)
#pragma unroll
                for (int m = 0; m < 4; ++m)
#pragma unroll
                    for (int n = 0; n < 2; ++n) acc[a][b][m][n] = (f32x4){0.f, 0.f, 0.f, 0.f};
        cur = nxt; cA = nA; cB = nB; ++ui;
        if constexpr (ALIGN_EPI) { if (wr == 1) PG8_BAR; }
    }
    PG8_WAIT_V(0);
    if constexpr (!ALIGN_EPI) { if (wr == 0) PG8_BAR; }
    PG8_BAR;
    if constexpr (Epi::AFTER_DRAIN) { E.fused(acc, cur, wr, wc, fr, fq, lds, wid, lane); S.done(cur); }
#undef PG8_SA
#undef PG8_SB
#undef PG8_STAGE
#undef PG8_LDA
#undef PG8_LDB
#undef PG8_MMA
#undef PG8_WAIT_V
#undef PG8_WAIT_L
#undef PG8_BAR
#undef PG8_SCHED
}
}


constexpr int NWAVES = 8;
constexpr int D = 1024, BATCH = 8, SEQ = 2048, DEPTH = 2, M = BATCH * SEQ, INW = 3584, DFF = 2816, NMOD = 6, NCH = SEQ / 64;
constexpr float EPS = 1e-6f;
constexpr size_t MiB = 1u << 20, KiB = 1u << 10;
constexpr size_t WS_CTL = 0, CTL_ZERO_BYTES = 1 * MiB;
constexpr size_t WS_MOD = 64 * KiB;
constexpr size_t WS_SSUM = 448 * KiB;
constexpr size_t WS_TAB = 1 * MiB;
constexpr size_t WS_SHW1 = WS_TAB + 512 * KiB;
constexpr size_t WS_SHW2 = WS_SHW1 + 2 * 8 * 3584 * 4;
constexpr size_t WS_BL = 3 * MiB;
constexpr size_t WS_W = 4 * MiB;
constexpr size_t W_IN_OFF = 0, W_OUT_OFF = (size_t)INW * D * 2, W_GU_OFF = W_OUT_OFF + (size_t)D * D * 2, W_DN_OFF = W_GU_OFF + (size_t)2 * DFF * D * 2, W_LAYER = W_DN_OFF + (size_t)DFF * D * 2;
constexpr size_t WS_A = 56 * MiB;
constexpr size_t WS_PROJ = 88 * MiB;
constexpr size_t WS_URET = 200 * MiB;
constexpr size_t WS_UHG = 216 * MiB;
constexpr size_t WS_A2 = 200 * MiB;
constexpr size_t WS_END = 248 * MiB;
static_assert(WS_SHW2 + 2 * 8 * 5632 * 4 <= WS_BL && WS_W + 2 * W_LAYER <= WS_A && WS_A + (size_t)M * D * 2 <= WS_PROJ && WS_PROJ + (size_t)M * INW * 2 <= WS_URET, "d_ws map");
static_assert(WS_MOD + 2 * 8 * 6144 * 4 <= WS_SSUM && WS_SSUM + 5 * M * 4 <= CTL_ZERO_BYTES, "ctl map");
constexpr int CW_BAR = 4096;
constexpr int RING_BYTES = 131072;
constexpr int LDSCTL_OFF = RING_BYTES, MISC_OFF = LDSCTL_OFF + 320;
constexpr int STAGE_OFF = RING_BYTES + 4096;
constexpr int LDS_BYTES = 147456;

#define GAS __attribute__((address_space(1)))
#define LAS __attribute__((address_space(3)))
typedef unsigned short bf16;
typedef unsigned v4u __attribute__((ext_vector_type(4)));
typedef unsigned v2u __attribute__((ext_vector_type(2)));
typedef float f32x4 __attribute__((ext_vector_type(4)));
typedef short bf16x8 __attribute__((ext_vector_type(8)));
typedef GAS unsigned gu32;
#define RLX_AGENT __ATOMIC_RELAXED, __HIP_MEMORY_SCOPE_AGENT
#define LDS_WAIT() asm volatile("s_waitcnt lgkmcnt(0)" ::: "memory")
#define LD_LAST(p) (*(p))
#define LD_ONCE(p) __builtin_nontemporal_load(p)
typedef float f32x2_t __attribute__((ext_vector_type(2)));
typedef __bf16 bf16x2_t __attribute__((ext_vector_type(2)));
__device__ __forceinline__ unsigned pk2(float lo, float hi) { const f32x2_t v = {lo, hi}; const bf16x2_t b = __builtin_convertvector(v, bf16x2_t); return __builtin_bit_cast(unsigned, b); }
__device__ __forceinline__ unsigned f2bf(float f) { return (unsigned)__builtin_bit_cast(unsigned short, (__bf16)f); }
__device__ __forceinline__ float bf2f(unsigned short u) { return __builtin_bit_cast(float, (unsigned)u << 16); }
__device__ __forceinline__ float h2f(unsigned short u) { return (float)__builtin_bit_cast(_Float16, u); }
__device__ __forceinline__ float dpp_f(float v, int ctrl_sel) {
    const int x = __builtin_bit_cast(int, v);
    int r;
    if (ctrl_sel == 0) r = __builtin_amdgcn_mov_dpp(x, 0xB1, 0xF, 0xF, true);
    else if (ctrl_sel == 1) r = __builtin_amdgcn_mov_dpp(x, 0x4E, 0xF, 0xF, true);
    else if (ctrl_sel == 2) r = __builtin_amdgcn_mov_dpp(x, 0x141, 0xF, 0xF, true);
    else r = __builtin_amdgcn_mov_dpp(x, 0x140, 0xF, 0xF, true);
    return __builtin_bit_cast(float, r);
}
__device__ __forceinline__ float row16_sum(float v) { v += dpp_f(v, 0); v += dpp_f(v, 1); v += dpp_f(v, 2); v += dpp_f(v, 3); return v; }
__device__ __forceinline__ float wave_sum(float v) {
    v = row16_sum(v);
    const int x = __builtin_bit_cast(int, v);
    return __builtin_bit_cast(float, __builtin_amdgcn_readlane(x, 0)) + __builtin_bit_cast(float, __builtin_amdgcn_readlane(x, 16))
         + __builtin_bit_cast(float, __builtin_amdgcn_readlane(x, 32)) + __builtin_bit_cast(float, __builtin_amdgcn_readlane(x, 48));
}


__device__ __forceinline__ f32x4 mfma16(bf16x8 a, bf16x8 b, f32x4 c) { return __builtin_amdgcn_mfma_f32_16x16x32_bf16(a, b, c, 0, 0, 0); }

struct TrItem { const float* W; bf16* WT; int K, N, item, mode; };
__device__ __forceinline__ void transpose_load(f32x4 (&v)[8], const TrItem& t, int lane) {
    const int nblk = t.N / 32, kb = t.item / nblk, nb = t.item % nblk, k0 = 64 * kb, n0 = 32 * nb;
    const float* src = t.W + (size_t)(k0 + (lane >> 3)) * t.N + n0 + (lane & 7) * 4;
#pragma unroll
    for (int i = 0; i < 8; ++i) v[i] = LD_ONCE((const f32x4*)(src + (size_t)(8 * i) * t.N));
}
__device__ __forceinline__ void transpose_store(const f32x4 (&v)[8], const TrItem& t, LAS float* scr, int lane) {
    const int nblk = t.N / 32, kb = t.item / nblk, nb = t.item % nblk, k0 = 64 * kb, n0 = 32 * nb;
    const int drow = t.mode == 0 ? n0 : (256 * (n0 >> 7) + (n0 & 127) + (t.mode == 2 ? 128 : 0));
#pragma unroll
    for (int i = 0; i < 8; ++i) { LAS float* p = scr + (8 * i + (lane >> 3)) * 33 + (lane & 7) * 4; p[0] = v[i][0]; p[1] = v[i][1]; p[2] = v[i][2]; p[3] = v[i][3]; }
    LDS_WAIT(); asm volatile("" ::: "memory");
    const int c = lane & 7;
#pragma unroll
    for (int j = 0; j < 4; ++j) { const int n = (lane >> 3) + 8 * j; const LAS float* s = scr + (8 * c) * 33 + n;
        v4u o; o.x = pk2(s[0 * 33], s[1 * 33]); o.y = pk2(s[2 * 33], s[3 * 33]); o.z = pk2(s[4 * 33], s[5 * 33]); o.w = pk2(s[6 * 33], s[7 * 33]);
        *(GAS v4u*)(t.WT + (size_t)(drow + n) * t.K + k0 + 8 * c) = o; }
    LDS_WAIT(); asm volatile("" ::: "memory");
}

typedef short v4i16_t __attribute__((ext_vector_type(4)));
__device__ __forceinline__ unsigned off_b(unsigned row, unsigned ch) { return 256u * row + 16u * (ch ^ (((row & 3) << 2) | ((row >> 2) & 3))); }
__device__ __forceinline__ unsigned tr_addr16(unsigned lane, unsigned c, unsigned ks, unsigned t) {
    const unsigned g = lane >> 4, q = (lane & 15) >> 2, p = lane & 3;
    return off_b(32 * ks + 8 * g + 4 * t + q, 2 * c + (p >> 1)) + 8 * (p & 1);
}
__device__ __forceinline__ bf16x8 tr_frag(LAS unsigned char* img, unsigned lane, unsigned c, unsigned ks) {
    const v4i16_t a = __builtin_amdgcn_ds_read_tr16_b64_v4i16((LAS v4i16_t*)(img + tr_addr16(lane, c, ks, 0)));
    const v4i16_t b = __builtin_amdgcn_ds_read_tr16_b64_v4i16((LAS v4i16_t*)(img + tr_addr16(lane, c, ks, 1)));
    return (bf16x8){a[0], a[1], a[2], a[3], b[0], b[1], b[2], b[3]};
}

template <int DK> struct StRegs { v4u k[DK / 64]; v4u v[2]; };
template <int DK, bool RET>
__device__ __forceinline__ void mix_state_load(StRegs<DK>& R, const bf16* proj, int it, int tid) {
    const int b = it >> 7, h = (it >> 5) & 3, c = it & 31;
    const size_t r0 = (size_t)b * 2048 + c * 64;
#pragma unroll
    for (int k = 0; k < 2; ++k) { const bf16* base = proj + (r0 + (tid >> 4) + 32 * k) * 3584 + (tid & 15) * 8 + h * 128;
        R.v[k] = *(const v4u*)(base + (RET ? 512 : 2560));
        if (!RET) R.k[k] = *(const v4u*)(base + 2048); }
    if (RET) R.k[0] = *(const v4u*)(proj + (r0 + (tid >> 3)) * 3584 + 256 + h * 64 + (tid & 7) * 8);
}
template <int DK, bool RET>
__device__ __forceinline__ void mix_state_item(LAS unsigned char* lds, const StRegs<DK>& R, bf16* ST, float* BL, int it, int tid) {
    constexpr int NSEG = 512 / DK, TS = 64 / NSEG;
    const int lane = tid & 63, wave = tid >> 6, d = tid % DK, seg = tid / DK, fr = lane & 15, fq = lane >> 4;
    const int h = (it >> 5) & 3;
    LAS unsigned char* VI = lds; LAS unsigned char* RAW = lds + 16384; LAS unsigned char* KI = lds + 32768; LAS float* TOT = (LAS float*)(lds + 49152);
#pragma unroll
    for (int k = 0; k < 2; ++k) { *(LAS v4u*)(VI + off_b((tid >> 4) + 32 * k, tid & 15)) = R.v[k];
        if (!RET) *(LAS v4u*)(RAW + ((tid >> 4) + 32 * k) * 256 + (tid & 15) * 16) = R.k[k]; }
    if (RET) *(LAS v4u*)(RAW + (tid >> 3) * 128 + (tid & 7) * 16) = R.k[0];
    __syncthreads();
    float kp[TS];
    if (RET) {
        const float lg2 = __log2f(1.f - exp2f(-5.f - (float)h)), gam = 1.f - exp2f(-5.f - (float)h);
        float f = __builtin_amdgcn_exp2f((float)(63 - seg * TS - (TS - 1)) * lg2);
#pragma unroll
        for (int i = TS - 1; i >= 0; --i) { const int t = seg * TS + i; kp[i] = bf2f(*(const LAS unsigned short*)(RAW + t * 128 + d * 2)) * f; f *= gam; }
    } else {
        float g[TS], bs[TS]; float run = 0.f;
#pragma unroll
        for (int i = 0; i < TS; ++i) { g[i] = h2f(*(const LAS unsigned short*)(RAW + (seg * TS + i) * 256 + d * 2)) * 1.44269504089f; run += g[i]; bs[i] = run; }
        TOT[seg * DK + d] = run;
        __syncthreads();
        float pre = 0.f, bl = 0.f;
#pragma unroll
        for (int s2 = 0; s2 < NSEG; ++s2) { const float t = TOT[s2 * DK + d]; bl += t; if (s2 < seg) pre += t; }
#pragma unroll
        for (int i = 0; i < TS; ++i) { const float bb = pre + bs[i]; kp[i] = (1.f - __builtin_amdgcn_exp2f(g[i])) * __builtin_amdgcn_exp2f(bl - bb); }
        if (seg == 0) BL[(size_t)it * 128 + d] = bl;
    }
#pragma unroll
    for (int i = 0; i < TS; i += 2) { const unsigned w = pk2(kp[i], kp[i + 1]);
        *(LAS unsigned short*)(KI + off_b(seg * TS + i, d >> 3) + (d & 7) * 2) = (unsigned short)w; *(LAS unsigned short*)(KI + off_b(seg * TS + i + 1, d >> 3) + (d & 7) * 2) = (unsigned short)(w >> 16); }
    __syncthreads();
    {
        bf16x8 bfr[2];
#pragma unroll
        for (int ks = 0; ks < 2; ++ks) bfr[ks] = tr_frag(VI, lane, wave, ks);
        bf16* dst = ST + (size_t)it * (128 * DK) + (size_t)(16 * wave + fr) * DK + 4 * fq;
#pragma unroll
        for (int dt = 0; dt < DK / 16; ++dt) {
            f32x4 acc = (f32x4){0.f, 0.f, 0.f, 0.f};
#pragma unroll
            for (int ks = 0; ks < 2; ++ks) acc = mfma16(tr_frag(KI, lane, dt, ks), bfr[ks], acc);
            v2u w; w.x = pk2(acc[0], acc[1]); w.y = pk2(acc[2], acc[3]);
            *(v2u*)(dst + 16 * dt) = w;
        }
    }
    __syncthreads();
}

template <int DK> struct OutRegs { v4u q[DK / 64]; v4u g[DK / 64]; v4u v[2]; v4u gate[2]; bf16x8 s[DK / 32]; float nwv; };
template <int DK, bool RET>
__device__ __forceinline__ void mix_out_load(OutRegs<DK>& R, const bf16* proj, const bf16* ST, const float* nw, int it, int tid) {
    const int lane = tid & 63, wave = tid >> 6, fr = lane & 15, fq = lane >> 4;
    const int b = it >> 7, h = (it >> 5) & 3, c = it & 31;
    const size_t r0 = (size_t)b * 2048 + c * 64;
#pragma unroll
    for (int k = 0; k < 2; ++k) { const bf16* base = proj + (r0 + (tid >> 4) + 32 * k) * 3584 + (tid & 15) * 8 + h * 128;
        R.v[k] = LD_LAST((const v4u*)(base + (RET ? 512 : 2560))); R.gate[k] = LD_LAST((const v4u*)(base + (RET ? 1024 : 3072)));
        if (!RET) { R.q[k] = LD_LAST((const v4u*)(base + 1536)); R.g[k] = LD_LAST((const v4u*)(base + 2048)); } }
    if (RET) { const bf16* base = proj + (r0 + (tid >> 3)) * 3584 + h * 64 + (tid & 7) * 8; R.q[0] = LD_LAST((const v4u*)base); R.g[0] = LD_LAST((const v4u*)(base + 256)); }
#pragma unroll
    for (int kd = 0; kd < DK / 32; ++kd) R.s[kd] = *(const bf16x8*)(ST + (size_t)it * (128 * DK) + (size_t)(16 * wave + fr) * DK + 32 * kd + 8 * fq);
    R.nwv = nw[h * 128 + 16 * wave + fr];
}
template <int DK, bool RET>
__device__ __forceinline__ void mix_out_park(LAS unsigned char* lds, const OutRegs<DK>& R, int tid) {
    LAS unsigned char* VI = lds; LAS unsigned char* RAWQ = lds + 16384; LAS unsigned char* RAWG = lds + 32768; LAS float* RED = (LAS float*)(lds + 128000);
#pragma unroll
    for (int k = 0; k < 2; ++k) { *(LAS v4u*)(VI + off_b((tid >> 4) + 32 * k, tid & 15)) = R.v[k];
        if (!RET) { *(LAS v4u*)(RAWQ + ((tid >> 4) + 32 * k) * 256 + (tid & 15) * 16) = R.q[k]; *(LAS v4u*)(RAWG + ((tid >> 4) + 32 * k) * 256 + (tid & 15) * 16) = R.g[k]; } }
    if (RET) { *(LAS v4u*)(RAWQ + (tid >> 3) * 128 + (tid & 7) * 16) = R.q[0]; *(LAS v4u*)(RAWG + (tid >> 3) * 128 + (tid & 7) * 16) = R.g[0]; }
    if (tid < 64) RED[tid] = 0.f;
    __syncthreads();
}
template <int DK, bool RET>
__device__ __forceinline__ void mix_out_item(LAS unsigned char* lds, const v4u (&gate)[2], const bf16x8 (&sfr)[DK / 32], float nwv, bf16* O, int it, int tid) {
    constexpr int NSEG = 512 / DK, TS = 64 / NSEG, PITCH = DK * 2 + 16, KD = DK / 32, RP = DK * 2;
    const int lane = tid & 63, wave = tid >> 6, d = tid % DK, seg = tid / DK, fr = lane & 15, fq = lane >> 4;
    const int b = it >> 7, h = (it >> 5) & 3, c = it & 31;
    const size_t r0 = (size_t)b * 2048 + c * 64;
    LAS unsigned char* VI = lds; LAS unsigned char* RAWQ = lds + 16384; LAS unsigned char* RAWG = lds + 32768;
    LAS unsigned char* QA = lds + 49152; LAS unsigned char* KC = lds + 66560; LAS unsigned char* QB = lds + 83968; LAS unsigned char* P = lds + 101376;
    LAS float* TOT = (LAS float*)(lds + 101376);
    LAS unsigned char* OT = lds + 110592; LAS float* RED = (LAS float*)(lds + 128000);
    float qa[TS], kc[TS], qb[TS];
    if (RET) {
        const float lg2 = __log2f(1.f - exp2f(-5.f - (float)h)), gam = 1.f - exp2f(-5.f - (float)h), eref = __builtin_amdgcn_exp2f(32.f * lg2);
        const int tb = seg * TS;
        float fa = __builtin_amdgcn_exp2f((float)(tb - 31) * lg2), fk = __builtin_amdgcn_exp2f((float)(31 - tb - (TS - 1)) * lg2);
#pragma unroll
        for (int i = 0; i < TS; ++i) { const float q = bf2f(*(const LAS unsigned short*)(RAWQ + (tb + i) * RP + d * 2)); qa[i] = q * fa; qb[i] = qa[i] * eref; fa *= gam; }
#pragma unroll
        for (int i = TS - 1; i >= 0; --i) { kc[i] = bf2f(*(const LAS unsigned short*)(RAWG + (tb + i) * RP + d * 2)) * fk; fk *= gam; }
    } else {
        float g[TS], bs[TS], q[TS]; float run = 0.f;
#pragma unroll
        for (int i = 0; i < TS; ++i) { const int t = seg * TS + i; q[i] = bf2f(*(const LAS unsigned short*)(RAWQ + t * RP + d * 2)); g[i] = h2f(*(const LAS unsigned short*)(RAWG + t * RP + d * 2)) * 1.44269504089f; run += g[i]; bs[i] = run; }
        TOT[seg * DK + d] = run;
        __syncthreads();
        float pre = 0.f, ref = 0.f;
#pragma unroll
        for (int s2 = 0; s2 < NSEG; ++s2) { const float t = TOT[s2 * DK + d]; if (s2 < NSEG / 2) ref += t; if (s2 < seg) pre += t; }
        const float eref = __builtin_amdgcn_exp2f(ref);
#pragma unroll
        for (int i = 0; i < TS; ++i) { const float e1 = __builtin_amdgcn_fmed3f(pre + bs[i] - ref, -115.f, 115.f);
            qa[i] = q[i] * __builtin_amdgcn_exp2f(e1); kc[i] = (1.f - __builtin_amdgcn_exp2f(g[i])) * __builtin_amdgcn_exp2f(-e1); qb[i] = qa[i] * eref; }
    }
#pragma unroll
    for (int i = 0; i < TS; i += 2) { const int t = seg * TS + i; const unsigned wa = pk2(qa[i], qa[i + 1]), wk = pk2(kc[i], kc[i + 1]), wb = pk2(qb[i], qb[i + 1]);
        *(LAS unsigned short*)(QA + t * PITCH + d * 2) = (unsigned short)wa; *(LAS unsigned short*)(QA + (t + 1) * PITCH + d * 2) = (unsigned short)(wa >> 16);
        *(LAS unsigned short*)(KC + t * PITCH + d * 2) = (unsigned short)wk; *(LAS unsigned short*)(KC + (t + 1) * PITCH + d * 2) = (unsigned short)(wk >> 16);
        *(LAS unsigned short*)(QB + t * PITCH + d * 2) = (unsigned short)wb; *(LAS unsigned short*)(QB + (t + 1) * PITCH + d * 2) = (unsigned short)(wb >> 16); }
    __syncthreads();
    {
        const int tt = wave & 3, sp = wave >> 2;
#pragma unroll
        for (int hh = 0; hh < 2; ++hh) {
            const int st = 2 * sp + hh;
            f32x4 acc = (f32x4){0.f, 0.f, 0.f, 0.f};
#pragma unroll
            for (int kd = 0; kd < KD; ++kd) { const bf16x8 a = *(const LAS bf16x8*)(KC + (16 * st + fr) * PITCH + (32 * kd + 8 * fq) * 2), bq = *(const LAS bf16x8*)(QA + (16 * tt + fr) * PITCH + (32 * kd + 8 * fq) * 2);
                acc = mfma16(a, bq, acc); }
            const int t = 16 * tt + fr, s0 = 16 * st + 4 * fq;
            const float p0 = (s0 + 0 <= t) ? acc[0] : 0.f, p1 = (s0 + 1 <= t) ? acc[1] : 0.f, p2 = (s0 + 2 <= t) ? acc[2] : 0.f, p3 = (s0 + 3 <= t) ? acc[3] : 0.f;
            v2u w; w.x = pk2(p0, p1); w.y = pk2(p2, p3);
            *(LAS v2u*)(P + t * 144 + s0 * 2) = w;
        }
    }
    __syncthreads();
    f32x4 o[4];
    {
        f32x4 accX[4];
#pragma unroll
        for (int tt = 0; tt < 4; ++tt) { o[tt] = (f32x4){0.f, 0.f, 0.f, 0.f}; accX[tt] = (f32x4){0.f, 0.f, 0.f, 0.f}; }
#pragma unroll
        for (int ks = 0; ks < 2; ++ks) { const bf16x8 bv = tr_frag(VI, lane, wave, ks);
#pragma unroll
            for (int tt = 0; tt < 4; ++tt) { const bf16x8 a = *(const LAS bf16x8*)(P + (16 * tt + fr) * 144 + (32 * ks + 8 * fq) * 2); o[tt] = mfma16(a, bv, o[tt]); } }
#pragma unroll
        for (int kd = 0; kd < KD; ++kd)
#pragma unroll
            for (int tt = 0; tt < 4; ++tt) { const bf16x8 a = *(const LAS bf16x8*)(QB + (16 * tt + fr) * PITCH + (32 * kd + 8 * fq) * 2); accX[tt] = mfma16(a, sfr[kd], accX[tt]); }
#pragma unroll
        for (int tt = 0; tt < 4; ++tt) o[tt] = o[tt] + accX[tt];
    }
#pragma unroll
    for (int tt = 0; tt < 4; ++tt)
#pragma unroll
        for (int r = 0; r < 4; ++r) { float s = row16_sum(o[tt][r] * o[tt][r]);
            if (fr == 0) __hip_atomic_fetch_add(RED + 16 * tt + 4 * fq + r, s, __ATOMIC_RELAXED, __HIP_MEMORY_SCOPE_WORKGROUP); }
    __syncthreads();
#pragma unroll
    for (int tt = 0; tt < 4; ++tt)
#pragma unroll
        for (int r = 0; r < 4; r += 2) { const int t = 16 * tt + 4 * fq + r; const float rs0 = __builtin_amdgcn_rsqf(RED[t] * (1.f / 128.f) + EPS), rs1 = __builtin_amdgcn_rsqf(RED[t + 1] * (1.f / 128.f) + EPS);
            const unsigned w = pk2(o[tt][r] * rs0 * nwv, o[tt][r + 1] * rs1 * nwv);
            *(LAS unsigned short*)(OT + t * 272 + (16 * wave + fr) * 2) = (unsigned short)w; *(LAS unsigned short*)(OT + (t + 1) * 272 + (16 * wave + fr) * 2) = (unsigned short)(w >> 16); }
    __syncthreads();
    {
        const int ocol = (RET ? 0 : 512) + h * 128;
#pragma unroll
        for (int k = 0; k < 2; ++k) { const int row = (tid >> 4) + 32 * k, ch = tid & 15;
            const v4u ov = *(const LAS v4u*)(OT + row * 272 + ch * 16); const v4u gv = gate[k];
            const unsigned oo[4] = {ov.x, ov.y, ov.z, ov.w}, gg[4] = {gv.x, gv.y, gv.z, gv.w}; unsigned w[4];
#pragma unroll
            for (int e = 0; e < 4; ++e) w[e] = pk2(__builtin_bit_cast(float, oo[e] << 16) * __builtin_bit_cast(float, gg[e] << 16), __builtin_bit_cast(float, oo[e] & 0xffff0000u) * __builtin_bit_cast(float, gg[e] & 0xffff0000u));
            v4u wv; wv.x = w[0]; wv.y = w[1]; wv.z = w[2]; wv.w = w[3];
            *(v4u*)(O + (r0 + row) * 1024 + ocol + ch * 8) = wv; }
    }
}

template <int DK, bool RET>
__device__ __forceinline__ void mix_state_loop(LAS unsigned char* lds, const bf16* proj, bf16* ST, float* BL, int first, int step, int end, int tid_in) {
    int tid = tid_in; asm volatile("" : "+v"(tid));
    if (first >= end) return;
    StRegs<DK> cur; mix_state_load<DK, RET>(cur, proj, first, tid);
    for (int it = first; it < end; it += step) {
        StRegs<DK> nxt = cur;
        const bool more = it + step < end;
        if (more) mix_state_load<DK, RET>(nxt, proj, it + step, tid);
        mix_state_item<DK, RET>(lds, cur, ST, BL, it, tid);
        cur = nxt;
    }
}

__device__ __forceinline__ void mix_out_both(LAS unsigned char* lds, const bf16* proj, const bf16* STH, const bf16* STR, const float* nwH, const float* nwR, bf16* O, int first, int step, int tid_in) {
    int tid = tid_in; asm volatile("" : "+v"(tid));
    if (first >= 1024) return;
    OutRegs<128> ch; mix_out_load<128, false>(ch, proj, STH, nwH, first, tid);
    OutRegs<64> cr;
    for (int it = first; it < 1024; it += step) {
        mix_out_park<128, false>(lds, ch, tid);
        const v4u gate[2] = {ch.gate[0], ch.gate[1]}; bf16x8 sfr[4]; const float nwv = ch.nwv;
#pragma unroll
        for (int kd = 0; kd < 4; ++kd) sfr[kd] = ch.s[kd];
        if (it + step < 1024) mix_out_load<128, false>(ch, proj, STH, nwH, it + step, tid); else mix_out_load<64, true>(cr, proj, STR, nwR, first, tid);
        mix_out_item<128, false>(lds, gate, sfr, nwv, O, it, tid);
    }
    for (int it = first; it < 1024; it += step) {
        mix_out_park<64, true>(lds, cr, tid);
        const v4u gate[2] = {cr.gate[0], cr.gate[1]}; bf16x8 sfr[2]; const float nwv = cr.nwv;
#pragma unroll
        for (int kd = 0; kd < 2; ++kd) sfr[kd] = cr.s[kd];
        if (it + step < 1024) mix_out_load<64, true>(cr, proj, STR, nwR, it + step, tid);
        mix_out_item<64, true>(lds, gate, sfr, nwv, O, it, tid);
    }
}


#ifndef GEMM_SP2
#define GEMM_SP2 true
#endif
#ifndef GEMM_ALIGN
#define GEMM_ALIGN true
#endif
constexpr int I_IN = 16 * 112, I_OUT = 16 * 32, I_G = 16 * 88, I_DN = 44 * 32, I_LAYER = I_IN + I_OUT + 2 * I_G + I_DN;
#define TR_DECODE(T, IT) do { const int l_ = (IT) / I_LAYER; int r_ = (IT) % I_LAYER; bf16* Wl_ = (bf16*)(ws + WS_W + (size_t)l_ * W_LAYER); \
    if (r_ < I_IN) { T.W = w_in + (size_t)l_ * D * INW; T.WT = Wl_ + W_IN_OFF / 2; T.K = D; T.N = INW; T.item = r_; T.mode = 0; } \
    else if (r_ < I_IN + I_OUT) { T.W = w_out + (size_t)l_ * D * D; T.WT = Wl_ + W_OUT_OFF / 2; T.K = D; T.N = D; T.item = r_ - I_IN; T.mode = 0; } \
    else if (r_ < I_IN + I_OUT + I_G) { T.W = w_gate + (size_t)l_ * D * DFF; T.WT = Wl_ + W_GU_OFF / 2; T.K = D; T.N = DFF; T.item = r_ - I_IN - I_OUT; T.mode = 1; } \
    else if (r_ < I_IN + I_OUT + 2 * I_G) { T.W = w_up + (size_t)l_ * D * DFF; T.WT = Wl_ + W_GU_OFF / 2; T.K = D; T.N = DFF; T.item = r_ - I_IN - I_OUT - I_G; T.mode = 2; } \
    else { T.W = w_down + (size_t)l_ * DFF * D; T.WT = Wl_ + W_DN_OFF / 2; T.K = DFF; T.N = D; T.item = r_ - I_IN - I_OUT - 2 * I_G; T.mode = 0; } } while (0)
#define TRANSPOSE_RANGE(IT0, IT1, WIDX, NW) do { LAS float* scr_ = (LAS float*)(lds + wave * 16384); int it_ = (IT0) + (WIDX); \
    if (it_ < (IT1)) { TrItem cur_; TR_DECODE(cur_, it_); f32x4 v_[8]; transpose_load(v_, cur_, lane); \
        for (;;) { const int nx_ = it_ + (NW); const bool more_ = nx_ < (IT1); TrItem nt_ = cur_; f32x4 vn_[8]; \
            if (more_) { TR_DECODE(nt_, nx_); transpose_load(vn_, nt_, lane); } \
            transpose_store(v_, cur_, scr_, lane); \
            if (!more_) break; \
            cur_ = nt_; it_ = nx_; \
            _Pragma("unroll") for (int i_ = 0; i_ < 8; ++i_) v_[i_] = vn_[i_]; } } } while (0)
#define TRANSPOSE_RANGE_SIMPLE(IT0, IT1, WIDX, NW) do { LAS float* scr_ = (LAS float*)(lds + wave * 16384); \
    for (int it_ = (IT0) + (WIDX); it_ < (IT1); it_ += (NW)) { TrItem cur_; TR_DECODE(cur_, it_); f32x4 v_[8]; transpose_load(v_, cur_, lane); transpose_store(v_, cur_, scr_, lane); } } while (0)
#define SHW_MFMA_ALL() do { __syncthreads(); \
    for (int i_ = tid; i_ < 4 * BATCH * 128; i_ += NWAVES * 64) { const int grp_ = i_ >> 10, b_ = (i_ >> 7) & 7, ch_ = i_ & 127; \
        const float* src_ = MOD + ((size_t)(grp_ >> 1) * BATCH + b_) * (NMOD * D) + ((grp_ & 1) ? 3 * D : 0) + ch_ * 8; \
        const f32x4 a_ = *(const f32x4*)src_, c_ = *(const f32x4*)(src_ + 4); \
        v4u hi_, lo_; hi_.x = pk2(a_[0], a_[1]); hi_.y = pk2(a_[2], a_[3]); hi_.z = pk2(c_[0], c_[1]); hi_.w = pk2(c_[2], c_[3]); \
        lo_.x = pk2(a_[0] - __builtin_bit_cast(float, hi_.x << 16), a_[1] - __builtin_bit_cast(float, hi_.x & 0xffff0000u)); lo_.y = pk2(a_[2] - __builtin_bit_cast(float, hi_.y << 16), a_[3] - __builtin_bit_cast(float, hi_.y & 0xffff0000u)); \
        lo_.z = pk2(c_[0] - __builtin_bit_cast(float, hi_.z << 16), c_[1] - __builtin_bit_cast(float, hi_.z & 0xffff0000u)); lo_.w = pk2(c_[2] - __builtin_bit_cast(float, hi_.w << 16), c_[3] - __builtin_bit_cast(float, hi_.w & 0xffff0000u)); \
        *(LAS v4u*)(lds + grp_ * 32768 + b_ * 2048 + ((ch_ ^ b_) << 4)) = hi_; *(LAS v4u*)(lds + grp_ * 32768 + (8 + b_) * 2048 + ((ch_ ^ (8 + b_)) << 4)) = lo_; } \
    __syncthreads(); \
    for (int it_ = wave * G + vcu; it_ < DEPTH * 9216 / 16; it_ += NWAVES * G) { \
        const int r0_ = it_ * 16, l_ = r0_ / 9216, rr_ = r0_ % 9216, type_ = rr_ >= INW ? 1 : 0, np0_ = type_ ? rr_ - INW : rr_, fr_ = lane & 15, fq_ = lane >> 4; \
        const bf16* wrow_ = (const bf16*)(ws + WS_W + (size_t)l_ * W_LAYER + (type_ ? W_GU_OFF : W_IN_OFF)) + (size_t)(np0_ + fr_) * D + 8 * fq_; \
        LAS unsigned char* ab_ = lds + (l_ * 2 + type_) * 32768 + fr_ * 2048; \
        f32x4 c_ = {0.f, 0.f, 0.f, 0.f}; \
        { bf16x8 bw_[32];                                     \
            _Pragma("unroll") for (int j_ = 0; j_ < 32; ++j_) bw_[j_] = *(const bf16x8*)(wrow_ + j_ * 32); \
            _Pragma("unroll") for (int j_ = 0; j_ < 32; ++j_) { const int ch_ = 4 * j_ + fq_; c_ = mfma16(*(const LAS bf16x8*)(ab_ + ((ch_ ^ fr_) << 4)), bw_[j_], c_); } } \
        _Pragma("unroll") for (int r_ = 0; r_ < 4; ++r_) { const float t_ = c_[r_] + __shfl_xor(c_[r_], 32); \
            if (lane < 32) { const int bt_ = 4 * fq_ + r_; if (type_) SHW2[((size_t)l_ * BATCH + bt_) * 5632 + np0_ + fr_] = t_; else SHW1[((size_t)l_ * BATCH + bt_) * INW + np0_ + fr_] = t_; } } } } while (0)
#ifndef A0_ROWS
#define A0_ROWS 8
#endif
struct Args { const float* in[15]; float* out; unsigned char* ws; };
__global__ void __launch_bounds__(NWAVES * 64, 2) fwd_kernel(Args args) {
    extern __shared__ __attribute__((aligned(16))) unsigned char lds_raw[];
    LAS unsigned char* lds = (LAS unsigned char*)lds_raw;
    volatile LAS unsigned* MISC = (volatile LAS unsigned*)(lds + MISC_OFF);
    const int tid = threadIdx.x, lane = tid & 63, wave = __builtin_amdgcn_readfirstlane(tid >> 6);
    const int G = gridDim.x, bx = blockIdx.x;
    const int vcu = (G % 8 == 0) ? (bx % 8) * (G / 8) + bx / 8 : bx;
    const int gw = vcu * NWAVES + wave, NGW = G * NWAVES;
    unsigned char* ws = args.ws;
    const float* x = args.in[0]; const float* cvec = args.in[1]; const float* w_ada = args.in[2]; const float* b_ada = args.in[3];
    const float* norm_mix_w = args.in[4]; const float* w_in = args.in[5]; const float* ret_norm_w = args.in[6]; const float* hg_lb = args.in[7];
    const float* hg_norm_w = args.in[8]; const float* w_out = args.in[9]; const float* norm_ffn_w = args.in[10]; const float* w_gate = args.in[11];
    const float* w_up = args.in[12]; const float* w_down = args.in[13]; const float* final_w = args.in[14];
    float* out = args.out; bf16* X16 = (bf16*)args.out;
    gu32* ctl = (gu32*)(ws + WS_CTL);
    float* MOD = (float*)(ws + WS_MOD); float* SSUM = (float*)(ws + WS_SSUM); float2* TAB = (float2*)(ws + WS_TAB);
    float* SHW1 = (float*)(ws + WS_SHW1); float* SHW2 = (float*)(ws + WS_SHW2); float* BL = (float*)(ws + WS_BL);
    bf16* ABUF = (bf16*)(ws + WS_A); bf16* PROJ = (bf16*)(ws + WS_PROJ); bf16* URET = (bf16*)(ws + WS_URET); bf16* UHG = (bf16*)(ws + WS_UHG); bf16* A2 = (bf16*)(ws + WS_A2);

    for (int u = tid; u < (LDS_BYTES - LDSCTL_OFF) / 4; u += NWAVES * 64) ((LAS unsigned*)(lds + LDSCTL_OFF))[u] = 0u;
    __syncthreads();
    XcdBarrier bar = xcd_barrier_post((unsigned*)(ctl + CW_BAR), MISC + 8);
#define GRID_BAR() xcd_barrier(bar)

    {
        LAS float* cs = (LAS float*)lds;
        for (int i = tid; i < BATCH * D; i += NWAVES * 64) cs[i] = pg8::silu_f(cvec[i]);
        __syncthreads();
        const int rep_ = 1;
        for (int uidx = vcu; uidx < 240; uidx += G) {
            const int l = uidx / 120, r = uidx % 120, cg = r / 10, ks = r % 10, k0 = (ks * 1024) / 10, k1 = ((ks + 1) * 1024) / 10, n = cg * 512 + tid;
            float acc[BATCH];
#pragma unroll
            for (int b = 0; b < BATCH; ++b) acc[b] = 0.f;
            const float* w = w_ada + (size_t)l * D * (NMOD * D) + n;
#pragma unroll 17
            for (int k = k0; k < k1; ++k) { const float wv = LD_ONCE(w + (size_t)k * (NMOD * D));
#pragma unroll
                for (int b = 0; b < BATCH; ++b) acc[b] += cs[b * D + k] * wv; }
            const float bb = ks == 0 ? b_ada[l * NMOD * D + n] : 0.f;
#pragma unroll
            for (int b = 0; b < BATCH; ++b) atomicAdd((rep_ == 1 ? MOD : (float*)(ws + WS_URET)) + ((size_t)l * BATCH + b) * (NMOD * D) + n, acc[b] + bb);
        }
        __syncthreads();
        TRANSPOSE_RANGE(0, DEPTH * I_LAYER, gw, NGW);
        for (int idx = vcu * (NWAVES * 64) + tid; idx < SEQ * 32; idx += G * NWAVES * 64) {
            const int pos = idx >> 5, i = idx & 31;
            const float lin = (float)i / 31.0f;
            const float inv = (float)exp(-(double)lin * 9.210340371976184);
            const float theta = (float)pos * inv;
            const double rev = (double)theta * 0.15915494309189535;
            const double ang = (rev - rint(rev)) * 6.283185307179586;
            TAB[idx] = make_float2((float)cos(ang), (float)sin(ang));
        }
    }
    GRID_BAR();
    {
        for (int rg = gw; rg < M / A0_ROWS; rg += NGW) {
            const int row0 = rg * A0_ROWS, b = row0 >> 11;
            f32x4 v[A0_ROWS][4];
#pragma unroll
            for (int r = 0; r < A0_ROWS; ++r)
#pragma unroll
                for (int j = 0; j < 4; ++j) v[r][j] = LD_ONCE((const f32x4*)(x + (size_t)(row0 + r) * D) + lane + 64 * j);
            f32x4 wm[4];
#pragma unroll
            for (int j = 0; j < 4; ++j) { const int col = (lane + 64 * j) * 4; wm[j] = (*(const f32x4*)(norm_mix_w + col)) * (1.f + *(const f32x4*)(MOD + (size_t)b * (NMOD * D) + D + col)); }
#pragma unroll
            for (int r = 0; r < A0_ROWS; ++r) {
                float s = 0.f;
#pragma unroll
                for (int j = 0; j < 4; ++j) s += (v[r][j][0] * v[r][j][0] + v[r][j][1] * v[r][j][1]) + (v[r][j][2] * v[r][j][2] + v[r][j][3] * v[r][j][3]);
                s = wave_sum(s);
                if (lane == 0) SSUM[row0 + r] = s;
                v2u* o8 = (v2u*)(ABUF + (size_t)(row0 + r) * D) + lane;
#pragma unroll
                for (int j = 0; j < 4; ++j) { const f32x4 a = v[r][j] * wm[j]; v2u w; w.x = pk2(a[0], a[1]); w.y = pk2(a[2], a[3]); o8[64 * j] = w; }
            }
        }
        SHW_MFMA_ALL();
    }
    GRID_BAR();
    for (int l = 0; l < DEPTH; ++l) {
        const bf16* Wl = (const bf16*)(ws + WS_W + (size_t)l * W_LAYER);
        const float* modl = MOD + (size_t)l * BATCH * (NMOD * D);
        {
            const int nM = M / 256;
            const bool split = (nM * 12) % G == 0 && nM * 4 == G;
            for (int part = 0; part < 2; ++part) {
                const int t0 = part == 0 ? 0 : (split ? 12 : 14), ntl = part == 0 ? (split ? 12 : 14) : (split ? 2 : 0);
                pg8::Gemm g{ABUF, Wl + W_IN_OFF / 2 + (size_t)t0 * 256 * D, M, ntl * 256, D}; pg8::StaticOrder S; S.init(M, ntl * 256, G, bx);
                pg8::EpiWin E{PROJ, SSUM + (size_t)(2 * l) * M, SHW1 + (size_t)l * BATCH * INW, TAB, hg_lb, l, lds + STAGE_OFF, t0};
                pg8::gemm_phase<pg8::EpiWin, pg8::StaticOrder, GEMM_ALIGN, GEMM_SP2>(lds, g, S, E);
                if (part == 0) GRID_BAR();
            }
            int first = bx, step = G;
            if (split) { const int nb = nM * 2; if (bx < nb) { first = bx; step = 1024; } else { first = bx; step = G - nb; } }
            mix_state_loop<128, false>(lds, PROJ, UHG, BL, first, step, 1024, tid);
            mix_state_loop<64, true>(lds, PROJ, URET, BL, first, step, 1024, tid);
        }
        GRID_BAR();
        {
            int tid3 = threadIdx.x; asm volatile("" : "+v"(tid3));
            for (int w = bx * (NWAVES * 64) + tid3; w < 32768; w += G * NWAVES * 64) {
                const int bh = w >> 10; bf16* base = URET + (size_t)bh * 32 * 8192 + (size_t)(w & 1023) * 8;
                const float dret = __builtin_amdgcn_exp2f(64.f * __log2f(1.f - exp2f(-5.f - (float)(bh & 3))));
                float S[8];
#pragma unroll
                for (int e = 0; e < 8; ++e) S[e] = 0.f;
                for (int cb = 0; cb < NCH; cb += 8) {
                    v4u uv[8];
#pragma unroll
                    for (int k = 0; k < 8; ++k) uv[k] = *(const v4u*)(base + (size_t)(cb + k) * 8192);
#pragma unroll
                    for (int k = 0; k < 8; ++k) {
                        v4u sv; sv.x = pk2(S[0], S[1]); sv.y = pk2(S[2], S[3]); sv.z = pk2(S[4], S[5]); sv.w = pk2(S[6], S[7]);
                        *(v4u*)(base + (size_t)(cb + k) * 8192) = sv;
                        const unsigned uu[4] = {uv[k].x, uv[k].y, uv[k].z, uv[k].w};
#pragma unroll
                        for (int e = 0; e < 4; ++e) { S[2 * e] = dret * S[2 * e] + __builtin_bit_cast(float, uu[e] << 16); S[2 * e + 1] = dret * S[2 * e + 1] + __builtin_bit_cast(float, uu[e] & 0xffff0000u); }
                    }
                }
            }
            for (int w2 = bx * (NWAVES * 64) + tid3; w2 < 65536; w2 += G * NWAVES * 64) {
                const int bh = w2 >> 11, d0 = (w2 & 15) * 8; bf16* base = UHG + (size_t)bh * 32 * 16384 + (size_t)(w2 & 2047) * 8; const float* blp = BL + (size_t)bh * 32 * 128 + d0;
                float S[8];
#pragma unroll
                for (int e = 0; e < 8; ++e) S[e] = 0.f;
                for (int cb = 0; cb < NCH; cb += 4) {
                    v4u uv[4]; f32x4 bl0[4], bl1[4];
#pragma unroll
                    for (int k = 0; k < 4; ++k) { uv[k] = *(const v4u*)(base + (size_t)(cb + k) * 16384); bl0[k] = *(const f32x4*)(blp + (cb + k) * 128); bl1[k] = *(const f32x4*)(blp + (cb + k) * 128 + 4); }
#pragma unroll
                    for (int k = 0; k < 4; ++k) {
                        float dec[8];
#pragma unroll
                        for (int e = 0; e < 4; ++e) { dec[e] = __builtin_amdgcn_exp2f(bl0[k][e]); dec[4 + e] = __builtin_amdgcn_exp2f(bl1[k][e]); }
                        v4u sv; sv.x = pk2(S[0], S[1]); sv.y = pk2(S[2], S[3]); sv.z = pk2(S[4], S[5]); sv.w = pk2(S[6], S[7]);
                        *(v4u*)(base + (size_t)(cb + k) * 16384) = sv;
                        const unsigned uu[4] = {uv[k].x, uv[k].y, uv[k].z, uv[k].w};
#pragma unroll
                        for (int e = 0; e < 4; ++e) { S[2 * e] = dec[2 * e] * S[2 * e] + __builtin_bit_cast(float, uu[e] << 16); S[2 * e + 1] = dec[2 * e + 1] * S[2 * e + 1] + __builtin_bit_cast(float, uu[e] & 0xffff0000u); }
                    }
                }
            }
        }
        GRID_BAR();
        {
            { mix_out_both(lds, PROJ, UHG, URET, hg_norm_w + l * 512, ret_norm_w + l * 512, ABUF, bx, G, tid); __syncthreads(); }
        }
        GRID_BAR();
        {
            pg8::Gemm g{ABUF, Wl + W_OUT_OFF / 2, M, D, D}; pg8::StaticOrder S; S.init(M, D, G, bx);
            if (l == 0) { pg8::EpiRes<true> E{x, X16, modl + 2 * D, norm_ffn_w + l * D, modl + 4 * D, A2, SSUM + (size_t)(2 * l + 1) * M};
                pg8::gemm_phase<pg8::EpiRes<true>, pg8::StaticOrder, true, GEMM_SP2>(lds, g, S, E); }
            else { pg8::EpiRes<false> E{X16, X16, modl + 2 * D, norm_ffn_w + l * D, modl + 4 * D, A2, SSUM + (size_t)(2 * l + 1) * M};
                pg8::gemm_phase<pg8::EpiRes<false>, pg8::StaticOrder, true, GEMM_SP2>(lds, g, S, E); }
        }
        GRID_BAR();
        {
            pg8::Gemm g{A2, Wl + W_GU_OFF / 2, M, 2 * DFF, D}; pg8::StaticOrder S; S.init(M, 2 * DFF, G, bx);
            pg8::EpiFfn E{PROJ, SSUM + (size_t)(2 * l + 1) * M, SHW2 + (size_t)l * BATCH * 5632, lds + STAGE_OFF};
            pg8::gemm_phase<pg8::EpiFfn, pg8::StaticOrder, GEMM_ALIGN, GEMM_SP2>(lds, g, S, E);
        }
        GRID_BAR();
        const bool has_next = (l + 1 < DEPTH);
        const bool fuse_final = !has_next && (M / 256) * (D / 256) == G;
        {
            pg8::Gemm g{PROJ, Wl + W_DN_OFF / 2, M, D, DFF}; pg8::StaticOrder S; S.init(M, D, G, bx);
            if (fuse_final) {
                pg8::EpiFinal E{X16, out, modl + 5 * D, final_w, SSUM + (size_t)(2 * l + 2) * M, &bar};
                pg8::gemm_phase<pg8::EpiFinal, pg8::StaticOrder, false, GEMM_SP2>(lds, g, S, E);
            } else {
                pg8::EpiRes<false> E{X16, X16, modl + 5 * D, has_next ? norm_mix_w + (l + 1) * D : nullptr, modl + BATCH * (NMOD * D) + D, ABUF, SSUM + (size_t)(2 * l + 2) * M};
                pg8::gemm_phase<pg8::EpiRes<false>, pg8::StaticOrder, true, GEMM_SP2>(lds, g, S, E);
            }
        }
        if (fuse_final) return;
        GRID_BAR();
    }
    {
        int tid_f = threadIdx.x; asm volatile("" : "+v"(tid_f)); const int lane_f = tid_f & 63;
        v4u hold[16][2];
#pragma unroll
        for (int i = 0; i < 16; ++i) { const int row = gw + i * NGW; if (row < M) { hold[i][0] = *((const v4u*)(X16 + (size_t)row * D) + lane_f * 2); hold[i][1] = *((const v4u*)(X16 + (size_t)row * D) + lane_f * 2 + 1); } }
        GRID_BAR();
#pragma unroll
        for (int i = 0; i < 16; ++i) { const int row = gw + i * NGW; if (row < M) {
            const float rs = __builtin_amdgcn_rsqf(SSUM[(size_t)4 * M + row] * (1.f / D) + EPS);
#pragma unroll
            for (int hh = 0; hh < 2; ++hh) { const unsigned w4[4] = {hold[i][hh].x, hold[i][hh].y, hold[i][hh].z, hold[i][hh].w};
#pragma unroll
                for (int q = 0; q < 2; ++q) { const int col = lane_f * 16 + hh * 8 + q * 4; const f32x4 fwv = *(const f32x4*)(final_w + col);
                    f32x4 o; o[0] = pg8::f16lo(w4[2 * q]); o[1] = pg8::f16hi(w4[2 * q]); o[2] = pg8::f16lo(w4[2 * q + 1]); o[3] = pg8::f16hi(w4[2 * q + 1]);
                    *(f32x4*)(out + (size_t)row * D + col) = o * rs * fwv; } } } }
    }
}

extern "C" void kernel_launch(void* const* d_in, const int* in_sizes, int n_in, void* d_out, int out_size, void* d_ws, size_t ws_size, hipStream_t stream) {
    static int grid = 0;
    if (grid == 0) {
        if (n_in != 15 || in_sizes[0] != M * D || out_size != M * D || ws_size < WS_END) { fprintf(stderr, "kernel_launch: unexpected shapes (n_in %d, in0 %d, out %d, ws %zu); nothing launched\n", n_in, n_in > 0 ? in_sizes[0] : -1, out_size, ws_size); grid = -1; return; }
        int dev = 0, cus = 0, per_cu = 0;
        if (hipGetDevice(&dev) != hipSuccess || hipDeviceGetAttribute(&cus, hipDeviceAttributeMultiprocessorCount, dev) != hipSuccess) { fprintf(stderr, "kernel_launch: device query failed\n"); grid = -1; return; }
        if (hipFuncSetAttribute((const void*)fwd_kernel, hipFuncAttributeMaxDynamicSharedMemorySize, LDS_BYTES) != hipSuccess) { fprintf(stderr, "kernel_launch: hipFuncSetAttribute failed\n"); grid = -1; return; }
        if (hipOccupancyMaxActiveBlocksPerMultiprocessor(&per_cu, (const void*)fwd_kernel, NWAVES * 64, LDS_BYTES) != hipSuccess || per_cu < 1)
            fprintf(stderr, "kernel_launch: note: occupancy query reports %d workgroups per CU\n", per_cu);
        (void)hipGetLastError();
        grid = cus;
    }
    if (grid < 0) return;
    if (hipMemsetAsync((char*)d_ws + WS_CTL, 0, CTL_ZERO_BYTES, stream) != hipSuccess) { fprintf(stderr, "kernel_launch: hipMemsetAsync failed\n"); return; }
    Args a{};
    for (int i = 0; i < 15; ++i) a.in[i] = (const float*)d_in[i];
    a.out = (float*)d_out; a.ws = (unsigned char*)d_ws;
    hipLaunchKernelGGL(fwd_kernel, dim3(grid), dim3(NWAVES * 64), LDS_BYTES, stream, a);
    const hipError_t le = hipPeekAtLastError();
    if (le != hipSuccess) fprintf(stderr, "kernel_launch: launch failed: %s\n", hipGetErrorName(le));
}
```

```cpp
#include <hip/hip_runtime.h>
#include <cstdio>
#include <cstdint>
#define LAS __attribute__((address_space(3)))

#define RED_ATOMIC 1
#define PG8_WGM 2
#define SHW_MFMA 1
#define MIX_CHAIN 1
#define HALF_TAIL 1
#define XB_TMO      128
#define XB_XCNT(j)  (256  + 64 * (j))
#define XB_XSUB(j)  (1280 + 64 * (j))
#define XB_XGEN(j)  (2304 + 64 * (j))
#define XB_TOP      3328
#define XB_TOPGEN   3392
#define XCD_BAR_WORDS 3456
#define XB_SPIN_CAP (1u << 18)

__device__ __forceinline__ unsigned xb_ld(unsigned* p)              { return __hip_atomic_load(p, __ATOMIC_RELAXED, __HIP_MEMORY_SCOPE_AGENT); }
__device__ __forceinline__ unsigned xb_add(unsigned* p, unsigned v) { return __hip_atomic_fetch_add(p, v, __ATOMIC_RELAXED, __HIP_MEMORY_SCOPE_AGENT); }
__device__ __forceinline__ unsigned xb_xcc_id() { return (unsigned)__builtin_amdgcn_s_getreg((3 << 11) | 20) & 0xFu; }
#define XB_SPIN(cond, bar) do { unsigned _sp = 0; while (cond) { __builtin_amdgcn_s_sleep(1); \
    if ((++_sp & 255u) == 0u) { if (xb_ld(&(bar)[XB_TMO])) break; if (_sp > XB_SPIN_CAP) { atomicAdd(&(bar)[XB_TMO], 1u); break; } } } } while (0)

struct XcdBarrier {
    unsigned* bar; unsigned x;
    volatile LAS unsigned* st;
};

__device__ __forceinline__ XcdBarrier xcd_barrier_post(unsigned* bar, volatile LAS unsigned* st) {
    XcdBarrier b; b.bar = bar; b.x = xb_xcc_id(); b.st = st;
    if (threadIdx.x == 0) (void)xb_add(&bar[XB_XCNT(b.x)], 1u);
    return b;
}
__device__ __forceinline__ void xcd_barrier_complete(unsigned* bar, unsigned x, unsigned& nloc, unsigned& nx) {
    const unsigned G = gridDim.x * gridDim.y * gridDim.z;
    unsigned sum, cnt, mine, sp = 0u;
    for (;;) {
        sum = 0u; cnt = 0u; mine = 0u;
#pragma unroll
        for (unsigned j = 0; j < 16; ++j) { const unsigned c = xb_ld(&bar[XB_XCNT(j)]); sum += c; cnt += (c > 0u) ? 1u : 0u; mine = (j == x) ? c : mine; }
        if (sum == G) break;
        __builtin_amdgcn_s_sleep(1);
        if ((++sp & 255u) == 0u) { if (xb_ld(&bar[XB_TMO])) break; if (sp > XB_SPIN_CAP) { atomicAdd(&bar[XB_TMO], 1u); break; } }
    }
    nloc = mine > 0u ? mine : 1u; nx = cnt > 0u ? cnt : 1u;
}

__device__ __forceinline__ void xcd_barrier(const XcdBarrier& b) {
    asm volatile("s_waitcnt vmcnt(0)" ::: "memory");
    __syncthreads();
    if (threadIdx.x == 0) {
        unsigned* bar = b.bar; const unsigned bx_ = xb_xcc_id();
        __builtin_amdgcn_s_waitcnt(0);
        unsigned nloc = b.st[0], nx = b.st[1];
        if (nloc == 0u) { xcd_barrier_complete(bar, bx_, nloc, nx); b.st[0] = nloc; b.st[1] = nx; }
        const unsigned old = xb_add(&bar[XB_XSUB(bx_)], 1u);
        const unsigned gen = old / nloc;
        if (old + 1u == (gen + 1u) * nloc) {
            __builtin_amdgcn_fence(__ATOMIC_RELEASE, "agent");
            asm volatile("s_waitcnt vmcnt(0)" ::: "memory");
            const unsigned og = xb_add(&bar[XB_TOP], 1u);
            const unsigned tg = og / nx;
            if (og + 1u == (tg + 1u) * nx) xb_add(&bar[XB_TOPGEN], 1u);
            else XB_SPIN(xb_ld(&bar[XB_TOPGEN]) == tg, bar);
            __builtin_amdgcn_fence(__ATOMIC_ACQUIRE, "agent");
            xb_add(&bar[XB_XGEN(bx_)], 1u);
            asm volatile("s_waitcnt vmcnt(0)" ::: "memory");
        } else {
            XB_SPIN(xb_ld(&bar[XB_XGEN(bx_)]) == gen, bar);
            __builtin_amdgcn_fence(__ATOMIC_ACQUIRE, "agent");
            asm volatile("s_waitcnt vmcnt(0)" ::: "memory");
        }
    }
    __syncthreads();
}
namespace pg8 {
#define PG8_LAS __attribute__((address_space(3)))
typedef unsigned short bf16_t;
typedef short bf16x8 __attribute__((ext_vector_type(8)));
typedef float f32x4 __attribute__((ext_vector_type(4)));
typedef unsigned u32x4 __attribute__((ext_vector_type(4)));
constexpr int BM = 256, BK = 64, HALF = 128, HTB = HALF * BK * 2  , STAGE_BYTES = 8 * HTB, NXCD = 8;
#ifndef PG8_WGM
#define PG8_WGM 8
#endif
constexpr int WGM = PG8_WGM;

__host__ __device__ __forceinline__ int lds_byte(int r, int c) { const int st = (r >> 4) * 2 + (c >> 5), rr = r & 15, cc = c & 31, ob = rr * 64 + cc * 2; return st * 1024 + (ob ^ (((ob >> 9) & 1) << 5)); }
__host__ __device__ __forceinline__ void stage_rc(int b, int& R, int& C) { const int st = b / 1024, sb = b % 1024, swz = sb ^ (((sb >> 9) & 1) << 5); R = (st >> 1) * 16 + swz / 64; C = (st & 1) * 32 + (swz % 64) / 2; }
__host__ __device__ __forceinline__ int perm32(int rho) { const int n = rho >> 4, i = rho & 15; return 8 * (i >> 2) + 4 * n + (i & 3); }

struct Unit { int pm, pn; };
struct Gemm { const bf16_t* A; const bf16_t* Bt; int M, N, K; };

struct StaticOrder {
    int nM, nN, nwg, G, c;
    __host__ __device__ void init(int M, int N, int G_, int c_) { nM = M / BM; nN = N / BM; nwg = nM * nN; G = G_; c = c_; }
    __host__ __device__ bool next(int i, Unit& u) const {
        const long L = (long)i * G + c; if (L >= nwg) return false;
        int wgid = (int)L; { const int q = nwg / NXCD, r = nwg % NXCD, xcd = wgid % NXCD, off = wgid / NXCD; wgid = (xcd < r ? xcd * (q + 1) : r * (q + 1) + (xcd - r) * q) + off; }
        const int nig = WGM * nN, gid = wgid / nig, fm = gid * WGM, gsz = (nM - fm) < WGM ? (nM - fm) : WGM;
        u.pm = fm + ((wgid % nig) % gsz); u.pn = (wgid % nig) / gsz; return true;
    }
    __device__ __forceinline__ void a_ready(const Unit&) const {}
    __device__ __forceinline__ void done(const Unit&) const {}
};

struct LimitOrder {
    StaticOrder base; int maxr;
    __device__ bool next(int i, Unit& u) const { return i < maxr && base.next(i, u); }
    __device__ __forceinline__ void a_ready(const Unit&) const {}
    __device__ __forceinline__ void done(const Unit&) const {}
};

typedef float f32x2c_t __attribute__((ext_vector_type(2))); typedef __bf16 bf16x2c_t __attribute__((ext_vector_type(2)));
__device__ __forceinline__ unsigned cvt_pk_bf16(float lo, float hi) { const f32x2c_t v = {lo, hi}; const bf16x2c_t b = __builtin_convertvector(v, bf16x2c_t); return __builtin_bit_cast(unsigned, b); }
typedef float f32x2 __attribute__((ext_vector_type(2)));

constexpr float K_EPS = 1e-6f;
#ifdef NT_RES
#define PG8_LD1(p) __builtin_nontemporal_load(p)
#else
#define PG8_LD1(p) (*(p))
#endif
#ifdef EPI_DRY
#define PG8_ST(T, p, v) do { const T v__ = (v); asm volatile("" :: "v"(v__)); if (!dry) *(T*)(p) = v__; } while (0)
#elif defined(EPI_NT)
#define PG8_ST(T, p, v) __builtin_nontemporal_store((v), (T*)(p))
#else
#define PG8_ST(T, p, v) (*(T*)(p) = (v))
#endif
__device__ __forceinline__ float silu_f(float v) { return v * __builtin_amdgcn_rcpf(1.f + __expf(-v)); }
__device__ __forceinline__ unsigned pk_f16(float lo, float hi) { const _Float16 a = (_Float16)lo, b = (_Float16)hi; return (unsigned)__builtin_bit_cast(unsigned short, a) | ((unsigned)__builtin_bit_cast(unsigned short, b) << 16); }

struct EpiWin {
    static constexpr bool PERM = true, AFTER_DRAIN = false, STAGED = true; static constexpr int NSTORE = 16;
    bf16_t* proj;
    const float* ssum;
    const float* shw;
    const float2* tab;
    const float* lbw;
    int layer;
    PG8_LAS unsigned char* stage;
    int pn_off;
    __device__ __forceinline__ void prefetch(const Unit& u, int ui, int wid, int lane) const {
        const float* src = wid < 4 ? ssum + u.pm * BM + 64 * wid + lane : shw + (size_t)(u.pm >> 3) * 3584 + (u.pn + pn_off) * BM + 64 * (wid - 4) + lane;
        __builtin_amdgcn_global_load_lds((const unsigned*)src, (PG8_LAS unsigned*)(stage + (ui & 1) * 2048 + wid * 256), 4, 0, 0);
    }
    __device__ __forceinline__ void operator()(const f32x4 (&acc)[2][2][4][2], const Unit& u, int wr, int wc, int fr_in, int fq_in, int ui, bool dry = false) const {
        int fr = fr_in, fq = fq_in; asm volatile("" : "+v"(fr), "+v"(fq));
        const int b = u.pm >> 3, pn = u.pn + pn_off;
        const int colb = pn * BM + wc * 32 + 8 * fq;
        const PG8_LAS float* SS = (const PG8_LAS float*)(stage + (ui & 1) * 2048); const PG8_LAS float* SV = SS + 256;
#ifdef EPI_RSPRE
        float rsv[2][4];
#pragma unroll
        for (int ai = 0; ai < 2; ++ai)
#pragma unroll
            for (int m = 0; m < 4; ++m) rsv[ai][m] = SS[ai * HALF + wr * 64 + m * 16 + fr];
#pragma unroll
        for (int ai = 0; ai < 2; ++ai)
#pragma unroll
            for (int m = 0; m < 4; ++m) rsv[ai][m] = __builtin_amdgcn_rsqf(rsv[ai][m] * (1.f / 1024.f) + K_EPS);
#endif
        const int type = pn == 0 ? 0 : pn == 1 ? 1 : (pn == 2 || pn == 3 || pn == 10 || pn == 11) ? 2 : (pn == 8 || pn == 9) ? 4 : 3;
        f32x4 sv[2][2];
#pragma unroll
        for (int bj = 0; bj < 2; ++bj)
#pragma unroll
            for (int n = 0; n < 2; ++n) sv[bj][n] = *(const PG8_LAS f32x4*)(SV + bj * HALF + wc * 32 + 8 * fq + 4 * n);
        float lb[2][8];
#pragma unroll
        for (int bj = 0; bj < 2; ++bj)
#pragma unroll
            for (int i = 0; i < 8; ++i) lb[bj][i] = 0.f;
        if (type == 4 && layer != 0) {
#pragma unroll
            for (int bj = 0; bj < 2; ++bj)
#pragma unroll
                for (int i = 0; i < 8; ++i) { const int c = colb + bj * HALF + i - 2048; lb[bj][i] = __builtin_amdgcn_rcpf(1.f + __expf(lbw[c] - lbw[512 + c])); }
        }
        if (type <= 1) {
            const float sc = type == 1 ? 0.125f : 1.f;
#pragma unroll
            for (int ap = 0; ap < 4; ++ap) { const int ai = ap >> 1, m0 = (ap & 1) * 2;
                f32x4 tb[2][2][2];
#pragma unroll
                for (int mm = 0; mm < 2; ++mm)
#pragma unroll
                    for (int bj = 0; bj < 2; ++bj) { const int pos = (u.pm * BM + ai * HALF + wr * 64 + (m0 + mm) * 16 + fr) & 2047, i0 = ((colb + bj * HALF) & 63) >> 1;
                        tb[mm][bj][0] = *(const f32x4*)(tab + pos * 32 + i0); tb[mm][bj][1] = *(const f32x4*)(tab + pos * 32 + i0 + 2); }
#pragma unroll
                for (int mm = 0; mm < 2; ++mm) { const int m = m0 + mm; const int row = u.pm * BM + ai * HALF + wr * 64 + m * 16 + fr;
#ifdef EPI_RSPRE
                    const float rs = rsv[ai][m];
#else
                    const float rs = __builtin_amdgcn_rsqf(SS[ai * HALF + wr * 64 + m * 16 + fr] * (1.f / 1024.f) + K_EPS);
#endif
#pragma unroll
                    for (int bj = 0; bj < 2; ++bj) {
                        const f32x4 v0 = acc[ai][bj][m][0] * rs + sv[bj][0], v1 = acc[ai][bj][m][1] * rs + sv[bj][1];
                        const f32x4 t0 = tb[mm][bj][0], t1 = tb[mm][bj][1];
                        float o[8];
                        o[0] = (v0[0] * t0[0] - v0[1] * t0[1]) * sc; o[1] = (v0[0] * t0[1] + v0[1] * t0[0]) * sc;
                        o[2] = (v0[2] * t0[2] - v0[3] * t0[3]) * sc; o[3] = (v0[2] * t0[3] + v0[3] * t0[2]) * sc;
                        o[4] = (v1[0] * t1[0] - v1[1] * t1[1]) * sc; o[5] = (v1[0] * t1[1] + v1[1] * t1[0]) * sc;
                        o[6] = (v1[2] * t1[2] - v1[3] * t1[3]) * sc; o[7] = (v1[2] * t1[3] + v1[3] * t1[2]) * sc;
                        u32x4 w; w.x = cvt_pk_bf16(o[0], o[1]); w.y = cvt_pk_bf16(o[2], o[3]); w.z = cvt_pk_bf16(o[4], o[5]); w.w = cvt_pk_bf16(o[6], o[7]);
                        PG8_ST(u32x4, proj + (size_t)row * 3584 + colb + bj * HALF, w);
                    }
                }
                asm volatile("" ::: "memory");
            }
            return;
        }
#pragma unroll
        for (int ai = 0; ai < 2; ++ai)
#pragma unroll
            for (int m = 0; m < 4; ++m) {
                const int row = u.pm * BM + ai * HALF + wr * 64 + m * 16 + fr;
#ifdef EPI_RSPRE
                const float rs = rsv[ai][m];
#else
                const float rs = __builtin_amdgcn_rsqf(SS[ai * HALF + wr * 64 + m * 16 + fr] * (1.f / 1024.f) + K_EPS);
#endif
                const int pos = row & 2047;
#pragma unroll
                for (int bj = 0; bj < 2; ++bj) {
                    float v[8];
                    {   const f32x4 v0 = acc[ai][bj][m][0] * rs + sv[bj][0], v1 = acc[ai][bj][m][1] * rs + sv[bj][1];
                        v[0] = v0[0]; v[1] = v0[1]; v[2] = v0[2]; v[3] = v0[3]; v[4] = v1[0]; v[5] = v1[1]; v[6] = v1[2]; v[7] = v1[3]; }
                    u32x4 w;
                    if (type == 2) {
                        w.x = cvt_pk_bf16(v[0], v[1]); w.y = cvt_pk_bf16(v[2], v[3]); w.z = cvt_pk_bf16(v[4], v[5]); w.w = cvt_pk_bf16(v[6], v[7]);
                    } else if (type == 3) {
                        unsigned wv[4];
#pragma unroll
                        for (int q = 0; q < 4; ++q) { const f32x2 x = (f32x2){v[2 * q], v[2 * q + 1]}, xn = x * (-1.44269504089f);
                            f32x2 e; e.x = __builtin_amdgcn_exp2f(xn.x); e.y = __builtin_amdgcn_exp2f(xn.y);
                            const f32x2 d = e + 1.0f; f32x2 r; r.x = __builtin_amdgcn_rcpf(d.x); r.y = __builtin_amdgcn_rcpf(d.y);
                            const f32x2 o = x * r; wv[q] = cvt_pk_bf16(o.x, o.y); }
                        w.x = wv[0]; w.y = wv[1]; w.z = wv[2]; w.w = wv[3];
                    } else {
                        float g[8];
                        if (layer == 0) {
#pragma unroll
                            for (int i = 0; i < 8; ++i) g[i] = fminf(v[i], 0.f) - __logf(1.f + __expf(-fabsf(v[i])));
                        } else {
#pragma unroll
                            for (int i = 0; i < 8; ++i) { const float s = __builtin_amdgcn_rcpf(1.f + __expf(-v[i])); g[i] = __logf(lb[bj][i] + (1.f - lb[bj][i]) * s); }
                        }
                        w.x = pk_f16(g[0], g[1]); w.y = pk_f16(g[2], g[3]); w.z = pk_f16(g[4], g[5]); w.w = pk_f16(g[6], g[7]);
                    }
                    PG8_ST(u32x4, proj + (size_t)row * 3584 + colb + bj * HALF, w);
                }
            }
    }
};

__device__ __forceinline__ float f16lo(unsigned w) { return (float)__builtin_bit_cast(_Float16, (unsigned short)(w & 0xffffu)); }
__device__ __forceinline__ float f16hi(unsigned w) { return (float)__builtin_bit_cast(_Float16, (unsigned short)(w >> 16)); }
template <bool XF32> struct EpiRes {
    static constexpr bool PERM = true, AFTER_DRAIN = false, STAGED = false; static constexpr int NSTORE = 0;
    const void* xres; bf16_t* xout;
    const float* gvec;
    const float* nw; const float* scv;
    bf16_t* anext;
    float* ssum;
    __device__ __forceinline__ void operator()(const f32x4 (&acc)[2][2][4][2], const Unit& u, int wr, int wc, int fr_in, int fq_in) const {
        int fr = fr_in, fq = fq_in; asm volatile("" : "+v"(fr), "+v"(fq));
#ifdef EPI_DRY
        const bool dry = false;
#endif
        const int b = u.pm >> 3;
        const int colb = u.pn * BM + wc * 32 + 8 * fq;
        f32x4 gv[2][2], wm[2][2];
#pragma unroll
        for (int bj = 0; bj < 2; ++bj)
#pragma unroll
            for (int n = 0; n < 2; ++n) {
                const int c = colb + bj * HALF + 4 * n;
                gv[bj][n] = *(const f32x4*)(gvec + (size_t)b * 6144 + c);
                wm[bj][n] = nw ? (*(const f32x4*)(nw + c)) * (1.f + *(const f32x4*)(scv + (size_t)b * 6144 + c)) : (f32x4){0.f, 0.f, 0.f, 0.f};
            }
#pragma unroll
        for (int ap = 0; ap < 4; ++ap) { const int ai = ap >> 1, m0 = (ap & 1) * 2;
            f32x4 pre[2][2][2];
#pragma unroll
            for (int mm = 0; mm < 2; ++mm)
#pragma unroll
                for (int bj = 0; bj < 2; ++bj) { const size_t off = (size_t)(u.pm * BM + ai * HALF + wr * 64 + (m0 + mm) * 16 + fr) * 1024 + colb + bj * HALF;
                    if constexpr (XF32) { pre[mm][bj][0] = *(const f32x4*)((const float*)xres + off); pre[mm][bj][1] = *(const f32x4*)((const float*)xres + off + 4); }
                    else { const u32x4 h = *(const u32x4*)((const bf16_t*)xres + off); pre[mm][bj][0] = __builtin_bit_cast(f32x4, h); } }
#pragma unroll
            for (int mm = 0; mm < 2; ++mm) { const int m = m0 + mm;
                const int row = u.pm * BM + ai * HALF + wr * 64 + m * 16 + fr;
                float ss = 0.f;
#pragma unroll
                for (int bj = 0; bj < 2; ++bj) {
                    const size_t off = (size_t)row * 1024 + colb + bj * HALF;
                    f32x4 r0, r1;
                    if constexpr (XF32) { r0 = pre[mm][bj][0]; r1 = pre[mm][bj][1]; }
                    else { const u32x4 h = __builtin_bit_cast(u32x4, pre[mm][bj][0]); r0 = (f32x4){f16lo(h.x), f16hi(h.x), f16lo(h.y), f16hi(h.y)}; r1 = (f32x4){f16lo(h.z), f16hi(h.z), f16lo(h.w), f16hi(h.w)}; }
                    const f32x4 x0 = r0 + gv[bj][0] * acc[ai][bj][m][0], x1 = r1 + gv[bj][1] * acc[ai][bj][m][1];
                    { u32x4 hx; hx.x = pk_f16(x0[0], x0[1]); hx.y = pk_f16(x0[2], x0[3]); hx.z = pk_f16(x1[0], x1[1]); hx.w = pk_f16(x1[2], x1[3]); PG8_ST(u32x4, xout + off, hx); }
                    ss += (x0[0] * x0[0] + x0[1] * x0[1]) + (x0[2] * x0[2] + x0[3] * x0[3]) + (x1[0] * x1[0] + x1[1] * x1[1]) + (x1[2] * x1[2] + x1[3] * x1[3]);
                    if (nw) { const f32x4 a0 = x0 * wm[bj][0], a1 = x1 * wm[bj][1]; u32x4 w; w.x = cvt_pk_bf16(a0[0], a0[1]); w.y = cvt_pk_bf16(a0[2], a0[3]); w.z = cvt_pk_bf16(a1[0], a1[1]); w.w = cvt_pk_bf16(a1[2], a1[3]);
                        PG8_ST(u32x4, anext + off, w); }
                }
                ss += __shfl_xor(ss, 16); ss += __shfl_xor(ss, 32);
                if (fq == 0) atomicAdd(ssum + row, ss);
#ifdef DUP_SSATOM
                if (fq == 0) atomicAdd(ssum + row, 0.f);
#endif
            }
            asm volatile("" ::: "memory");
        }
    }
};

struct EpiFinal {
    static constexpr bool PERM = true, AFTER_DRAIN = true, STAGED = false; static constexpr int NSTORE = 0;
    const bf16_t* xres; float* out; const float* gvec; const float* fw; float* ssum; const XcdBarrier* bar;
    __device__ __forceinline__ void fused(f32x4 (&acc)[2][2][4][2], const Unit& u, int wr, int wc, int fr_in, int fq_in, PG8_LAS unsigned char* lds, int wid, int lane) const {
        int fr = fr_in, fq = fq_in; asm volatile("" : "+v"(fr), "+v"(fq));
        const int b = u.pm >> 3;
        const int colb = u.pn * BM + wc * 32 + 8 * fq;
        {
            f32x4 gv[2][2];
#pragma unroll
            for (int bj = 0; bj < 2; ++bj)
#pragma unroll
                for (int n = 0; n < 2; ++n) gv[bj][n] = *(const f32x4*)(gvec + (size_t)b * 6144 + colb + bj * HALF + 4 * n);
#pragma unroll
            for (int ai = 0; ai < 2; ++ai) {
                u32x4 pre[4][2];
#pragma unroll
                for (int m = 0; m < 4; ++m)
#pragma unroll
                    for (int bj = 0; bj < 2; ++bj) pre[m][bj] = *(const u32x4*)(xres + (size_t)(u.pm * BM + ai * HALF + wr * 64 + m * 16 + fr) * 1024 + colb + bj * HALF);
#pragma unroll
                for (int m = 0; m < 4; ++m) {
                    const int row = u.pm * BM + ai * HALF + wr * 64 + m * 16 + fr;
                    float ss = 0.f;
#pragma unroll
                    for (int bj = 0; bj < 2; ++bj) {
                        const u32x4 h = pre[m][bj];
                        const f32x4 r0 = (f32x4){f16lo(h.x), f16hi(h.x), f16lo(h.y), f16hi(h.y)}, r1 = (f32x4){f16lo(h.z), f16hi(h.z), f16lo(h.w), f16hi(h.w)};
                        const f32x4 x0 = r0 + gv[bj][0] * acc[ai][bj][m][0], x1 = r1 + gv[bj][1] * acc[ai][bj][m][1];
                        acc[ai][bj][m][0] = x0; acc[ai][bj][m][1] = x1;
                        ss += (x0[0] * x0[0] + x0[1] * x0[1]) + (x0[2] * x0[2] + x0[3] * x0[3]) + (x1[0] * x1[0] + x1[1] * x1[1]) + (x1[2] * x1[2] + x1[3] * x1[3]);
                    }
                    ss += __shfl_xor(ss, 16); ss += __shfl_xor(ss, 32);
                    if (fq == 0) atomicAdd(ssum + row, ss);
#ifdef DUP_SSATOM
                if (fq == 0) atomicAdd(ssum + row, 0.f);
#endif
                }
                asm volatile("" ::: "memory");
            }
        }
        xcd_barrier(*bar);
        f32x4 fv[2][2];
#pragma unroll
        for (int bj = 0; bj < 2; ++bj)
#pragma unroll
            for (int n = 0; n < 2; ++n) fv[bj][n] = *(const f32x4*)(fw + colb + bj * HALF + 4 * n);
        float sq[2][4];
#pragma unroll
        for (int ai = 0; ai < 2; ++ai)
#pragma unroll
            for (int m = 0; m < 4; ++m) sq[ai][m] = __hip_atomic_load(ssum + u.pm * BM + ai * HALF + wr * 64 + m * 16 + fr, __ATOMIC_RELAXED, __HIP_MEMORY_SCOPE_AGENT);
#pragma unroll
        for (int ai = 0; ai < 2; ++ai)
#pragma unroll
            for (int m = 0; m < 4; ++m) {
                const int row = u.pm * BM + ai * HALF + wr * 64 + m * 16 + fr;
                const float rs = __builtin_amdgcn_rsqf(sq[ai][m] * (1.f / 1024.f) + K_EPS);
#pragma unroll
                for (int bj = 0; bj < 2; ++bj) {
                    const size_t off = (size_t)row * 1024 + colb + bj * HALF;
                    *(f32x4*)(out + off) = acc[ai][bj][m][0] * rs * fv[bj][0]; *(f32x4*)(out + off + 4) = acc[ai][bj][m][1] * rs * fv[bj][1];
                }
            }
    }
};

struct EpiFfn {
    static constexpr bool PERM = true, AFTER_DRAIN = false, STAGED = true; static constexpr int NSTORE = 8;
    bf16_t* act; const float* ssum; const float* shw;
    PG8_LAS unsigned char* stage;
    __device__ __forceinline__ void prefetch(const Unit& u, int ui, int wid, int lane) const {
        const float* src = wid < 4 ? ssum + u.pm * BM + 64 * wid + lane : shw + (size_t)(u.pm >> 3) * 5632 + u.pn * BM + 64 * (wid - 4) + lane;
        __builtin_amdgcn_global_load_lds((const unsigned*)src, (PG8_LAS unsigned*)(stage + (ui & 1) * 2048 + wid * 256), 4, 0, 0);
    }
    __device__ __forceinline__ void operator()(const f32x4 (&acc)[2][2][4][2], const Unit& u, int wr, int wc, int fr_in, int fq_in, int ui, bool dry = false) const {
        int fr = fr_in, fq = fq_in; asm volatile("" : "+v"(fr), "+v"(fq));
        const int cl = wc * 32 + 8 * fq;
        const PG8_LAS float* SS = (const PG8_LAS float*)(stage + (ui & 1) * 2048); const PG8_LAS float* SV = SS + 256;
#ifdef EPI_RSPRE
        float rsv[2][4];
#pragma unroll
        for (int ai = 0; ai < 2; ++ai)
#pragma unroll
            for (int m = 0; m < 4; ++m) rsv[ai][m] = SS[ai * HALF + wr * 64 + m * 16 + fr];
#pragma unroll
        for (int ai = 0; ai < 2; ++ai)
#pragma unroll
            for (int m = 0; m < 4; ++m) rsv[ai][m] = __builtin_amdgcn_rsqf(rsv[ai][m] * (1.f / 1024.f) + K_EPS);
#endif
        f32x2 sg[4], sgn[4], su[4];
#pragma unroll
        for (int n = 0; n < 2; ++n) { const f32x4 a = *(const PG8_LAS f32x4*)(SV + cl + 4 * n), c = *(const PG8_LAS f32x4*)(SV + HALF + cl + 4 * n);
            sg[2 * n] = (f32x2){a[0], a[1]}; sg[2 * n + 1] = (f32x2){a[2], a[3]}; su[2 * n] = (f32x2){c[0], c[1]}; su[2 * n + 1] = (f32x2){c[2], c[3]}; }
#pragma unroll
        for (int q = 0; q < 4; ++q) sgn[q] = sg[q] * (-1.44269504089f);
#pragma unroll
        for (int ai = 0; ai < 2; ++ai)
#pragma unroll
            for (int m = 0; m < 4; ++m) {
                const int row = u.pm * BM + ai * HALF + wr * 64 + m * 16 + fr;
#ifdef EPI_RSPRE
                const float rs = rsv[ai][m], nrs = rs * (-1.44269504089f);
#else
                const float rs = __builtin_amdgcn_rsqf(SS[ai * HALF + wr * 64 + m * 16 + fr] * (1.f / 1024.f) + K_EPS), nrs = rs * (-1.44269504089f);
#endif
                unsigned wv[4];
#pragma unroll
                for (int q = 0; q < 4; ++q) {
                    const f32x4 ag4 = acc[ai][0][m][q >> 1], au4 = acc[ai][1][m][q >> 1];
                    const f32x2 ag = (q & 1) ? (f32x2){ag4[2], ag4[3]} : (f32x2){ag4[0], ag4[1]}, au = (q & 1) ? (f32x2){au4[2], au4[3]} : (f32x2){au4[0], au4[1]};
                    const f32x2 g = ag * rs + sg[q], gn = ag * nrs + sgn[q], uu = au * rs + su[q];
                    f32x2 e; e.x = __builtin_amdgcn_exp2f(gn.x); e.y = __builtin_amdgcn_exp2f(gn.y);
                    const f32x2 d = e + 1.0f;
                    f32x2 r; r.x = __builtin_amdgcn_rcpf(d.x); r.y = __builtin_amdgcn_rcpf(d.y);
                    const f32x2 o = (g * uu) * r;
                    wv[q] = cvt_pk_bf16(o.x, o.y);
                }
                u32x4 w; w.x = wv[0]; w.y = wv[1]; w.z = wv[2]; w.w = wv[3];
                PG8_ST(u32x4, act + (size_t)row * 2816 + u.pn * HALF + cl, w);
            }
    }
#ifdef HALF_TAIL
    __device__ __forceinline__ void half_epi(const f32x4 (&acc)[2][4][2], const Unit& u, int half, int wr, int wc, int fr_in, int fq_in, int ui) const {
        int fr = fr_in, fq = fq_in; asm volatile("" : "+v"(fr), "+v"(fq));
        const int cl = wc * 32 + 8 * fq;
        const PG8_LAS float* SS = (const PG8_LAS float*)(stage + (ui & 1) * 2048); const PG8_LAS float* SV = SS + 256;
        f32x2 sg[4], sgn[4], su[4];
#pragma unroll
        for (int n = 0; n < 2; ++n) { const f32x4 a = *(const PG8_LAS f32x4*)(SV + cl + 4 * n), c = *(const PG8_LAS f32x4*)(SV + HALF + cl + 4 * n);
            sg[2 * n] = (f32x2){a[0], a[1]}; sg[2 * n + 1] = (f32x2){a[2], a[3]}; su[2 * n] = (f32x2){c[0], c[1]}; su[2 * n + 1] = (f32x2){c[2], c[3]}; }
#pragma unroll
        for (int q = 0; q < 4; ++q) sgn[q] = sg[q] * (-1.44269504089f);
#pragma unroll
        for (int m = 0; m < 4; ++m) {
            const int rl = half * HALF + wr * 64 + m * 16 + fr, row = u.pm * BM + rl;
            const float rs = __builtin_amdgcn_rsqf(SS[rl] * (1.f / 1024.f) + K_EPS), nrs = rs * (-1.44269504089f);
            unsigned wv[4];
#pragma unroll
            for (int q = 0; q < 4; ++q) {
                const f32x4 ag4 = acc[0][m][q >> 1], au4 = acc[1][m][q >> 1];
                const f32x2 ag = (q & 1) ? (f32x2){ag4[2], ag4[3]} : (f32x2){ag4[0], ag4[1]}, au = (q & 1) ? (f32x2){au4[2], au4[3]} : (f32x2){au4[0], au4[1]};
                const f32x2 g = ag * rs + sg[q], gn = ag * nrs + sgn[q], uu = au * rs + su[q];
                f32x2 e; e.x = __builtin_amdgcn_exp2f(gn.x); e.y = __builtin_amdgcn_exp2f(gn.y);
                const f32x2 d = e + 1.0f;
                f32x2 r; r.x = __builtin_amdgcn_rcpf(d.x); r.y = __builtin_amdgcn_rcpf(d.y);
                const f32x2 o = (g * uu) * r;
                wv[q] = cvt_pk_bf16(o.x, o.y);
            }
            u32x4 w; w.x = wv[0]; w.y = wv[1]; w.z = wv[2]; w.w = wv[3];
            *(u32x4*)(act + (size_t)row * 2816 + u.pn * HALF + cl) = w;
        }
    }
#endif
};

template <class Epi, class Sched, bool ALIGN_EPI = false, bool SP2 = false>
__device__ __forceinline__ void gemm_phase(PG8_LAS unsigned char* lds, const Gemm g, const Sched& S, const Epi& E) {
    int tid_l = threadIdx.x; asm volatile("" : "+v"(tid_l));
    const int tid = tid_l, wid = __builtin_amdgcn_readfirstlane(tid >> 6), lane = tid & 63, wr = wid >> 2, wc = wid & 3, fr = lane & 15, fq = lane >> 4;
#ifdef DUP_K
    const int K = g.K, nt0 = K / BK, nt = 2 * nt0;
#ifdef DUP_KHIT
#define PG8_TW(t) ((((t) >> 2) << 1) | ((t) & 1))
#else
#define PG8_TW(t) ((t) % nt0)
#endif
#else
    const int K = g.K, nt = K / BK;
#define PG8_TW(t) (t)
#endif
    unsigned voffA[2], voffB[2];
#pragma unroll
    for (int i = 0; i < 2; ++i) { int R, C; stage_rc(tid * 16 + i * 8192, R, C); const int Rb = Epi::PERM ? ((R & ~31) + perm32(R & 31)) : R;
        voffA[i] = (unsigned)(R * K + C) * 2u; voffB[i] = (unsigned)(Rb * K + C) * 2u; }
    const size_t kstep = (size_t)(BK * 2);
    const size_t hstep = (size_t)HALF * K * 2;
    const size_t tstep = 2 * hstep;
    const unsigned ldsw = (unsigned)wid * 1024u;
    const int aoff = lds_byte(wr * 64 + fr, fq * 8), boff = lds_byte(wc * 32 + fr, fq * 8);
#define PG8_SA(b, h) (((b) * 2 + (h)) * HTB)
#define PG8_SB(b, h) ((4 + (b) * 2 + (h)) * HTB)
#define PG8_STAGE(bufoff, gbase, voff) do { _Pragma("unroll") for (int _i = 0; _i < 2; ++_i) \
        __builtin_amdgcn_global_load_lds((const unsigned*)((const char*)(gbase) + (voff)[_i]), (PG8_LAS unsigned*)(lds + (bufoff) + ldsw + _i * 8192), 16, 0, 0); } while (0)
#define PG8_LDA(dst, b, h) do { _Pragma("unroll") for (int m = 0; m < 4; ++m) _Pragma("unroll") for (int k = 0; k < 2; ++k) dst[m][k] = *(const PG8_LAS bf16x8*)(lds + PG8_SA(b, h) + aoff + m * 2048 + k * 1024); } while (0)
#define PG8_LDB(dst, b, h) do { _Pragma("unroll") for (int n = 0; n < 2; ++n) _Pragma("unroll") for (int k = 0; k < 2; ++k) dst[n][k] = *(const PG8_LAS bf16x8*)(lds + PG8_SB(b, h) + boff + n * 2048 + k * 1024); } while (0)
#define PG8_MMA(ai, bj, At, Bt) do { __builtin_amdgcn_s_setprio(1); _Pragma("unroll") for (int m = 0; m < 4; ++m) _Pragma("unroll") for (int n = 0; n < 2; ++n) _Pragma("unroll") for (int k = 0; k < 2; ++k) \
        acc[ai][bj][m][n] = __builtin_amdgcn_mfma_f32_16x16x32_bf16(Bt[n][k], At[m][k], acc[ai][bj][m][n], 0, 0, 0); __builtin_amdgcn_s_setprio(0); } while (0)
#define PG8_WAIT_V(n) asm volatile("s_waitcnt vmcnt(" #n ")" ::: "memory")
#define PG8_WAIT_L(n) asm volatile("s_waitcnt lgkmcnt(" #n ")" ::: "memory")
#define PG8_BAR __builtin_amdgcn_s_barrier()
#define PG8_SCHED __builtin_amdgcn_sched_barrier(0)
    Unit cur, nxt; int ui = 0;
    if (!S.next(0, cur)) return;
    f32x4 acc[2][2][4][2];
#pragma unroll
    for (int a = 0; a < 2; ++a)
#pragma unroll
        for (int b = 0; b < 2; ++b)
#pragma unroll
            for (int m = 0; m < 4; ++m)
#pragma unroll
                for (int n = 0; n < 2; ++n) acc[a][b][m][n] = (f32x4){0.f, 0.f, 0.f, 0.f};
    bf16x8 At[4][2], B0[2][2], B1[2][2];
    const char* cA = (const char*)g.A + (size_t)cur.pm * tstep; const char* cB = (const char*)g.Bt + (size_t)cur.pn * tstep;
    S.a_ready(cur);
    if constexpr (SP2) {
        PG8_STAGE(PG8_SB(0, 0), cB, voffB); PG8_STAGE(PG8_SB(0, 1), cB + hstep, voffB); PG8_STAGE(PG8_SA(0, 0), cA, voffA); PG8_STAGE(PG8_SA(0, 1), cA + hstep, voffA);
        if (wr == 1) PG8_BAR;
        PG8_WAIT_V(2); PG8_BAR;
        PG8_STAGE(PG8_SB(1, 0), cB + kstep, voffB); PG8_STAGE(PG8_SA(1, 0), cA + kstep, voffA); PG8_STAGE(PG8_SB(1, 1), cB + hstep + kstep, voffB);
        PG8_WAIT_V(6); PG8_BAR;
    } else {
        PG8_STAGE(PG8_SB(0, 0), cB, voffB); PG8_STAGE(PG8_SA(0, 0), cA, voffA); PG8_STAGE(PG8_SB(0, 1), cB + hstep, voffB); PG8_STAGE(PG8_SA(0, 1), cA + hstep, voffA);
        if (wr == 1) PG8_BAR;
        PG8_WAIT_V(4); PG8_BAR;
        PG8_STAGE(PG8_SB(1, 0), cB + kstep, voffB); PG8_STAGE(PG8_SA(1, 0), cA + kstep, voffA); PG8_STAGE(PG8_SB(1, 1), cB + hstep + kstep, voffB);
        PG8_WAIT_V(6); PG8_BAR;
    }
    for (;;) {
        const bool has_next = S.next(ui + 1, nxt);
        const char* nA = has_next ? (const char*)g.A + (size_t)nxt.pm * tstep : cA; const char* nB = has_next ? (const char*)g.Bt + (size_t)nxt.pn * tstep : cB;
        if constexpr (Epi::STAGED) E.prefetch(cur, ui, wid, lane);
        for (int t = 0; t < nt; t += 2) {
            const bool last = (t == nt - 2);
            const char* a1 = cA + (size_t)PG8_TW(t + 1) * kstep;
            const char* a2 = last ? nA : cA + (size_t)PG8_TW(t + 2) * kstep; const char* b2 = last ? nB : cB + (size_t)PG8_TW(t + 2) * kstep;
            const char* a3 = a2 + kstep; const char* b3 = b2 + kstep;
            if (last && has_next) S.a_ready(nxt);
            if constexpr (SP2) {
            PG8_LDB(B0, 0, 0); PG8_LDB(B1, 0, 1); PG8_SCHED; PG8_LDA(At, 0, 0); PG8_STAGE(PG8_SA(1, 1), a1 + hstep, voffA);
            PG8_WAIT_V(8); PG8_WAIT_L(0); PG8_BAR; PG8_MMA(0, 0, At, B0); PG8_MMA(0, 1, At, B1); PG8_BAR; PG8_SCHED;
            PG8_LDA(At, 0, 1); PG8_STAGE(PG8_SB(0, 0), b2, voffB); PG8_STAGE(PG8_SB(0, 1), b2 + hstep, voffB); PG8_STAGE(PG8_SA(0, 0), a2, voffA);
            PG8_WAIT_V(8); PG8_WAIT_L(0); PG8_BAR; PG8_MMA(1, 0, At, B0); PG8_MMA(1, 1, At, B1); PG8_BAR; PG8_SCHED;
            PG8_LDB(B0, 1, 0); PG8_LDB(B1, 1, 1); PG8_SCHED; PG8_LDA(At, 1, 0); PG8_STAGE(PG8_SA(0, 1), a2 + hstep, voffA);
            PG8_WAIT_V(8); PG8_WAIT_L(0); PG8_BAR; PG8_MMA(0, 0, At, B0); PG8_MMA(0, 1, At, B1); PG8_BAR; PG8_SCHED;
            PG8_LDA(At, 1, 1); PG8_STAGE(PG8_SB(1, 0), b3, voffB); PG8_STAGE(PG8_SB(1, 1), b3 + hstep, voffB); PG8_STAGE(PG8_SA(1, 0), a3, voffA);
            PG8_WAIT_V(8); PG8_WAIT_L(0); PG8_BAR; PG8_MMA(1, 0, At, B0); PG8_MMA(1, 1, At, B1); PG8_BAR; PG8_SCHED;
            } else {
            PG8_LDB(B0, 0, 0); PG8_SCHED; PG8_LDA(At, 0, 0); PG8_STAGE(PG8_SA(1, 1), a1 + hstep, voffA);
            PG8_WAIT_L(8); PG8_BAR; PG8_WAIT_L(0); PG8_MMA(0, 0, At, B0); PG8_BAR; PG8_SCHED;
            PG8_LDB(B1, 0, 1); PG8_STAGE(PG8_SB(0, 0), b2, voffB);
            PG8_BAR; PG8_WAIT_L(0); PG8_MMA(0, 1, At, B1); PG8_BAR;
            PG8_LDA(At, 0, 1); PG8_STAGE(PG8_SA(0, 0), a2, voffA);
            PG8_BAR; PG8_WAIT_L(0); PG8_MMA(1, 0, At, B0); PG8_BAR; PG8_SCHED;
            PG8_STAGE(PG8_SB(0, 1), b2 + hstep, voffB);
            PG8_WAIT_V(6); PG8_BAR; PG8_MMA(1, 1, At, B1); PG8_BAR;
            PG8_LDB(B0, 1, 0); PG8_SCHED; PG8_LDA(At, 1, 0); PG8_STAGE(PG8_SA(0, 1), a2 + hstep, voffA);
            PG8_WAIT_L(8); PG8_BAR; PG8_WAIT_L(0); PG8_MMA(0, 0, At, B0); PG8_BAR; PG8_SCHED;
            PG8_LDB(B1, 1, 1); PG8_STAGE(PG8_SB(1, 0), b3, voffB);
            PG8_BAR; PG8_WAIT_L(0); PG8_MMA(0, 1, At, B1); PG8_BAR;
            PG8_LDA(At, 1, 1); PG8_STAGE(PG8_SA(1, 0), a3, voffA);
            PG8_BAR; PG8_WAIT_L(0); PG8_MMA(1, 0, At, B0); PG8_BAR; PG8_SCHED;
            PG8_STAGE(PG8_SB(1, 1), b3 + hstep, voffB);
            PG8_WAIT_V(6); PG8_BAR; PG8_MMA(1, 1, At, B1); PG8_BAR;
            }
        }
        if constexpr (ALIGN_EPI) { if (wr == 0) PG8_BAR; }
#ifdef DUP_K
#pragma unroll
        for (int a_ = 0; a_ < 2; ++a_)
#pragma unroll
            for (int b_ = 0; b_ < 2; ++b_)
#pragma unroll
                for (int m_ = 0; m_ < 4; ++m_)
#pragma unroll
                    for (int n_ = 0; n_ < 2; ++n_) acc[a_][b_][m_][n_] *= 0.5f;
#endif
#ifdef DUP_EPI2
#ifdef EPI_DRY
        if constexpr (!Epi::AFTER_DRAIN && Epi::STAGED) E(acc, cur, wr, wc, fr, fq, ui, __builtin_amdgcn_readfirstlane(ui) >= 0);
#else
        if constexpr (!Epi::AFTER_DRAIN && Epi::STAGED) E(acc, cur, wr, wc, fr, fq, ui);
#endif
#endif
        if constexpr (!Epi::AFTER_DRAIN) { if constexpr (Epi::STAGED) E(acc, cur, wr, wc, fr, fq, ui); else E(acc, cur, wr, wc, fr, fq); S.done(cur); }
        if (!has_next) break;
#pragma unroll
        for (int a = 0; a < 2; ++a)
#pragma unroll
            for (int b = 0; b < 2; ++b)
#pragma unroll
                for (int m = 0; m < 4; ++m)
#pragma unroll
                    for (int n = 0; n < 2; ++n) acc[a][b][m][n] = (f32x4){0.f, 0.f, 0.f, 0.f};
        cur = nxt; cA = nA; cB = nB; ++ui;
        if constexpr (ALIGN_EPI) { if (wr == 1) PG8_BAR; }
    }
    PG8_WAIT_V(0);
    if constexpr (!ALIGN_EPI) { if (wr == 0) PG8_BAR; }
    PG8_BAR;
    if constexpr (Epi::AFTER_DRAIN) { E.fused(acc, cur, wr, wc, fr, fq, lds, wid, lane); S.done(cur); }
#undef PG8_SA
#undef PG8_SB
#undef PG8_STAGE
#undef PG8_LDA
#undef PG8_LDB
#undef PG8_MMA
#undef PG8_WAIT_V
#undef PG8_WAIT_L
#undef PG8_BAR
#undef PG8_SCHED
}
#ifdef HALF_TAIL
template <class Epi>
__device__ __forceinline__ void gemm_half_unit(PG8_LAS unsigned char* lds, const Gemm g, const Unit u, const int half, const Epi& E, const int ui) {
    int tid_l = threadIdx.x; asm volatile("" : "+v"(tid_l));
    const int tid = tid_l, wid = __builtin_amdgcn_readfirstlane(tid >> 6), lane = tid & 63, wr = wid >> 2, wc = wid & 3, fr = lane & 15, fq = lane >> 4;
    const int K = g.K, nt = K / BK;
    unsigned voffA[2], voffB[2];
#pragma unroll
    for (int i = 0; i < 2; ++i) { int R, C; stage_rc(tid * 16 + i * 8192, R, C); const int Rb = Epi::PERM ? ((R & ~31) + perm32(R & 31)) : R;
        voffA[i] = (unsigned)(R * K + C) * 2u; voffB[i] = (unsigned)(Rb * K + C) * 2u; }
    const size_t kstep = (size_t)(BK * 2), hstep = (size_t)HALF * K * 2, tstep = 2 * hstep;
    const unsigned ldsw = (unsigned)wid * 1024u;
    const int aoff = lds_byte(wr * 64 + fr, fq * 8), boff = lds_byte(wc * 32 + fr, fq * 8);
#define PGH_A(q) ((q) * 3 * HTB)
#define PGH_B(q, h) ((q) * 3 * HTB + (1 + (h)) * HTB)
#define PGH_STAGE(bufoff, gbase, voff) do { _Pragma("unroll") for (int _i = 0; _i < 2; ++_i) \
        __builtin_amdgcn_global_load_lds((const unsigned*)((const char*)(gbase) + (voff)[_i]), (PG8_LAS unsigned*)(lds + (bufoff) + ldsw + _i * 8192), 16, 0, 0); } while (0)
#define PGH_TILE(q, kt) do { PGH_STAGE(PGH_B(q, 0), cB + (size_t)(kt) * kstep, voffB); PGH_STAGE(PGH_B(q, 1), cB + hstep + (size_t)(kt) * kstep, voffB); PGH_STAGE(PGH_A(q), cA + (size_t)(kt) * kstep, voffA); } while (0)
#define PGH_LDA(dst, off) do { _Pragma("unroll") for (int m = 0; m < 4; ++m) _Pragma("unroll") for (int k = 0; k < 2; ++k) dst[m][k] = *(const PG8_LAS bf16x8*)(lds + (off) + aoff + m * 2048 + k * 1024); } while (0)
#define PGH_LDB(dst, off) do { _Pragma("unroll") for (int n = 0; n < 2; ++n) _Pragma("unroll") for (int k = 0; k < 2; ++k) dst[n][k] = *(const PG8_LAS bf16x8*)(lds + (off) + boff + n * 2048 + k * 1024); } while (0)
#define PGH_MMA(bj, At, Bt) do { __builtin_amdgcn_s_setprio(1); _Pragma("unroll") for (int m = 0; m < 4; ++m) _Pragma("unroll") for (int n = 0; n < 2; ++n) _Pragma("unroll") for (int k = 0; k < 2; ++k) \
        acc[bj][m][n] = __builtin_amdgcn_mfma_f32_16x16x32_bf16(Bt[n][k], At[m][k], acc[bj][m][n], 0, 0, 0); __builtin_amdgcn_s_setprio(0); } while (0)
    f32x4 acc[2][4][2];
#pragma unroll
    for (int b = 0; b < 2; ++b)
#pragma unroll
        for (int m = 0; m < 4; ++m)
#pragma unroll
            for (int n = 0; n < 2; ++n) acc[b][m][n] = (f32x4){0.f, 0.f, 0.f, 0.f};
    bf16x8 At[4][2], B0[2][2], B1[2][2];
    const char* cA = (const char*)g.A + (size_t)u.pm * tstep + (size_t)half * hstep; const char* cB = (const char*)g.Bt + (size_t)u.pn * tstep;
    E.prefetch(u, ui, wid, lane);
    PGH_TILE(0, 0); PGH_TILE(1, 1);
    if (wr == 1) __builtin_amdgcn_s_barrier();
    asm volatile("s_waitcnt vmcnt(6)" ::: "memory");
    __builtin_amdgcn_s_barrier(); __builtin_amdgcn_s_barrier();
    for (int t = 0; t < nt; ++t) {
        const int q = t % 3, q2 = (t + 2) % 3;
        PGH_LDB(B0, PGH_B(q, 0)); PGH_LDB(B1, PGH_B(q, 1)); __builtin_amdgcn_sched_barrier(0); PGH_LDA(At, PGH_A(q));
        if (t + 2 < nt) { PGH_TILE(q2, t + 2); asm volatile("s_waitcnt vmcnt(6)" ::: "memory"); } else { asm volatile("s_waitcnt vmcnt(0)" ::: "memory"); }
        asm volatile("s_waitcnt lgkmcnt(0)" ::: "memory"); __builtin_amdgcn_s_barrier();
        PGH_MMA(0, At, B0); PGH_MMA(1, At, B1);
        __builtin_amdgcn_s_barrier(); __builtin_amdgcn_sched_barrier(0);
    }
    if (wr == 0) __builtin_amdgcn_s_barrier();
    E.half_epi(acc, u, half, wr, wc, fr, fq, ui);
#undef PGH_A
#undef PGH_B
#undef PGH_STAGE
#undef PGH_TILE
#undef PGH_LDA
#undef PGH_LDB
#undef PGH_MMA
}
#endif
}

constexpr int NWAVES = 8;
constexpr int D = 1024, BATCH = 8, SEQ = 2048, DEPTH = 2, M = BATCH * SEQ, INW = 3584, DFF = 2816, NMOD = 6, NCH = SEQ / 64;
constexpr float EPS = 1e-6f;
#ifndef CTL_MEMSET_MIB
#define CTL_MEMSET_MIB 1
#endif
constexpr size_t MiB = 1u << 20, KiB = 1u << 10;
constexpr size_t WS_CTL = 0, CTL_ZERO_BYTES = CTL_MEMSET_MIB * MiB;
constexpr size_t CTL_REGION = CTL_ZERO_BYTES;
constexpr size_t WS_MOD = 64 * KiB;
constexpr size_t WS_SSUM = 448 * KiB;
constexpr size_t WS_TAB = 1 * MiB;
constexpr size_t WS_SHW1 = WS_TAB + 512 * KiB;
constexpr size_t WS_SHW2 = WS_SHW1 + 2 * 8 * 3584 * 4;
constexpr size_t WS_BL = 3 * MiB;
constexpr size_t WS_W = 4 * MiB;
constexpr size_t W_IN_OFF = 0, W_OUT_OFF = (size_t)INW * D * 2, W_GU_OFF = W_OUT_OFF + (size_t)D * D * 2, W_DN_OFF = W_GU_OFF + (size_t)2 * DFF * D * 2, W_LAYER = W_DN_OFF + (size_t)DFF * D * 2;
constexpr size_t WS_A = 56 * MiB;
constexpr size_t WS_PROJ = 88 * MiB;
constexpr size_t WS_URET = 200 * MiB;
constexpr size_t WS_UHG = 216 * MiB;
constexpr size_t WS_A2 = 200 * MiB;
constexpr size_t WS_END = 248 * MiB;
static_assert(WS_SHW2 + 2 * 8 * 5632 * 4 <= WS_BL && WS_W + 2 * W_LAYER <= WS_A && WS_A + (size_t)M * D * 2 <= WS_PROJ && WS_PROJ + (size_t)M * INW * 2 <= WS_URET, "d_ws map");
static_assert(WS_MOD + 2 * 8 * 6144 * 4 <= WS_SSUM && WS_SSUM + 5 * M * 4 <= CTL_REGION, "ctl map");
constexpr int CW_BAR = 4096;
static_assert((CW_BAR + 3456) * 4 <= CTL_ZERO_BYTES, "barrier words inside the per-call memset");
constexpr int RING_BYTES = 131072;
#ifdef HALF_TAIL
constexpr int MISC_BASE = 147456;
constexpr int LDS_BYTES = 163840;
#else
constexpr int MISC_BASE = RING_BYTES;
constexpr int LDS_BYTES = 147456;
#endif
constexpr int LDSCTL_OFF = MISC_BASE, MISC_OFF = LDSCTL_OFF + 320;
constexpr int STAGE_OFF = MISC_BASE + 4096;

#define GAS __attribute__((address_space(1)))
#define LAS __attribute__((address_space(3)))
typedef unsigned short bf16;
typedef unsigned v4u __attribute__((ext_vector_type(4)));
typedef unsigned v2u __attribute__((ext_vector_type(2)));
typedef float f32x4 __attribute__((ext_vector_type(4)));
typedef short bf16x8 __attribute__((ext_vector_type(8)));
typedef GAS unsigned gu32;
#define RLX_AGENT __ATOMIC_RELAXED, __HIP_MEMORY_SCOPE_AGENT
#define LDS_WAIT() asm volatile("s_waitcnt lgkmcnt(0)" ::: "memory")
#ifdef NT_P4
#define LD_LAST(p) __builtin_nontemporal_load(p)
#else
#define LD_LAST(p) (*(p))
#endif
#if 1
#define LD_ONCE(p) __builtin_nontemporal_load(p)
#else
#define LD_ONCE(p) (*(p))
#endif
typedef float f32x2_t __attribute__((ext_vector_type(2)));
typedef __bf16 bf16x2_t __attribute__((ext_vector_type(2)));
__device__ __forceinline__ unsigned pk2(float lo, float hi) { const f32x2_t v = {lo, hi}; const bf16x2_t b = __builtin_convertvector(v, bf16x2_t); return __builtin_bit_cast(unsigned, b); }
__device__ __forceinline__ unsigned f2bf(float f) { return (unsigned)__builtin_bit_cast(unsigned short, (__bf16)f); }
__device__ __forceinline__ float bf2f(unsigned short u) { return __builtin_bit_cast(float, (unsigned)u << 16); }
__device__ __forceinline__ float h2f(unsigned short u) { return (float)__builtin_bit_cast(_Float16, u); }
__device__ __forceinline__ float dpp_f(float v, int ctrl_sel) {
    const int x = __builtin_bit_cast(int, v);
    int r;
    if (ctrl_sel == 0) r = __builtin_amdgcn_mov_dpp(x, 0xB1, 0xF, 0xF, true);
    else if (ctrl_sel == 1) r = __builtin_amdgcn_mov_dpp(x, 0x4E, 0xF, 0xF, true);
    else if (ctrl_sel == 2) r = __builtin_amdgcn_mov_dpp(x, 0x141, 0xF, 0xF, true);
    else r = __builtin_amdgcn_mov_dpp(x, 0x140, 0xF, 0xF, true);
    return __builtin_bit_cast(float, r);
}
__device__ __forceinline__ float row16_sum(float v) { v += dpp_f(v, 0); v += dpp_f(v, 1); v += dpp_f(v, 2); v += dpp_f(v, 3); return v; }
__device__ __forceinline__ float wave_sum(float v) {
    v = row16_sum(v);
    const int x = __builtin_bit_cast(int, v);
    return __builtin_bit_cast(float, __builtin_amdgcn_readlane(x, 0)) + __builtin_bit_cast(float, __builtin_amdgcn_readlane(x, 16))
         + __builtin_bit_cast(float, __builtin_amdgcn_readlane(x, 32)) + __builtin_bit_cast(float, __builtin_amdgcn_readlane(x, 48));
}


__device__ __forceinline__ f32x4 mfma16(bf16x8 a, bf16x8 b, f32x4 c) { return __builtin_amdgcn_mfma_f32_16x16x32_bf16(a, b, c, 0, 0, 0); }

struct TrItem { const float* W; bf16* WT; int K, N, item, mode; };
__device__ __forceinline__ void transpose_load(f32x4 (&v)[8], const TrItem& t, int lane) {
    const int nblk = t.N / 32, kb = t.item / nblk, nb = t.item % nblk, k0 = 64 * kb, n0 = 32 * nb;
    const float* src = t.W + (size_t)(k0 + (lane >> 3)) * t.N + n0 + (lane & 7) * 4;
#pragma unroll
    for (int i = 0; i < 8; ++i) v[i] = LD_ONCE((const f32x4*)(src + (size_t)(8 * i) * t.N));
}
__device__ __forceinline__ void transpose_store(const f32x4 (&v)[8], const TrItem& t, LAS float* scr, int lane) {
    const int nblk = t.N / 32, kb = t.item / nblk, nb = t.item % nblk, k0 = 64 * kb, n0 = 32 * nb;
    const int drow = t.mode == 0 ? n0 : (256 * (n0 >> 7) + (n0 & 127) + (t.mode == 2 ? 128 : 0));
#pragma unroll
    for (int i = 0; i < 8; ++i) { LAS float* p = scr + (8 * i + (lane >> 3)) * 33 + (lane & 7) * 4; p[0] = v[i][0]; p[1] = v[i][1]; p[2] = v[i][2]; p[3] = v[i][3]; }
    LDS_WAIT(); asm volatile("" ::: "memory");
    const int c = lane & 7;
#pragma unroll
    for (int j = 0; j < 4; ++j) { const int n = (lane >> 3) + 8 * j; const LAS float* s = scr + (8 * c) * 33 + n;
        v4u o; o.x = pk2(s[0 * 33], s[1 * 33]); o.y = pk2(s[2 * 33], s[3 * 33]); o.z = pk2(s[4 * 33], s[5 * 33]); o.w = pk2(s[6 * 33], s[7 * 33]);
        *(GAS v4u*)(t.WT + (size_t)(drow + n) * t.K + k0 + 8 * c) = o; }
    LDS_WAIT(); asm volatile("" ::: "memory");
}

typedef short v4i16_t __attribute__((ext_vector_type(4)));
__device__ __forceinline__ unsigned off_b(unsigned row, unsigned ch) { return 256u * row + 16u * (ch ^ (((row & 3) << 2) | ((row >> 2) & 3))); }
__device__ __forceinline__ unsigned tr_addr16(unsigned lane, unsigned c, unsigned ks, unsigned t) {
    const unsigned g = lane >> 4, q = (lane & 15) >> 2, p = lane & 3;
    return off_b(32 * ks + 8 * g + 4 * t + q, 2 * c + (p >> 1)) + 8 * (p & 1);
}
__device__ __forceinline__ bf16x8 tr_frag(LAS unsigned char* img, unsigned lane, unsigned c, unsigned ks) {
    const v4i16_t a = __builtin_amdgcn_ds_read_tr16_b64_v4i16((LAS v4i16_t*)(img + tr_addr16(lane, c, ks, 0)));
    const v4i16_t b = __builtin_amdgcn_ds_read_tr16_b64_v4i16((LAS v4i16_t*)(img + tr_addr16(lane, c, ks, 1)));
    return (bf16x8){a[0], a[1], a[2], a[3], b[0], b[1], b[2], b[3]};
}

template <int DK> struct StRegs { v4u k[DK / 64]; v4u v[2]; };
template <int DK, bool RET>
__device__ __forceinline__ void mix_state_load(StRegs<DK>& R, const bf16* proj, int it, int tid) {
    const int b = it >> 7, h = (it >> 5) & 3, c = it & 31;
    const size_t r0 = (size_t)b * 2048 + c * 64;
#pragma unroll
    for (int k = 0; k < 2; ++k) { const bf16* base = proj + (r0 + (tid >> 4) + 32 * k) * 3584 + (tid & 15) * 8 + h * 128;
        R.v[k] = *(const v4u*)(base + (RET ? 512 : 2560));
        if (!RET) R.k[k] = *(const v4u*)(base + 2048); }
    if (RET) R.k[0] = *(const v4u*)(proj + (r0 + (tid >> 3)) * 3584 + 256 + h * 64 + (tid & 7) * 8);
}
template <int DK, bool RET>
__device__ __forceinline__ void mix_state_item(LAS unsigned char* lds, const StRegs<DK>& R, bf16* ST, float* BL, int it, int tid) {
    constexpr int NSEG = 512 / DK, TS = 64 / NSEG;
    const int lane = tid & 63, wave = tid >> 6, d = tid % DK, seg = tid / DK, fr = lane & 15, fq = lane >> 4;
    const int h = (it >> 5) & 3;
    LAS unsigned char* VI = lds; LAS unsigned char* RAW = lds + 16384; LAS unsigned char* KI = lds + 32768; LAS float* TOT = (LAS float*)(lds + 49152);
#pragma unroll
    for (int k = 0; k < 2; ++k) { *(LAS v4u*)(VI + off_b((tid >> 4) + 32 * k, tid & 15)) = R.v[k];
        if (!RET) *(LAS v4u*)(RAW + ((tid >> 4) + 32 * k) * 256 + (tid & 15) * 16) = R.k[k]; }
    if (RET) *(LAS v4u*)(RAW + (tid >> 3) * 128 + (tid & 7) * 16) = R.k[0];
    __syncthreads();
    float kp[TS];
    if (RET) {
        const float lg2 = __log2f(1.f - exp2f(-5.f - (float)h)), gam = 1.f - exp2f(-5.f - (float)h);
        float f = __builtin_amdgcn_exp2f((float)(63 - seg * TS - (TS - 1)) * lg2);
#pragma unroll
        for (int i = TS - 1; i >= 0; --i) { const int t = seg * TS + i; kp[i] = bf2f(*(const LAS unsigned short*)(RAW + t * 128 + d * 2)) * f; f *= gam; }
    } else {
        float g[TS], bs[TS]; float run = 0.f;
#pragma unroll
        for (int i = 0; i < TS; ++i) { g[i] = h2f(*(const LAS unsigned short*)(RAW + (seg * TS + i) * 256 + d * 2)) * 1.44269504089f; run += g[i]; bs[i] = run; }
        TOT[seg * DK + d] = run;
        __syncthreads();
        float pre = 0.f, bl = 0.f;
#pragma unroll
        for (int s2 = 0; s2 < NSEG; ++s2) { const float t = TOT[s2 * DK + d]; bl += t; if (s2 < seg) pre += t; }
#pragma unroll
        for (int i = 0; i < TS; ++i) { const float bb = pre + bs[i]; kp[i] = (1.f - __builtin_amdgcn_exp2f(g[i])) * __builtin_amdgcn_exp2f(bl - bb); }
        if (seg == 0) BL[(size_t)it * 128 + d] = bl;
    }
#pragma unroll
    for (int i = 0; i < TS; i += 2) { const unsigned w = pk2(kp[i], kp[i + 1]);
        *(LAS unsigned short*)(KI + off_b(seg * TS + i, d >> 3) + (d & 7) * 2) = (unsigned short)w; *(LAS unsigned short*)(KI + off_b(seg * TS + i + 1, d >> 3) + (d & 7) * 2) = (unsigned short)(w >> 16); }
    __syncthreads();
    {
        bf16x8 bfr[2];
#pragma unroll
        for (int ks = 0; ks < 2; ++ks) bfr[ks] = tr_frag(VI, lane, wave, ks);
        bf16* dst = ST + (size_t)it * (128 * DK) + (size_t)(16 * wave + fr) * DK + 4 * fq;
#pragma unroll
        for (int dt = 0; dt < DK / 16; ++dt) {
            f32x4 acc = (f32x4){0.f, 0.f, 0.f, 0.f};
#pragma unroll
            for (int ks = 0; ks < 2; ++ks) acc = mfma16(tr_frag(KI, lane, dt, ks), bfr[ks], acc);
            v2u w; w.x = pk2(acc[0], acc[1]); w.y = pk2(acc[2], acc[3]);
            *(v2u*)(dst + 16 * dt) = w;
        }
    }
    __syncthreads();
}

template <int DK> struct OutRegs { v4u q[DK / 64]; v4u g[DK / 64]; v4u v[2]; v4u gate[2]; bf16x8 s[DK / 32]; float nwv; };
template <int DK, bool RET>
__device__ __forceinline__ void mix_out_load(OutRegs<DK>& R, const bf16* proj, const bf16* ST, const float* nw, int it, int tid) {
    const int lane = tid & 63, wave = tid >> 6, fr = lane & 15, fq = lane >> 4;
    const int b = it >> 7, h = (it >> 5) & 3, c = it & 31;
    const size_t r0 = (size_t)b * 2048 + c * 64;
#pragma unroll
    for (int k = 0; k < 2; ++k) { const bf16* base = proj + (r0 + (tid >> 4) + 32 * k) * 3584 + (tid & 15) * 8 + h * 128;
        R.v[k] = LD_LAST((const v4u*)(base + (RET ? 512 : 2560))); R.gate[k] = LD_LAST((const v4u*)(base + (RET ? 1024 : 3072)));
        if (!RET) { R.q[k] = LD_LAST((const v4u*)(base + 1536)); R.g[k] = LD_LAST((const v4u*)(base + 2048)); } }
    if (RET) { const bf16* base = proj + (r0 + (tid >> 3)) * 3584 + h * 64 + (tid & 7) * 8; R.q[0] = LD_LAST((const v4u*)base); R.g[0] = LD_LAST((const v4u*)(base + 256)); }
#pragma unroll
    for (int kd = 0; kd < DK / 32; ++kd) R.s[kd] = *(const bf16x8*)(ST + (size_t)it * (128 * DK) + (size_t)(16 * wave + fr) * DK + 32 * kd + 8 * fq);
    R.nwv = nw[h * 128 + 16 * wave + fr];
}
template <int DK, bool RET>
__device__ __forceinline__ void mix_out_park(LAS unsigned char* lds, const OutRegs<DK>& R, int tid) {
    LAS unsigned char* VI = lds; LAS unsigned char* RAWQ = lds + 16384; LAS unsigned char* RAWG = lds + 32768; LAS float* RED = (LAS float*)(lds + 128000);
#pragma unroll
    for (int k = 0; k < 2; ++k) { *(LAS v4u*)(VI + off_b((tid >> 4) + 32 * k, tid & 15)) = R.v[k];
        if (!RET) { *(LAS v4u*)(RAWQ + ((tid >> 4) + 32 * k) * 256 + (tid & 15) * 16) = R.q[k]; *(LAS v4u*)(RAWG + ((tid >> 4) + 32 * k) * 256 + (tid & 15) * 16) = R.g[k]; } }
    if (RET) { *(LAS v4u*)(RAWQ + (tid >> 3) * 128 + (tid & 7) * 16) = R.q[0]; *(LAS v4u*)(RAWG + (tid >> 3) * 128 + (tid & 7) * 16) = R.g[0]; }
    if (tid < 64) RED[tid] = 0.f;
    __syncthreads();
}
template <int DK, bool RET>
__device__ __forceinline__ void mix_out_item(LAS unsigned char* lds, const v4u (&gate)[2], const bf16x8 (&sfr)[DK / 32], float nwv, bf16* O, int it, int tid, const bf16* DBG_PROJ = nullptr) {
    constexpr int NSEG = 512 / DK, TS = 64 / NSEG, PITCH = DK * 2 + 16, KD = DK / 32, RP = DK * 2;
    const int lane = tid & 63, wave = tid >> 6, d = tid % DK, seg = tid / DK, fr = lane & 15, fq = lane >> 4;
    const int b = it >> 7, h = (it >> 5) & 3, c = it & 31;
    const size_t r0 = (size_t)b * 2048 + c * 64;
    LAS unsigned char* VI = lds; LAS unsigned char* RAWQ = lds + 16384; LAS unsigned char* RAWG = lds + 32768;
    LAS unsigned char* QA = lds + 49152; LAS unsigned char* KC = lds + 66560; LAS unsigned char* QB = lds + 83968; LAS unsigned char* P = lds + 101376;
    LAS float* TOT = (LAS float*)(lds + 101376);
    LAS unsigned char* OT = lds + 110592; LAS float* RED = (LAS float*)(lds + 128000); LAS float* RED2 = (LAS float*)(lds + 128256);
#ifdef S1_PAIR
    {
        constexpr int NS2 = 1024 / DK, TS2 = 64 / NS2;
        const int dp = tid % (DK / 2), sg = tid / (DK / 2), tb = sg * TS2;
        f32x2_t qa[TS2], kc[TS2], qb[TS2];
        if (RET) {
            const float lg2 = __log2f(1.f - exp2f(-5.f - (float)h)), gam = 1.f - exp2f(-5.f - (float)h), eref = __builtin_amdgcn_exp2f(32.f * lg2);
            float fa = __builtin_amdgcn_exp2f((float)(tb - 31) * lg2), fk = __builtin_amdgcn_exp2f((float)(31 - tb - (TS2 - 1)) * lg2);
#pragma unroll
            for (int i = 0; i < TS2; ++i) { const unsigned w = *(const LAS unsigned*)(RAWQ + (tb + i) * RP + dp * 4);
                qa[i] = (f32x2_t){__builtin_bit_cast(float, w << 16), __builtin_bit_cast(float, w & 0xffff0000u)} * fa; qb[i] = qa[i] * eref; fa *= gam; }
#pragma unroll
            for (int i = TS2 - 1; i >= 0; --i) { const unsigned w = *(const LAS unsigned*)(RAWG + (tb + i) * RP + dp * 4);
                kc[i] = (f32x2_t){__builtin_bit_cast(float, w << 16), __builtin_bit_cast(float, w & 0xffff0000u)} * fk; fk *= gam; }
        } else {
            f32x2_t g[TS2], bs[TS2], q[TS2]; f32x2_t run = {0.f, 0.f};
#pragma unroll
            for (int i = 0; i < TS2; ++i) { const unsigned wq = *(const LAS unsigned*)(RAWQ + (tb + i) * RP + dp * 4), wg = *(const LAS unsigned*)(RAWG + (tb + i) * RP + dp * 4);
                q[i] = (f32x2_t){__builtin_bit_cast(float, wq << 16), __builtin_bit_cast(float, wq & 0xffff0000u)};
                g[i] = (f32x2_t){h2f((unsigned short)wg), h2f((unsigned short)(wg >> 16))} * 1.44269504089f; run += g[i]; bs[i] = run; }
            *(LAS f32x2_t*)(TOT + sg * DK + 2 * dp) = run;
            __syncthreads();
            f32x2_t pre = {0.f, 0.f}, ref = {0.f, 0.f};
#pragma unroll
            for (int s2 = 0; s2 < NS2; ++s2) { const f32x2_t t = *(const LAS f32x2_t*)(TOT + s2 * DK + 2 * dp); if (s2 < NS2 / 2) ref += t; if (s2 < sg) pre += t; }
            const f32x2_t eref = {__builtin_amdgcn_exp2f(ref.x), __builtin_amdgcn_exp2f(ref.y)};
#pragma unroll
            for (int i = 0; i < TS2; ++i) { const f32x2_t e0 = pre + bs[i] - ref; const float e1x = __builtin_amdgcn_fmed3f(e0.x, -115.f, 115.f), e1y = __builtin_amdgcn_fmed3f(e0.y, -115.f, 115.f);
                qa[i] = q[i] * (f32x2_t){__builtin_amdgcn_exp2f(e1x), __builtin_amdgcn_exp2f(e1y)};
                kc[i] = (1.f - (f32x2_t){__builtin_amdgcn_exp2f(g[i].x), __builtin_amdgcn_exp2f(g[i].y)}) * (f32x2_t){__builtin_amdgcn_exp2f(-e1x), __builtin_amdgcn_exp2f(-e1y)};
                qb[i] = qa[i] * eref; }
        }
#pragma unroll
        for (int i = 0; i < TS2; ++i) { const int t = tb + i;
            *(LAS unsigned*)(QA + t * PITCH + dp * 4) = pk2(qa[i].x, qa[i].y); *(LAS unsigned*)(KC + t * PITCH + dp * 4) = pk2(kc[i].x, kc[i].y); *(LAS unsigned*)(QB + t * PITCH + dp * 4) = pk2(qb[i].x, qb[i].y); }
        __syncthreads();
    }
#else
#ifdef DUP_P4S1
    for (int rep1 = 0; rep1 < 2; ++rep1)
#endif
    {
    float qa[TS], kc[TS], qb[TS];
    if (RET) {
        const float lg2 = __log2f(1.f - exp2f(-5.f - (float)h)), gam = 1.f - exp2f(-5.f - (float)h), eref = __builtin_amdgcn_exp2f(32.f * lg2);
        const int tb = seg * TS;
        float fa = __builtin_amdgcn_exp2f((float)(tb - 31) * lg2), fk = __builtin_amdgcn_exp2f((float)(31 - tb - (TS - 1)) * lg2);
#pragma unroll
        for (int i = 0; i < TS; ++i) { const float q = bf2f(*(const LAS unsigned short*)(RAWQ + (tb + i) * RP + d * 2)); qa[i] = q * fa; qb[i] = qa[i] * eref; fa *= gam; }
#pragma unroll
        for (int i = TS - 1; i >= 0; --i) { kc[i] = bf2f(*(const LAS unsigned short*)(RAWG + (tb + i) * RP + d * 2)) * fk; fk *= gam; }
    } else {
        float g[TS], bs[TS], q[TS]; float run = 0.f;
#pragma unroll
        for (int i = 0; i < TS; ++i) { const int t = seg * TS + i; q[i] = bf2f(*(const LAS unsigned short*)(RAWQ + t * RP + d * 2)); g[i] = h2f(*(const LAS unsigned short*)(RAWG + t * RP + d * 2)) * 1.44269504089f; run += g[i]; bs[i] = run; }
        TOT[seg * DK + d] = run;
        __syncthreads();
        float pre = 0.f, ref = 0.f;
#pragma unroll
        for (int s2 = 0; s2 < NSEG; ++s2) { const float t = TOT[s2 * DK + d]; if (s2 < NSEG / 2) ref += t; if (s2 < seg) pre += t; }
        const float eref = __builtin_amdgcn_exp2f(ref);
#pragma unroll
        for (int i = 0; i < TS; ++i) { const float e1 = __builtin_amdgcn_fmed3f(pre + bs[i] - ref, -115.f, 115.f);
            qa[i] = q[i] * __builtin_amdgcn_exp2f(e1); kc[i] = (1.f - __builtin_amdgcn_exp2f(g[i])) * __builtin_amdgcn_exp2f(-e1); qb[i] = qa[i] * eref; }
    }
#pragma unroll
    for (int i = 0; i < TS; i += 2) { const int t = seg * TS + i; const unsigned wa = pk2(qa[i], qa[i + 1]), wk = pk2(kc[i], kc[i + 1]), wb = pk2(qb[i], qb[i + 1]);
        *(LAS unsigned short*)(QA + t * PITCH + d * 2) = (unsigned short)wa; *(LAS unsigned short*)(QA + (t + 1) * PITCH + d * 2) = (unsigned short)(wa >> 16);
        *(LAS unsigned short*)(KC + t * PITCH + d * 2) = (unsigned short)wk; *(LAS unsigned short*)(KC + (t + 1) * PITCH + d * 2) = (unsigned short)(wk >> 16);
        *(LAS unsigned short*)(QB + t * PITCH + d * 2) = (unsigned short)wb; *(LAS unsigned short*)(QB + (t + 1) * PITCH + d * 2) = (unsigned short)(wb >> 16); }
    __syncthreads();
    }
#endif
#ifdef DUP_P4S23
    for (int rep2 = 0; rep2 < 2; ++rep2)
#endif
    {
        const int tt = wave & 3, sp = wave >> 2;
#ifdef S2_ILV
        bf16x8 bq[KD], a0[KD], a1[KD];
#pragma unroll
        for (int kd = 0; kd < KD; ++kd) { bq[kd] = *(const LAS bf16x8*)(QA + (16 * tt + fr) * PITCH + (32 * kd + 8 * fq) * 2);
            a0[kd] = *(const LAS bf16x8*)(KC + (16 * (2 * sp) + fr) * PITCH + (32 * kd + 8 * fq) * 2); a1[kd] = *(const LAS bf16x8*)(KC + (16 * (2 * sp + 1) + fr) * PITCH + (32 * kd + 8 * fq) * 2); }
        f32x4 accs[2] = {(f32x4){0.f, 0.f, 0.f, 0.f}, (f32x4){0.f, 0.f, 0.f, 0.f}};
#pragma unroll
        for (int kd = 0; kd < KD; ++kd) { accs[0] = mfma16(a0[kd], bq[kd], accs[0]); accs[1] = mfma16(a1[kd], bq[kd], accs[1]); }
#pragma unroll
        for (int hh = 0; hh < 2; ++hh) {
            const int st = 2 * sp + hh; const f32x4 acc = accs[hh];
            const int t = 16 * tt + fr, s0 = 16 * st + 4 * fq;
            const float p0 = (s0 + 0 <= t) ? acc[0] : 0.f, p1 = (s0 + 1 <= t) ? acc[1] : 0.f, p2 = (s0 + 2 <= t) ? acc[2] : 0.f, p3 = (s0 + 3 <= t) ? acc[3] : 0.f;
            v2u w; w.x = pk2(p0, p1); w.y = pk2(p2, p3);
            *(LAS v2u*)(P + t * 144 + s0 * 2) = w;
        }
#else
#pragma unroll
        for (int hh = 0; hh < 2; ++hh) {
            const int st = 2 * sp + hh;
            f32x4 acc = (f32x4){0.f, 0.f, 0.f, 0.f};
#pragma unroll
            for (int kd = 0; kd < KD; ++kd) { const bf16x8 a = *(const LAS bf16x8*)(KC + (16 * st + fr) * PITCH + (32 * kd + 8 * fq) * 2), bq = *(const LAS bf16x8*)(QA + (16 * tt + fr) * PITCH + (32 * kd + 8 * fq) * 2);
                acc = mfma16(a, bq, acc); }
            const int t = 16 * tt + fr, s0 = 16 * st + 4 * fq;
            const float p0 = (s0 + 0 <= t) ? acc[0] : 0.f, p1 = (s0 + 1 <= t) ? acc[1] : 0.f, p2 = (s0 + 2 <= t) ? acc[2] : 0.f, p3 = (s0 + 3 <= t) ? acc[3] : 0.f;
            v2u w; w.x = pk2(p0, p1); w.y = pk2(p2, p3);
            *(LAS v2u*)(P + t * 144 + s0 * 2) = w;
        }
#endif
    }
    __syncthreads();
    f32x4 o[4];
    {
        f32x4 accX[4];
#pragma unroll
        for (int tt = 0; tt < 4; ++tt) { o[tt] = (f32x4){0.f, 0.f, 0.f, 0.f}; accX[tt] = (f32x4){0.f, 0.f, 0.f, 0.f}; }
#pragma unroll
        for (int ks = 0; ks < 2; ++ks) { const bf16x8 bv = tr_frag(VI, lane, wave, ks);
#pragma unroll
            for (int tt = 0; tt < 4; ++tt) { const bf16x8 a = *(const LAS bf16x8*)(P + (16 * tt + fr) * 144 + (32 * ks + 8 * fq) * 2); o[tt] = mfma16(a, bv, o[tt]); } }
#pragma unroll
        for (int kd = 0; kd < KD; ++kd)
#pragma unroll
            for (int tt = 0; tt < 4; ++tt) { const bf16x8 a = *(const LAS bf16x8*)(QB + (16 * tt + fr) * PITCH + (32 * kd + 8 * fq) * 2); accX[tt] = mfma16(a, sfr[kd], accX[tt]); }
#pragma unroll
        for (int tt = 0; tt < 4; ++tt) o[tt] = o[tt] + accX[tt];
    }
#pragma unroll
    for (int tt = 0; tt < 4; ++tt)
#pragma unroll
        for (int r = 0; r < 4; ++r) { float s = row16_sum(o[tt][r] * o[tt][r]);
#ifdef RED_ATOMIC
            if (fr == 0) __hip_atomic_fetch_add(RED + 16 * tt + 4 * fq + r, s, __ATOMIC_RELAXED, __HIP_MEMORY_SCOPE_WORKGROUP); }
    __syncthreads();
#else
            if (fr == 0) RED2[wave * 64 + 16 * tt + 4 * fq + r] = s; }
    __syncthreads();
    if (tid < 64) { float s = 0.f;
#pragma unroll
        for (int w = 0; w < 8; ++w) s += RED2[w * 64 + tid];
        RED[tid] = s; }
    __syncthreads();
#endif
#pragma unroll
    for (int tt = 0; tt < 4; ++tt)
#pragma unroll
        for (int r = 0; r < 4; r += 2) { const int t = 16 * tt + 4 * fq + r; const float rs0 = __builtin_amdgcn_rsqf(RED[t] * (1.f / 128.f) + EPS), rs1 = __builtin_amdgcn_rsqf(RED[t + 1] * (1.f / 128.f) + EPS);
            const unsigned w = pk2(o[tt][r] * rs0 * nwv, o[tt][r + 1] * rs1 * nwv);
            *(LAS unsigned short*)(OT + t * 272 + (16 * wave + fr) * 2) = (unsigned short)w; *(LAS unsigned short*)(OT + (t + 1) * 272 + (16 * wave + fr) * 2) = (unsigned short)(w >> 16); }
    __syncthreads();
    {
        const int ocol = (RET ? 0 : 512) + h * 128;
#pragma unroll
        for (int k = 0; k < 2; ++k) { const int row = (tid >> 4) + 32 * k, ch = tid & 15;
            const v4u ov = *(const LAS v4u*)(OT + row * 272 + ch * 16); const v4u gv = gate[k];
            const unsigned oo[4] = {ov.x, ov.y, ov.z, ov.w}, gg[4] = {gv.x, gv.y, gv.z, gv.w}; unsigned w[4];
#pragma unroll
            for (int e = 0; e < 4; ++e) w[e] = pk2(__builtin_bit_cast(float, oo[e] << 16) * __builtin_bit_cast(float, gg[e] << 16), __builtin_bit_cast(float, oo[e] & 0xffff0000u) * __builtin_bit_cast(float, gg[e] & 0xffff0000u));
            v4u wv; wv.x = w[0]; wv.y = w[1]; wv.z = w[2]; wv.w = w[3];
            *(v4u*)(O + (r0 + row) * 1024 + ocol + ch * 8) = wv; }
    }
}

template <int DK, bool RET>
__device__ __forceinline__ void mix_state_loop(LAS unsigned char* lds, const bf16* proj, bf16* ST, float* BL, int first, int step, int end, int tid_in) {
    int tid = tid_in; asm volatile("" : "+v"(tid));
    if (first >= end) return;
    StRegs<DK> cur; mix_state_load<DK, RET>(cur, proj, first, tid);
    for (int it = first; it < end; it += step) {
        StRegs<DK> nxt = cur;
        const bool more = it + step < end;
        if (more) mix_state_load<DK, RET>(nxt, proj, it + step, tid);
        mix_state_item<DK, RET>(lds, cur, ST, BL, it, tid);
#ifdef DUP_P2C
        mix_state_item<DK, RET>(lds, cur, ST, BL, it, tid);
#endif
        cur = nxt;
    }
}
#ifndef MIX_CHAIN
template <int DK, bool RET>
__device__ __forceinline__ void mix_out_loop(LAS unsigned char* lds, const bf16* proj, const bf16* ST, const float* nw, bf16* O, int first, int step, int tid_in) {
    int tid = tid_in; asm volatile("" : "+v"(tid));
    if (first >= 1024) return;
    OutRegs<DK> cur; mix_out_load<DK, RET>(cur, proj, ST, nw, first, tid);
    for (int it = first; it < 1024; it += step) {
        mix_out_park<DK, RET>(lds, cur, tid);
        const v4u gate[2] = {cur.gate[0], cur.gate[1]}; bf16x8 sfr[DK / 32]; const float nwv = cur.nwv;
#pragma unroll
        for (int kd = 0; kd < DK / 32; ++kd) sfr[kd] = cur.s[kd];
#ifndef NO_PREFETCH
        if (it + step < 1024) mix_out_load<DK, RET>(cur, proj, ST, nw, it + step, tid);
#endif
        mix_out_item<DK, RET>(lds, gate, sfr, nwv, O, it, tid, proj);
#ifdef DUP_P4C
        __syncthreads(); if (tid < 64) ((LAS float*)(lds + 128000))[tid] = 0.f; __syncthreads();
        mix_out_item<DK, RET>(lds, gate, sfr, nwv, O, it, tid, proj);
#endif
#ifdef NO_PREFETCH
        __syncthreads();
        if (it + step < 1024) mix_out_load<DK, RET>(cur, proj, ST, nw, it + step, tid);
#endif
    }
}
#endif

#ifdef MIX_CHAIN_P2
__device__ __forceinline__ void mix_state_both(LAS unsigned char* lds, const bf16* proj, bf16* STH, bf16* STR, float* BL, int first, int step, int end, int tid_in) {
    int tid = tid_in; asm volatile("" : "+v"(tid));
    if (first >= end) return;
    StRegs<128> ch; mix_state_load<128, false>(ch, proj, first, tid);
    StRegs<64> cr;
    for (int it = first; it < end; it += step) {
        StRegs<128> nxt = ch;
        if (it + step < end) mix_state_load<128, false>(nxt, proj, it + step, tid); else mix_state_load<64, true>(cr, proj, first, tid);
        mix_state_item<128, false>(lds, ch, STH, BL, it, tid);
        ch = nxt;
    }
    for (int it = first; it < end; it += step) {
        StRegs<64> nxt = cr;
        if (it + step < end) mix_state_load<64, true>(nxt, proj, it + step, tid);
        mix_state_item<64, true>(lds, cr, STR, BL, it, tid);
        cr = nxt;
    }
}
#endif
#ifdef MIX_CHAIN
__device__ __forceinline__ void mix_out_both(LAS unsigned char* lds, const bf16* proj, const bf16* STH, const bf16* STR, const float* nwH, const float* nwR, bf16* O, int first, int step, int tid_in) {
    int tid = tid_in; asm volatile("" : "+v"(tid));
    if (first >= 1024) return;
    OutRegs<128> ch; mix_out_load<128, false>(ch, proj, STH, nwH, first, tid);
    OutRegs<64> cr;
    for (int it = first; it < 1024; it += step) {
        mix_out_park<128, false>(lds, ch, tid);
        const v4u gate[2] = {ch.gate[0], ch.gate[1]}; bf16x8 sfr[4]; const float nwv = ch.nwv;
#pragma unroll
        for (int kd = 0; kd < 4; ++kd) sfr[kd] = ch.s[kd];
        if (it + step < 1024) mix_out_load<128, false>(ch, proj, STH, nwH, it + step, tid); else mix_out_load<64, true>(cr, proj, STR, nwR, first, tid);
        mix_out_item<128, false>(lds, gate, sfr, nwv, O, it, tid);
    }
    for (int it = first; it < 1024; it += step) {
        mix_out_park<64, true>(lds, cr, tid);
        const v4u gate[2] = {cr.gate[0], cr.gate[1]}; bf16x8 sfr[2]; const float nwv = cr.nwv;
#pragma unroll
        for (int kd = 0; kd < 2; ++kd) sfr[kd] = cr.s[kd];
        if (it + step < 1024) mix_out_load<64, true>(cr, proj, STR, nwR, it + step, tid);
        mix_out_item<64, true>(lds, gate, sfr, nwv, O, it, tid);
    }
}
#endif

#ifdef P2_PAIR
__device__ __forceinline__ void mix_state_pair_item(LAS unsigned char* lds, const StRegs<128>& RH, const StRegs<64>& RR, bf16* STH, bf16* STR, float* BL, int it, int tid) {
    const int lane = tid & 63, wave = tid >> 6, fr = lane & 15, fq = lane >> 4;
    const int h = (it >> 5) & 3;
    const int dH = tid & 127, segH = tid >> 7, dR = tid & 63, segR = tid >> 6;
    LAS unsigned char* VIH = lds; LAS unsigned char* RAWH = lds + 16384; LAS unsigned char* KIH = lds + 32768; LAS float* TOT = (LAS float*)(lds + 49152);
    LAS unsigned char* VIR = lds + 65536; LAS unsigned char* RAWR = lds + 81920; LAS unsigned char* KIR = lds + 98304;
#pragma unroll
    for (int k = 0; k < 2; ++k) { *(LAS v4u*)(VIH + off_b((tid >> 4) + 32 * k, tid & 15)) = RH.v[k]; *(LAS v4u*)(RAWH + ((tid >> 4) + 32 * k) * 256 + (tid & 15) * 16) = RH.k[k];
        *(LAS v4u*)(VIR + off_b((tid >> 4) + 32 * k, tid & 15)) = RR.v[k]; }
    *(LAS v4u*)(RAWR + (tid >> 3) * 128 + (tid & 7) * 16) = RR.k[0];
    __syncthreads();
    float g[16], bs[16];
    {   float run = 0.f;
#pragma unroll
        for (int i = 0; i < 16; ++i) { g[i] = h2f(*(const LAS unsigned short*)(RAWH + (segH * 16 + i) * 256 + dH * 2)) * 1.44269504089f; run += g[i]; bs[i] = run; }
        TOT[segH * 128 + dH] = run;
    }
    {
        float kp[8];
        const float lg2 = __log2f(1.f - exp2f(-5.f - (float)h)), gam = 1.f - exp2f(-5.f - (float)h);
        float f = __builtin_amdgcn_exp2f((float)(63 - segR * 8 - 7) * lg2);
#pragma unroll
        for (int i = 7; i >= 0; --i) { const int t = segR * 8 + i; kp[i] = bf2f(*(const LAS unsigned short*)(RAWR + t * 128 + dR * 2)) * f; f *= gam; }
#pragma unroll
        for (int i = 0; i < 8; i += 2) { const unsigned w = pk2(kp[i], kp[i + 1]);
            *(LAS unsigned short*)(KIR + off_b(segR * 8 + i, dR >> 3) + (dR & 7) * 2) = (unsigned short)w; *(LAS unsigned short*)(KIR + off_b(segR * 8 + i + 1, dR >> 3) + (dR & 7) * 2) = (unsigned short)(w >> 16); }
    }
    __syncthreads();
    {   float kp[16]; float pre = 0.f, bl = 0.f;
#pragma unroll
        for (int s2 = 0; s2 < 4; ++s2) { const float t = TOT[s2 * 128 + dH]; bl += t; if (s2 < segH) pre += t; }
#pragma unroll
        for (int i = 0; i < 16; ++i) { const float bb = pre + bs[i]; kp[i] = (1.f - __builtin_amdgcn_exp2f(g[i])) * __builtin_amdgcn_exp2f(bl - bb); }
        if (segH == 0) BL[(size_t)it * 128 + dH] = bl;
#pragma unroll
        for (int i = 0; i < 16; i += 2) { const unsigned w = pk2(kp[i], kp[i + 1]);
            *(LAS unsigned short*)(KIH + off_b(segH * 16 + i, dH >> 3) + (dH & 7) * 2) = (unsigned short)w; *(LAS unsigned short*)(KIH + off_b(segH * 16 + i + 1, dH >> 3) + (dH & 7) * 2) = (unsigned short)(w >> 16); }
    }
    __syncthreads();
    {
        bf16x8 bh[2], br[2];
#pragma unroll
        for (int ks = 0; ks < 2; ++ks) { bh[ks] = tr_frag(VIH, lane, wave, ks); br[ks] = tr_frag(VIR, lane, wave, ks); }
        bf16* dsth = STH + (size_t)it * (128 * 128) + (size_t)(16 * wave + fr) * 128 + 4 * fq;
        bf16* dstr = STR + (size_t)it * (128 * 64) + (size_t)(16 * wave + fr) * 64 + 4 * fq;
#pragma unroll
        for (int dt = 0; dt < 8; ++dt) {
            f32x4 acc = (f32x4){0.f, 0.f, 0.f, 0.f};
#pragma unroll
            for (int ks = 0; ks < 2; ++ks) acc = mfma16(tr_frag(KIH, lane, dt, ks), bh[ks], acc);
            v2u w; w.x = pk2(acc[0], acc[1]); w.y = pk2(acc[2], acc[3]);
            *(v2u*)(dsth + 16 * dt) = w;
        }
#pragma unroll
        for (int dt = 0; dt < 4; ++dt) {
            f32x4 acc = (f32x4){0.f, 0.f, 0.f, 0.f};
#pragma unroll
            for (int ks = 0; ks < 2; ++ks) acc = mfma16(tr_frag(KIR, lane, dt, ks), br[ks], acc);
            v2u w; w.x = pk2(acc[0], acc[1]); w.y = pk2(acc[2], acc[3]);
            *(v2u*)(dstr + 16 * dt) = w;
        }
    }
    __syncthreads();
}
__device__ __forceinline__ void mix_state_pair_loop(LAS unsigned char* lds, const bf16* proj, bf16* STH, bf16* STR, float* BL, int first, int step, int end, int tid_in) {
    int tid = tid_in; asm volatile("" : "+v"(tid));
    if (first >= end) return;
    StRegs<128> ch; StRegs<64> cr; mix_state_load<128, false>(ch, proj, first, tid); mix_state_load<64, true>(cr, proj, first, tid);
    for (int it = first; it < end; it += step) {
        StRegs<128> nh = ch; StRegs<64> nr = cr;
        if (it + step < end) { mix_state_load<128, false>(nh, proj, it + step, tid); mix_state_load<64, true>(nr, proj, it + step, tid); }
        mix_state_pair_item(lds, ch, cr, STH, STR, BL, it, tid);
        ch = nh; cr = nr;
    }
}
#endif

template <int DK, bool RET>
__device__ __forceinline__ void mix_state_item_v1(LAS unsigned char* lds, const bf16* proj, bf16* ST, float* BL, int it, int tid_in) {
    int tid = tid_in; asm volatile("" : "+v"(tid));
    constexpr int NSEG = 512 / DK, TS = 64 / NSEG;
    const int lane = tid & 63, wave = tid >> 6, d = tid % DK, seg = tid / DK;
    const int b = it >> 7, h = (it >> 5) & 3, c = it & 31;
    const size_t r0 = (size_t)b * 2048 + c * 64;
    LAS unsigned char* KT = lds; LAS unsigned char* VT = lds + 18432; LAS float* TOT = (LAS float*)(lds + 36864);
    {
        const int j = tid & 127, sg = tid >> 7;
        const bf16* src = proj + (r0 + 16 * sg) * 3584 + (RET ? 512 : 2560) + h * 128 + j;
        unsigned vv[16];
#pragma unroll
        for (int i = 0; i < 16; ++i) vv[i] = src[(size_t)i * 3584];
        v4u w0, w1; w0.x = vv[0] | (vv[1] << 16); w0.y = vv[2] | (vv[3] << 16); w0.z = vv[4] | (vv[5] << 16); w0.w = vv[6] | (vv[7] << 16);
        w1.x = vv[8] | (vv[9] << 16); w1.y = vv[10] | (vv[11] << 16); w1.z = vv[12] | (vv[13] << 16); w1.w = vv[14] | (vv[15] << 16);
        *(LAS v4u*)(VT + j * 144 + sg * 32) = w0; *(LAS v4u*)(VT + j * 144 + sg * 32 + 16) = w1;
    }
    float kp[TS];
    if (RET) {
        const float lg = __logf(1.f - exp2f(-5.f - (float)h));
        const bf16* src = proj + (r0 + seg * TS) * 3584 + 256 + h * 64 + d;
#pragma unroll
        for (int i = 0; i < TS; ++i) { const int t = seg * TS + i; kp[i] = bf2f(src[(size_t)i * 3584]) * __expf((float)(63 - t) * lg); }
    } else {
        const bf16* src = proj + (r0 + seg * TS) * 3584 + 2048 + h * 128 + d;
        float g[TS], bs[TS]; float run = 0.f;
#pragma unroll
        for (int i = 0; i < TS; ++i) { g[i] = h2f(src[(size_t)i * 3584]); run += g[i]; bs[i] = run; }
        TOT[seg * DK + d] = run;
        __syncthreads();
        float pre = 0.f, bl = 0.f;
#pragma unroll
        for (int s2 = 0; s2 < NSEG; ++s2) { const float t = TOT[s2 * DK + d]; bl += t; if (s2 < seg) pre += t; }
#pragma unroll
        for (int i = 0; i < TS; ++i) { const float bb = pre + bs[i]; kp[i] = (1.f - __expf(g[i])) * __expf(bl - bb); }
        if (seg == 0) BL[(size_t)it * 128 + d] = bl;
    }
    {
        unsigned pw[TS / 2];
#pragma unroll
        for (int i = 0; i < TS / 2; ++i) pw[i] = pk2(kp[2 * i], kp[2 * i + 1]);
#pragma unroll
        for (int i = 0; i < TS / 8; ++i) { v4u w; w.x = pw[4 * i]; w.y = pw[4 * i + 1]; w.z = pw[4 * i + 2]; w.w = pw[4 * i + 3]; *(LAS v4u*)(KT + d * 144 + seg * TS * 2 + 16 * i) = w; }
    }
    __syncthreads();
    {
        const int fr = lane & 15, fq = lane >> 4;
        bf16x8 bfr[2];
#pragma unroll
        for (int ks = 0; ks < 2; ++ks) bfr[ks] = *(const LAS bf16x8*)(VT + (16 * wave + fr) * 144 + (32 * ks + 8 * fq) * 2);
        bf16* dst = ST + (size_t)it * (128 * DK) + (size_t)(16 * wave + fr) * DK + 4 * fq;
#pragma unroll
        for (int dt = 0; dt < DK / 16; ++dt) {
            f32x4 acc = (f32x4){0.f, 0.f, 0.f, 0.f};
#pragma unroll
            for (int ks = 0; ks < 2; ++ks) { const bf16x8 a = *(const LAS bf16x8*)(KT + (16 * dt + fr) * 144 + (32 * ks + 8 * fq) * 2); acc = mfma16(a, bfr[ks], acc); }
            v2u w; w.x = pk2(acc[0], acc[1]); w.y = pk2(acc[2], acc[3]);
            *(v2u*)(dst + 16 * dt) = w;
        }
    }
    __syncthreads();
}

template <int DK, bool RET>
__device__ __forceinline__ void mix_out_item_v1(LAS unsigned char* lds, const bf16* proj, const bf16* ST, const float* nw, bf16* O, int it, int tid_in) {
    int tid = tid_in; asm volatile("" : "+v"(tid));
    constexpr int NSEG = 512 / DK, TS = 64 / NSEG, PITCH = DK * 2 + 16, KD = DK / 32;
    const int lane = tid & 63, wave = tid >> 6, d = tid % DK, seg = tid / DK, fr = lane & 15, fq = lane >> 4;
    const int tt = wave & 3, jh = wave >> 2;
    const int b = it >> 7, h = (it >> 5) & 3, c = it & 31;
    const size_t r0 = (size_t)b * 2048 + c * 64;
    LAS unsigned char* QA = lds; LAS unsigned char* KC = lds + 17408; LAS unsigned char* QB = lds + 34816; LAS unsigned char* VT = lds + 52224; LAS unsigned char* P = lds + 70656;
    LAS float* TOT = (LAS float*)(lds + 79872); LAS float* RED = (LAS float*)(lds + 83968);
    bf16x8 sfr[4][KD];
#pragma unroll
    for (int jt = 0; jt < 4; ++jt)
#pragma unroll
        for (int kd = 0; kd < KD; ++kd) sfr[jt][kd] = *(const bf16x8*)(ST + (size_t)it * (128 * DK) + (size_t)(64 * jh + 16 * jt + fr) * DK + 32 * kd + 8 * fq);
    {
        const int j = tid & 127, sg = tid >> 7;
        const bf16* src = proj + (r0 + 16 * sg) * 3584 + (RET ? 512 : 2560) + h * 128 + j;
        unsigned vv[16];
#pragma unroll
        for (int i = 0; i < 16; ++i) vv[i] = src[(size_t)i * 3584];
        v4u w0, w1; w0.x = vv[0] | (vv[1] << 16); w0.y = vv[2] | (vv[3] << 16); w0.z = vv[4] | (vv[5] << 16); w0.w = vv[6] | (vv[7] << 16);
        w1.x = vv[8] | (vv[9] << 16); w1.y = vv[10] | (vv[11] << 16); w1.z = vv[12] | (vv[13] << 16); w1.w = vv[14] | (vv[15] << 16);
        *(LAS v4u*)(VT + j * 144 + sg * 32) = w0; *(LAS v4u*)(VT + j * 144 + sg * 32 + 16) = w1;
    }
    float qa[TS], kc[TS], qb[TS];
    if (RET) {
        const float lg = __logf(1.f - exp2f(-5.f - (float)h));
        const bf16* qs = proj + (r0 + seg * TS) * 3584 + h * 64 + d;
#pragma unroll
        for (int i = 0; i < TS; ++i) { const int t = seg * TS + i; const float q = bf2f(qs[(size_t)i * 3584]), k = bf2f(qs[(size_t)i * 3584 + 256]);
            qa[i] = q * __expf((float)(t - 31) * lg); kc[i] = k * __expf((float)(31 - t) * lg); qb[i] = q * __expf((float)(t + 1) * lg); }
    } else {
        const bf16* src = proj + (r0 + seg * TS) * 3584 + 1536 + h * 128 + d;
        float g[TS], bs[TS], q[TS]; float run = 0.f;
#pragma unroll
        for (int i = 0; i < TS; ++i) { q[i] = bf2f(src[(size_t)i * 3584]); g[i] = h2f(src[(size_t)i * 3584 + 512]); run += g[i]; bs[i] = run; }
        TOT[seg * DK + d] = run;
        __syncthreads();
        float pre = 0.f, ref = 0.f;
#pragma unroll
        for (int s2 = 0; s2 < NSEG; ++s2) { const float t = TOT[s2 * DK + d]; if (s2 < NSEG / 2) ref += t; if (s2 < seg) pre += t; }
#pragma unroll
        for (int i = 0; i < TS; ++i) { const float bb = pre + bs[i]; const float e1 = fminf(fmaxf(bb - ref, -80.f), 80.f);
            qa[i] = q[i] * __expf(e1); kc[i] = (1.f - __expf(g[i])) * __expf(-e1); qb[i] = q[i] * __expf(bb); }
    }
#pragma unroll
    for (int i = 0; i < TS; ++i) { const int t = seg * TS + i;
        *(LAS unsigned short*)(QA + t * PITCH + d * 2) = (unsigned short)f2bf(qa[i]);
        *(LAS unsigned short*)(KC + t * PITCH + d * 2) = (unsigned short)f2bf(kc[i]);
        *(LAS unsigned short*)(QB + t * PITCH + d * 2) = (unsigned short)f2bf(qb[i]); }
    __syncthreads();
#pragma unroll
    for (int hh = 0; hh < 2; ++hh) {
        const int st = 2 * jh + hh;
        f32x4 acc = (f32x4){0.f, 0.f, 0.f, 0.f};
#pragma unroll
        for (int kd = 0; kd < KD; ++kd) { const bf16x8 a = *(const LAS bf16x8*)(KC + (16 * st + fr) * PITCH + (32 * kd + 8 * fq) * 2), bq = *(const LAS bf16x8*)(QA + (16 * tt + fr) * PITCH + (32 * kd + 8 * fq) * 2);
            acc = mfma16(a, bq, acc); }
        const int t = 16 * tt + fr, s0 = 16 * st + 4 * fq;
        const float p0 = (s0 + 0 <= t) ? acc[0] : 0.f, p1 = (s0 + 1 <= t) ? acc[1] : 0.f, p2 = (s0 + 2 <= t) ? acc[2] : 0.f, p3 = (s0 + 3 <= t) ? acc[3] : 0.f;
        v2u w; w.x = pk2(p0, p1); w.y = pk2(p2, p3);
        *(LAS v2u*)(P + t * 144 + s0 * 2) = w;
    }
    __syncthreads();
    f32x4 o[4];
    {
        f32x4 accI[4], accX[4];
#pragma unroll
        for (int jt = 0; jt < 4; ++jt) { accI[jt] = (f32x4){0.f, 0.f, 0.f, 0.f}; accX[jt] = (f32x4){0.f, 0.f, 0.f, 0.f}; }
#pragma unroll
        for (int ks = 0; ks < 2; ++ks) { const bf16x8 a = *(const LAS bf16x8*)(P + (16 * tt + fr) * 144 + (32 * ks + 8 * fq) * 2);
#pragma unroll
            for (int jt = 0; jt < 4; ++jt) { const bf16x8 bv = *(const LAS bf16x8*)(VT + (64 * jh + 16 * jt + fr) * 144 + (32 * ks + 8 * fq) * 2); accI[jt] = mfma16(a, bv, accI[jt]); } }
#pragma unroll
        for (int kd = 0; kd < KD; ++kd) { const bf16x8 a = *(const LAS bf16x8*)(QB + (16 * tt + fr) * PITCH + (32 * kd + 8 * fq) * 2);
#pragma unroll
            for (int jt = 0; jt < 4; ++jt) accX[jt] = mfma16(a, sfr[jt][kd], accX[jt]); }
#pragma unroll
        for (int jt = 0; jt < 4; ++jt) o[jt] = accI[jt] + accX[jt];
    }
    {
        float part[4];
#pragma unroll
        for (int r = 0; r < 4; ++r) { float s = 0.f;
#pragma unroll
            for (int jt = 0; jt < 4; ++jt) s += o[jt][r] * o[jt][r];
            part[r] = row16_sum(s); }
        if (fr == 0) {
#pragma unroll
            for (int r = 0; r < 4; ++r) RED[jh * 64 + 16 * tt + 4 * fq + r] = part[r];
        }
    }
    __syncthreads();
    {
        const int gcol = (RET ? 1024 : 3072) + h * 128, ocol = (RET ? 0 : 512) + h * 128;
        float rs[4];
#pragma unroll
        for (int r = 0; r < 4; ++r) { const int t = 16 * tt + 4 * fq + r; rs[r] = rsqrtf((RED[t] + RED[64 + t]) * (1.f / 128.f) + EPS); }
#pragma unroll
        for (int jt = 0; jt < 4; ++jt) { const int j = 64 * jh + 16 * jt + fr; const float wj = nw[h * 128 + j];
#pragma unroll
            for (int r = 0; r < 4; ++r) { const size_t row = r0 + 16 * tt + 4 * fq + r; const float gate = bf2f(proj[row * 3584 + gcol + j]);
                O[row * 1024 + ocol + j] = (bf16)f2bf(o[jt][r] * rs[r] * wj * gate); } }
    }
    __syncthreads();
}


#ifndef GEMM_SP2
#define GEMM_SP2 true
#endif
#ifndef GEMM_ALIGN
#define GEMM_ALIGN true
#endif
constexpr int I_IN = 16 * 112, I_OUT = 16 * 32, I_G = 16 * 88, I_DN = 44 * 32, I_LAYER = I_IN + I_OUT + 2 * I_G + I_DN;
#ifdef DEFER_W
constexpr int I_PRE = I_IN + I_OUT + 2 * I_G;
constexpr int N_MAIN = I_PRE + I_IN + 2 * I_G, N_DEFER = 2 * I_DN + I_OUT;
__device__ __forceinline__ int tr_main(int v) { return v < I_PRE ? v : (v < I_PRE + I_IN ? v + I_DN : v + I_DN + I_OUT); }
__device__ __forceinline__ int tr_defer(int v) { return v < I_DN ? I_PRE + v : (v < I_DN + I_OUT ? I_LAYER + I_IN + (v - I_DN) : I_LAYER + I_PRE + (v - I_DN - I_OUT)); }
#endif
#ifdef DEFER_W
#define TR_MAPF(x) (trmode_ == 0 ? (x) : trmode_ == 1 ? tr_main(x) : tr_defer(x))
#else
#define TR_MAPF(x) (x)
#endif
#define TR_DECODE(T, IT0_) do { const int IT_ = TR_MAPF(IT0_); const int l_ = (IT_) / I_LAYER; int r_ = (IT_) % I_LAYER; bf16* Wl_ = (bf16*)(ws + WS_W + (size_t)l_ * W_LAYER); \
    if (r_ < I_IN) { T.W = w_in + (size_t)l_ * D * INW; T.WT = Wl_ + W_IN_OFF / 2; T.K = D; T.N = INW; T.item = r_; T.mode = 0; } \
    else if (r_ < I_IN + I_OUT) { T.W = w_out + (size_t)l_ * D * D; T.WT = Wl_ + W_OUT_OFF / 2; T.K = D; T.N = D; T.item = r_ - I_IN; T.mode = 0; } \
    else if (r_ < I_IN + I_OUT + I_G) { T.W = w_gate + (size_t)l_ * D * DFF; T.WT = Wl_ + W_GU_OFF / 2; T.K = D; T.N = DFF; T.item = r_ - I_IN - I_OUT; T.mode = 1; } \
    else if (r_ < I_IN + I_OUT + 2 * I_G) { T.W = w_up + (size_t)l_ * D * DFF; T.WT = Wl_ + W_GU_OFF / 2; T.K = D; T.N = DFF; T.item = r_ - I_IN - I_OUT - I_G; T.mode = 2; } \
    else { T.W = w_down + (size_t)l_ * DFF * D; T.WT = Wl_ + W_DN_OFF / 2; T.K = DFF; T.N = D; T.item = r_ - I_IN - I_OUT - 2 * I_G; T.mode = 0; } } while (0)
#define TRANSPOSE_RANGE(IT0, IT1, WIDX, NW) do { LAS float* scr_ = (LAS float*)(lds + wave * 16384); int it_ = (IT0) + (WIDX); \
    if (it_ < (IT1)) { TrItem cur_; TR_DECODE(cur_, it_); f32x4 v_[8]; transpose_load(v_, cur_, lane); \
        for (;;) { const int nx_ = it_ + (NW); const bool more_ = nx_ < (IT1); TrItem nt_ = cur_; f32x4 vn_[8]; \
            if (more_) { TR_DECODE(nt_, nx_); transpose_load(vn_, nt_, lane); } \
            transpose_store(v_, cur_, scr_, lane); \
            if (!more_) break; \
            cur_ = nt_; it_ = nx_; \
            _Pragma("unroll") for (int i_ = 0; i_ < 8; ++i_) v_[i_] = vn_[i_]; } } } while (0)
#define TRANSPOSE_RANGE_SIMPLE(IT0, IT1, WIDX, NW) do { LAS float* scr_ = (LAS float*)(lds + wave * 16384); \
    for (int it_ = (IT0) + (WIDX); it_ < (IT1); it_ += (NW)) { TrItem cur_; TR_DECODE(cur_, it_); f32x4 v_[8]; transpose_load(v_, cur_, lane); transpose_store(v_, cur_, scr_, lane); } } while (0)
#ifndef SHW_MFMA
#define SHW_RANGE(R0, R1, WIDX, NW) do { LAS float* shl_ = (LAS float*)lds; __syncthreads(); \
    for (int i_ = tid; i_ < 4 * BATCH * (D / 4); i_ += NWAVES * 64) { const int grp_ = i_ >> 11, rem_ = i_ & 2047, b_ = rem_ >> 8, c4_ = rem_ & 255; \
        *(LAS f32x4*)(shl_ + (size_t)i_ * 4) = *(const f32x4*)(MOD + ((size_t)(grp_ >> 1) * BATCH + b_) * (NMOD * D) + ((grp_ & 1) ? 3 * D : 0) + c4_ * 4); } \
    __syncthreads(); \
    for (int rb_ = (R0) + (WIDX); rb_ < (R1); rb_ += 2 * (NW)) { bf16x8 w0_[2], w1_[2]; \
        _Pragma("unroll") for (int i_ = 0; i_ < 2; ++i_) { const int r_ = rb_ + i_ * (NW); if (r_ < (R1)) { const int l_ = r_ / 9216, rr_ = r_ % 9216, type_ = rr_ >= INW ? 1 : 0, np_ = type_ ? rr_ - INW : rr_; \
            const bf16* wrow_ = (const bf16*)(ws + WS_W + (size_t)l_ * W_LAYER + (type_ ? W_GU_OFF : W_IN_OFF)) + (size_t)np_ * D; \
            w0_[i_] = *(const bf16x8*)(wrow_ + 8 * lane); w1_[i_] = *(const bf16x8*)(wrow_ + 512 + 8 * lane); } } \
        _Pragma("unroll") for (int i_ = 0; i_ < 2; ++i_) { const int r_ = rb_ + i_ * (NW); if (r_ < (R1)) { const int l_ = r_ / 9216, rr_ = r_ % 9216, type_ = rr_ >= INW ? 1 : 0, np_ = type_ ? rr_ - INW : rr_; \
            float wf_[16]; \
            _Pragma("unroll") for (int j_ = 0; j_ < 8; ++j_) { wf_[j_] = bf2f((unsigned short)w0_[i_][j_]); wf_[8 + j_] = bf2f((unsigned short)w1_[i_][j_]); } \
            float keep_ = 0.f; \
            _Pragma("unroll") for (int b_ = 0; b_ < BATCH; ++b_) { const LAS float* sh_ = shl_ + ((l_ * 2 + type_) * BATCH + b_) * D; \
                const f32x4 a0_ = *(const LAS f32x4*)(sh_ + 8 * lane), a1_ = *(const LAS f32x4*)(sh_ + 8 * lane + 4), a2_ = *(const LAS f32x4*)(sh_ + 512 + 8 * lane), a3_ = *(const LAS f32x4*)(sh_ + 512 + 8 * lane + 4); \
                float s_ = wf_[0] * a0_[0] + wf_[1] * a0_[1] + wf_[2] * a0_[2] + wf_[3] * a0_[3] + wf_[4] * a1_[0] + wf_[5] * a1_[1] + wf_[6] * a1_[2] + wf_[7] * a1_[3] \
                         + wf_[8] * a2_[0] + wf_[9] * a2_[1] + wf_[10] * a2_[2] + wf_[11] * a2_[3] + wf_[12] * a3_[0] + wf_[13] * a3_[1] + wf_[14] * a3_[2] + wf_[15] * a3_[3]; \
                s_ = wave_sum(s_); if (lane == b_) keep_ = s_; } \
            if (lane < BATCH) { if (type_) SHW2[((size_t)l_ * BATCH + lane) * 5632 + np_] = keep_; else SHW1[((size_t)l_ * BATCH + lane) * INW + np_] = keep_; } } } } } while (0)
#endif
#define SHW_MFMA_ALL() do { __syncthreads(); \
    for (int i_ = tid; i_ < 4 * BATCH * 128; i_ += NWAVES * 64) { const int grp_ = i_ >> 10, b_ = (i_ >> 7) & 7, ch_ = i_ & 127; \
        const float* src_ = MOD + ((size_t)(grp_ >> 1) * BATCH + b_) * (NMOD * D) + ((grp_ & 1) ? 3 * D : 0) + ch_ * 8; \
        const f32x4 a_ = *(const f32x4*)src_, c_ = *(const f32x4*)(src_ + 4); \
        v4u hi_, lo_; hi_.x = pk2(a_[0], a_[1]); hi_.y = pk2(a_[2], a_[3]); hi_.z = pk2(c_[0], c_[1]); hi_.w = pk2(c_[2], c_[3]); \
        lo_.x = pk2(a_[0] - __builtin_bit_cast(float, hi_.x << 16), a_[1] - __builtin_bit_cast(float, hi_.x & 0xffff0000u)); lo_.y = pk2(a_[2] - __builtin_bit_cast(float, hi_.y << 16), a_[3] - __builtin_bit_cast(float, hi_.y & 0xffff0000u)); \
        lo_.z = pk2(c_[0] - __builtin_bit_cast(float, hi_.z << 16), c_[1] - __builtin_bit_cast(float, hi_.z & 0xffff0000u)); lo_.w = pk2(c_[2] - __builtin_bit_cast(float, hi_.w << 16), c_[3] - __builtin_bit_cast(float, hi_.w & 0xffff0000u)); \
        *(LAS v4u*)(lds + grp_ * 32768 + b_ * 2048 + ((ch_ ^ b_) << 4)) = hi_; *(LAS v4u*)(lds + grp_ * 32768 + (8 + b_) * 2048 + ((ch_ ^ (8 + b_)) << 4)) = lo_; } \
    __syncthreads(); \
    for (int it_ = wave * G + vcu; it_ < DEPTH * 9216 / 16; it_ += NWAVES * G) { \
        const int r0_ = it_ * 16, l_ = r0_ / 9216, rr_ = r0_ % 9216, type_ = rr_ >= INW ? 1 : 0, np0_ = type_ ? rr_ - INW : rr_, fr_ = lane & 15, fq_ = lane >> 4; \
        const bf16* wrow_ = (const bf16*)(ws + WS_W + (size_t)l_ * W_LAYER + (type_ ? W_GU_OFF : W_IN_OFF)) + (size_t)(np0_ + fr_) * D + 8 * fq_; \
        LAS unsigned char* ab_ = lds + (l_ * 2 + type_) * 32768 + fr_ * 2048; \
        f32x4 c_ = {0.f, 0.f, 0.f, 0.f}; \
        { bf16x8 bw_[32];                                     \
            _Pragma("unroll") for (int j_ = 0; j_ < 32; ++j_) bw_[j_] = *(const bf16x8*)(wrow_ + j_ * 32); \
            _Pragma("unroll") for (int j_ = 0; j_ < 32; ++j_) { const int ch_ = 4 * j_ + fq_; c_ = mfma16(*(const LAS bf16x8*)(ab_ + ((ch_ ^ fr_) << 4)), bw_[j_], c_); } } \
        _Pragma("unroll") for (int r_ = 0; r_ < 4; ++r_) { const float t_ = c_[r_] + __shfl_xor(c_[r_], 32); \
            if (lane < 32) { const int bt_ = 4 * fq_ + r_; if (type_) SHW2[((size_t)l_ * BATCH + bt_) * 5632 + np0_ + fr_] = t_; else SHW1[((size_t)l_ * BATCH + bt_) * INW + np0_ + fr_] = t_; } } } } while (0)
#ifndef A0_ROWS
#define A0_ROWS 8
#endif
struct Args { const float* in[15]; float* out; unsigned char* ws; };
__global__ void __launch_bounds__(NWAVES * 64, 2) fwd_kernel(Args args) {
    extern __shared__ __attribute__((aligned(16))) unsigned char lds_raw[];
    LAS unsigned char* lds = (LAS unsigned char*)lds_raw;
    volatile LAS unsigned* MISC = (volatile LAS unsigned*)(lds + MISC_OFF);
    const int tid = threadIdx.x, lane = tid & 63, wave = __builtin_amdgcn_readfirstlane(tid >> 6);
    const int G = gridDim.x, bx = blockIdx.x;
    const int vcu = (G % 8 == 0) ? (bx % 8) * (G / 8) + bx / 8 : bx;
    const int gw = vcu * NWAVES + wave, NGW = G * NWAVES;
    unsigned char* ws = args.ws;
    const float* x = args.in[0]; const float* cvec = args.in[1]; const float* w_ada = args.in[2]; const float* b_ada = args.in[3];
    const float* norm_mix_w = args.in[4]; const float* w_in = args.in[5]; const float* ret_norm_w = args.in[6]; const float* hg_lb = args.in[7];
    const float* hg_norm_w = args.in[8]; const float* w_out = args.in[9]; const float* norm_ffn_w = args.in[10]; const float* w_gate = args.in[11];
    const float* w_up = args.in[12]; const float* w_down = args.in[13]; const float* final_w = args.in[14];
    float* out = args.out; bf16* X16 = (bf16*)args.out;
    gu32* ctl = (gu32*)(ws + WS_CTL);
    float* MOD = (float*)(ws + WS_MOD); float* SSUM = (float*)(ws + WS_SSUM); float2* TAB = (float2*)(ws + WS_TAB);
    float* SHW1 = (float*)(ws + WS_SHW1); float* SHW2 = (float*)(ws + WS_SHW2); float* BL = (float*)(ws + WS_BL);
    bf16* ABUF = (bf16*)(ws + WS_A); bf16* PROJ = (bf16*)(ws + WS_PROJ); bf16* URET = (bf16*)(ws + WS_URET); bf16* UHG = (bf16*)(ws + WS_UHG); bf16* A2 = (bf16*)(ws + WS_A2);

    for (int u = tid; u < (LDS_BYTES - LDSCTL_OFF) / 4; u += NWAVES * 64) ((LAS unsigned*)(lds + LDSCTL_OFF))[u] = 0u;
    __syncthreads();
    XcdBarrier bar = xcd_barrier_post((unsigned*)(ctl + CW_BAR), MISC + 8);
#ifdef PROBE_A
    unsigned long long tprev = __builtin_amdgcn_s_memrealtime(); float TA = 0.f, TB = 0.f; int pidx = 0;
#define GRID_BAR() do { xcd_barrier(bar); const unsigned long long tn = __builtin_amdgcn_s_memrealtime(); const float dt = (float)(tn - tprev) * 0.01f; if ((PROBE_A >> pidx) & 1) TA += dt; if ((PROBE_B >> pidx) & 1) TB += dt; tprev = tn; ++pidx; } while (0)
#else
#ifdef DUP_BAR
#define GRID_BAR() do { xcd_barrier(bar); xcd_barrier(bar); } while (0)
#else
#define GRID_BAR() xcd_barrier(bar)
#endif
#endif

    {
        LAS float* cs = (LAS float*)lds;
#if defined(ADA_CS8) || defined(ADA_NOATOM)
        for (int i = tid; i < BATCH * D; i += NWAVES * 64) cs[(i & (D - 1)) * BATCH + (i >> 10)] = pg8::silu_f(cvec[i]);
#else
        for (int i = tid; i < BATCH * D; i += NWAVES * 64) cs[i] = pg8::silu_f(cvec[i]);
#endif
        __syncthreads();
#ifdef ADA_NOATOM
        for (int uidx = vcu; uidx < 192; uidx += G) {
            LAS float* part = (LAS float*)(lds + 32768);
            const int l = uidx / 96, cg = uidx % 96;
            float acc[BATCH];
#pragma unroll
            for (int b = 0; b < BATCH; ++b) acc[b] = 0.f;
            const float* w = w_ada + (size_t)l * D * (NMOD * D) + (size_t)(wave * 128) * (NMOD * D) + cg * 64 + lane;
            const LAS float* csw = cs + wave * 128 * BATCH;
#pragma unroll 16
            for (int k = 0; k < 128; ++k) { const float wv = LD_ONCE(w + (size_t)k * (NMOD * D));
                const f32x4 c0 = *(const LAS f32x4*)(csw + k * 8), c1 = *(const LAS f32x4*)(csw + k * 8 + 4);
                acc[0] += c0[0] * wv; acc[1] += c0[1] * wv; acc[2] += c0[2] * wv; acc[3] += c0[3] * wv; acc[4] += c1[0] * wv; acc[5] += c1[1] * wv; acc[6] += c1[2] * wv; acc[7] += c1[3] * wv; }
#pragma unroll
            for (int b = 0; b < BATCH; ++b) part[(wave * BATCH + b) * 64 + lane] = acc[b];
            __syncthreads();
            {
                float s = b_ada[l * NMOD * D + cg * 64 + lane];
#pragma unroll
                for (int w8 = 0; w8 < NWAVES; ++w8) s += part[(w8 * BATCH + wave) * 64 + lane];
                MOD[((size_t)l * BATCH + wave) * (NMOD * D) + cg * 64 + lane] = s;
            }
            __syncthreads();
        }
#else
#ifdef DUP_ADA
        for (int rep_ = 0; rep_ < 2; ++rep_)
#else
        const int rep_ = 1;
#endif
        for (int uidx = vcu; uidx < 240; uidx += G) {
            const int l = uidx / 120, r = uidx % 120, cg = r / 10, ks = r % 10, k0 = (ks * 1024) / 10, k1 = ((ks + 1) * 1024) / 10, n = cg * 512 + tid;
            float acc[BATCH];
#pragma unroll
            for (int b = 0; b < BATCH; ++b) acc[b] = 0.f;
            const float* w = w_ada + (size_t)l * D * (NMOD * D) + n;
#pragma unroll 17
            for (int k = k0; k < k1; ++k) { const float wv = LD_ONCE(w + (size_t)k * (NMOD * D));
#ifdef ADA_CS8
                const f32x4 c0 = *(const LAS f32x4*)(cs + k * 8), c1 = *(const LAS f32x4*)(cs + k * 8 + 4);
                acc[0] += c0[0] * wv; acc[1] += c0[1] * wv; acc[2] += c0[2] * wv; acc[3] += c0[3] * wv; acc[4] += c1[0] * wv; acc[5] += c1[1] * wv; acc[6] += c1[2] * wv; acc[7] += c1[3] * wv; }
#else
#pragma unroll
                for (int b = 0; b < BATCH; ++b) acc[b] += cs[b * D + k] * wv; }
#endif
            const float bb = ks == 0 ? b_ada[l * NMOD * D + n] : 0.f;
#pragma unroll
            for (int b = 0; b < BATCH; ++b) atomicAdd((rep_ == 1 ? MOD : (float*)(ws + WS_URET)) + ((size_t)l * BATCH + b) * (NMOD * D) + n, acc[b] + bb);
        }
#endif
        __syncthreads();
#ifdef DEFER_W
        { const int trmode_ = 1; TRANSPOSE_RANGE(0, N_MAIN, gw, NGW); }
#else
        TRANSPOSE_RANGE(0, DEPTH * I_LAYER, gw, NGW);
#endif
#ifdef DUP_P0A
        TRANSPOSE_RANGE(0, DEPTH * I_LAYER, gw, NGW);
#endif
        for (int idx = vcu * (NWAVES * 64) + tid; idx < SEQ * 32; idx += G * NWAVES * 64) {
            const int pos = idx >> 5, i = idx & 31;
            const float lin = (float)i / 31.0f;
            const float inv = (float)exp(-(double)lin * 9.210340371976184);
            const float theta = (float)pos * inv;
            const double rev = (double)theta * 0.15915494309189535;
            const double ang = (rev - rint(rev)) * 6.283185307179586;
            TAB[idx] = make_float2((float)cos(ang), (float)sin(ang));
        }
    }
    GRID_BAR();
#ifdef DUP_P0B
    for (int rep = 0; rep < 2; ++rep)
#endif
    {
        for (int rg = gw; rg < M / A0_ROWS; rg += NGW) {
            const int row0 = rg * A0_ROWS, b = row0 >> 11;
            f32x4 v[A0_ROWS][4];
#pragma unroll
            for (int r = 0; r < A0_ROWS; ++r)
#pragma unroll
                for (int j = 0; j < 4; ++j) v[r][j] = LD_ONCE((const f32x4*)(x + (size_t)(row0 + r) * D) + lane + 64 * j);
            f32x4 wm[4];
#pragma unroll
            for (int j = 0; j < 4; ++j) { const int col = (lane + 64 * j) * 4; wm[j] = (*(const f32x4*)(norm_mix_w + col)) * (1.f + *(const f32x4*)(MOD + (size_t)b * (NMOD * D) + D + col)); }
#pragma unroll
            for (int r = 0; r < A0_ROWS; ++r) {
                float s = 0.f;
#pragma unroll
                for (int j = 0; j < 4; ++j) s += (v[r][j][0] * v[r][j][0] + v[r][j][1] * v[r][j][1]) + (v[r][j][2] * v[r][j][2] + v[r][j][3] * v[r][j][3]);
                s = wave_sum(s);
                if (lane == 0) SSUM[row0 + r] = s;
                v2u* o8 = (v2u*)(ABUF + (size_t)(row0 + r) * D) + lane;
#pragma unroll
                for (int j = 0; j < 4; ++j) { const f32x4 a = v[r][j] * wm[j]; v2u w; w.x = pk2(a[0], a[1]); w.y = pk2(a[2], a[3]); o8[64 * j] = w; }
            }
        }
#ifdef SHW_MFMA
        SHW_MFMA_ALL();
#else
        SHW_RANGE(0, DEPTH * 9216, gw, NGW);
#endif
    }
    GRID_BAR();
    for (int l = 0; l < DEPTH; ++l) {
        const bf16* Wl = (const bf16*)(ws + WS_W + (size_t)l * W_LAYER);
        const float* modl = MOD + (size_t)l * BATCH * (NMOD * D);
        {
            const int nM = M / 256;
            const bool split = (nM * 12) % G == 0 && nM * 4 == G;
            for (int part = 0; part < 2; ++part) {
                const int t0 = part == 0 ? 0 : (split ? 12 : 14), ntl = part == 0 ? (split ? 12 : 14) : (split ? 2 : 0);
                pg8::Gemm g{ABUF, Wl + W_IN_OFF / 2 + (size_t)t0 * 256 * D, M, ntl * 256, D}; pg8::StaticOrder S; S.init(M, ntl * 256, G, bx);
                pg8::EpiWin E{PROJ, SSUM + (size_t)(2 * l) * M, SHW1 + (size_t)l * BATCH * INW, TAB, hg_lb, l, lds + STAGE_OFF, t0};
                pg8::gemm_phase<pg8::EpiWin, pg8::StaticOrder, GEMM_ALIGN, GEMM_SP2>(lds, g, S, E);
                if (part == 0) GRID_BAR();
            }
            int first = bx, step = G;
#ifdef P2_REBAL
            if (split) { const int nb = nM * 2; if (bx < nb) { first = 1024; step = 1024; } else { first = bx - nb; step = G - nb; } }
#else
            if (split) { const int nb = nM * 2; if (bx < nb) { first = bx; step = 1024; } else { first = bx; step = G - nb; } }
#endif
#if defined(P2_PAIR)
            mix_state_pair_loop(lds, PROJ, UHG, URET, BL, first, step, 1024, tid);
#elif defined(MIX_CHAIN_P2)
            mix_state_both(lds, PROJ, UHG, URET, BL, first, step, 1024, tid);
#else
            mix_state_loop<128, false>(lds, PROJ, UHG, BL, first, step, 1024, tid);
            mix_state_loop<64, true>(lds, PROJ, URET, BL, first, step, 1024, tid);
#endif
        }
        GRID_BAR();
#ifdef DUP_P3
        for (int rep = 0; rep < 2; ++rep)
#else
        const int rep = 1;
#endif
        {
            int tid3 = threadIdx.x; asm volatile("" : "+v"(tid3));
#ifdef P3_SPREAD
            for (int W3 = (tid3 >> 6) * G + bx; W3 < 1536; W3 += NWAVES * G)
            if (W3 < 512) { const int w = W3 * 64 + (tid3 & 63);
#else
            for (int w = bx * (NWAVES * 64) + tid3; w < 32768; w += G * NWAVES * 64) {
#endif
                const int bh = w >> 10; bf16* base = URET + (size_t)bh * 32 * 8192 + (size_t)(w & 1023) * 8;
                const float dret = __builtin_amdgcn_exp2f(64.f * __log2f(1.f - exp2f(-5.f - (float)(bh & 3))));
                float S[8];
#pragma unroll
                for (int e = 0; e < 8; ++e) S[e] = 0.f;
                for (int cb = 0; cb < NCH; cb += 8) {
                    v4u uv[8];
#pragma unroll
                    for (int k = 0; k < 8; ++k) uv[k] = *(const v4u*)(base + (size_t)(cb + k) * 8192);
#pragma unroll
                    for (int k = 0; k < 8; ++k) {
                        v4u sv; sv.x = pk2(S[0], S[1]); sv.y = pk2(S[2], S[3]); sv.z = pk2(S[4], S[5]); sv.w = pk2(S[6], S[7]);
                        *(v4u*)(base + (size_t)(cb + k) * 8192) = sv;
                        const unsigned uu[4] = {uv[k].x, uv[k].y, uv[k].z, uv[k].w};
#pragma unroll
                        for (int e = 0; e < 4; ++e) { S[2 * e] = dret * S[2 * e] + __builtin_bit_cast(float, uu[e] << 16); S[2 * e + 1] = dret * S[2 * e + 1] + __builtin_bit_cast(float, uu[e] & 0xffff0000u); }
                    }
                }
            }
#ifdef P3_SPREAD
            else { const int w2 = (W3 - 512) * 64 + (tid3 & 63);
#else
            for (int w2 = bx * (NWAVES * 64) + tid3; w2 < 65536; w2 += G * NWAVES * 64) {
#endif
                const int bh = w2 >> 11, d0 = (w2 & 15) * 8; bf16* base = UHG + (size_t)bh * 32 * 16384 + (size_t)(w2 & 2047) * 8; const float* blp = BL + (size_t)bh * 32 * 128 + d0;
                float S[8];
#pragma unroll
                for (int e = 0; e < 8; ++e) S[e] = 0.f;
                for (int cb = 0; cb < NCH; cb += 4) {
                    v4u uv[4]; f32x4 bl0[4], bl1[4];
#pragma unroll
                    for (int k = 0; k < 4; ++k) { uv[k] = *(const v4u*)(base + (size_t)(cb + k) * 16384); bl0[k] = *(const f32x4*)(blp + (cb + k) * 128); bl1[k] = *(const f32x4*)(blp + (cb + k) * 128 + 4); }
#pragma unroll
                    for (int k = 0; k < 4; ++k) {
                        float dec[8];
#pragma unroll
                        for (int e = 0; e < 4; ++e) { dec[e] = __builtin_amdgcn_exp2f(bl0[k][e]); dec[4 + e] = __builtin_amdgcn_exp2f(bl1[k][e]); }
                        v4u sv; sv.x = pk2(S[0], S[1]); sv.y = pk2(S[2], S[3]); sv.z = pk2(S[4], S[5]); sv.w = pk2(S[6], S[7]);
                        *(v4u*)(base + (size_t)(cb + k) * 16384) = sv;
                        const unsigned uu[4] = {uv[k].x, uv[k].y, uv[k].z, uv[k].w};
#pragma unroll
                        for (int e = 0; e < 4; ++e) { S[2 * e] = dec[2 * e] * S[2 * e] + __builtin_bit_cast(float, uu[e] << 16); S[2 * e + 1] = dec[2 * e + 1] * S[2 * e + 1] + __builtin_bit_cast(float, uu[e] & 0xffff0000u); }
                    }
                }
            }
        }
        GRID_BAR();
#ifdef DUP_P4
        for (int rep = 0; rep < 2; ++rep)
#endif
        {
#if defined(OLD_P4)
            for (int i = bx; i < 2048; i += G) { if (i < 1024) mix_out_item_v1<128, false>(lds, PROJ, UHG, hg_norm_w + l * 512, ABUF, i, tid); else mix_out_item_v1<64, true>(lds, PROJ, URET, ret_norm_w + l * 512, ABUF, i - 1024, tid); }
#elif defined(OLD_P4_RET)
#ifdef DUP_P4HG
            mix_out_loop<128, false>(lds, PROJ, UHG, hg_norm_w + l * 512, ABUF, bx, G, tid);
            __syncthreads();
#endif
            mix_out_loop<128, false>(lds, PROJ, UHG, hg_norm_w + l * 512, ABUF, bx, G, tid);
            __syncthreads();
#ifdef DUP_P4RET
            for (int i = bx; i < 1024; i += G) mix_out_item_v1<64, true>(lds, PROJ, URET, ret_norm_w + l * 512, ABUF, i, tid);
#endif
            for (int i = bx; i < 1024; i += G) mix_out_item_v1<64, true>(lds, PROJ, URET, ret_norm_w + l * 512, ABUF, i, tid);
#elif defined(OLD_P4_HG)
            for (int i = bx; i < 1024; i += G) mix_out_item_v1<128, false>(lds, PROJ, UHG, hg_norm_w + l * 512, ABUF, i, tid);
            mix_out_loop<64, true>(lds, PROJ, URET, ret_norm_w + l * 512, ABUF, bx, G, tid);
#elif defined(RET_NEW_LAYER)
            mix_out_loop<128, false>(lds, PROJ, UHG, hg_norm_w + l * 512, ABUF, bx, G, tid);
            __syncthreads();
            if (l == RET_NEW_LAYER) mix_out_loop<64, true>(lds, PROJ, URET, ret_norm_w + l * 512, ABUF, bx, G, tid);
            else for (int i = bx; i < 1024; i += G) mix_out_item_v1<64, true>(lds, PROJ, URET, ret_norm_w + l * 512, ABUF, i, tid);
#elif defined(RET_FIRST)
            mix_out_loop<64, true>(lds, PROJ, URET, ret_norm_w + l * 512, ABUF, bx, G, tid);
            __syncthreads();
            mix_out_loop<128, false>(lds, PROJ, UHG, hg_norm_w + l * 512, ABUF, bx, G, tid);
#else
#ifdef DUP_P4N
            for (int rep = 0; rep < 2; ++rep)
#endif
#ifdef MIX_CHAIN
            { mix_out_both(lds, PROJ, UHG, URET, hg_norm_w + l * 512, ret_norm_w + l * 512, ABUF, bx, G, tid); __syncthreads(); }
#else
            { mix_out_loop<128, false>(lds, PROJ, UHG, hg_norm_w + l * 512, ABUF, bx, G, tid);
            mix_out_loop<64, true>(lds, PROJ, URET, ret_norm_w + l * 512, ABUF, bx, G, tid); __syncthreads(); }
#endif
#endif
        }
        GRID_BAR();
#ifdef DIFF_RET
        if (l == 0) {
            bf16* O2 = (bf16*)out;
            for (int i2 = bx; i2 < 1024; i2 += G) mix_out_item_v1<64, true>(lds, PROJ, URET, ret_norm_w + l * 512, O2, i2, tid);
            GRID_BAR();
            unsigned* PRBU = (unsigned*)(ws + 33792);
            unsigned cnt = 0; unsigned long long best = 0ull;
            for (int idx = bx * 512 + tid; idx < M * 512; idx += G * 512) { const int row = idx >> 9, col = idx & 511;
                const float a = bf2f(ABUF[(size_t)row * 1024 + col]), bq = bf2f(O2[(size_t)row * 1024 + col]); const float df = fabsf(a - bq);
                if (df > 0.05f + 0.05f * fabsf(bq)) { ++cnt; const unsigned long long key = ((unsigned long long)__builtin_bit_cast(unsigned, df) << 32) | (unsigned)idx; if (key > best) best = key; } }
            if (cnt) atomicAdd(PRBU, cnt);
            if (best) atomicMax((unsigned long long*)(PRBU + 2), best);
            GRID_BAR();
        }
#endif
        {
            pg8::Gemm g{ABUF, Wl + W_OUT_OFF / 2, M, D, D}; pg8::StaticOrder S; S.init(M, D, G, bx);
            if (l == 0) { pg8::EpiRes<true> E{x, X16, modl + 2 * D, norm_ffn_w + l * D, modl + 4 * D, A2, SSUM + (size_t)(2 * l + 1) * M};
                pg8::gemm_phase<pg8::EpiRes<true>, pg8::StaticOrder, true, GEMM_SP2>(lds, g, S, E); }
            else { pg8::EpiRes<false> E{X16, X16, modl + 2 * D, norm_ffn_w + l * D, modl + 4 * D, A2, SSUM + (size_t)(2 * l + 1) * M};
                pg8::gemm_phase<pg8::EpiRes<false>, pg8::StaticOrder, true, GEMM_SP2>(lds, g, S, E); }
        }
        GRID_BAR();
        {
#ifdef HALF_TAIL
            pg8::Gemm g{A2, Wl + W_GU_OFF / 2, M, 2 * DFF, D};
            const int nwg6 = (M / 256) * (2 * DFF / 256), remh = nwg6 % G, nfull6 = nwg6 / G; const bool halft = remh != 0 && 2 * remh == G;
            pg8::EpiFfn E{PROJ, SSUM + (size_t)(2 * l + 1) * M, SHW2 + (size_t)l * BATCH * 5632, lds + STAGE_OFF};
            if (halft) {
                pg8::LimitOrder SL; SL.base.init(M, 2 * DFF, G, bx); SL.maxr = nfull6;
                pg8::gemm_phase<pg8::EpiFfn, pg8::LimitOrder, GEMM_ALIGN, GEMM_SP2>(lds, g, SL, E);
                pg8::StaticOrder T; T.init(M, 2 * DFF, G, bx % remh); pg8::Unit uh; T.next(nfull6, uh);
                pg8::gemm_half_unit<pg8::EpiFfn>(lds, g, uh, bx / remh, E, 0);
#ifdef DUP_HALF
                __syncthreads(); pg8::gemm_half_unit<pg8::EpiFfn>(lds, g, uh, bx / remh, E, 0);
#endif
            } else {
            pg8::StaticOrder S; S.init(M, 2 * DFF, G, bx);
            pg8::gemm_phase<pg8::EpiFfn, pg8::StaticOrder, GEMM_ALIGN, GEMM_SP2>(lds, g, S, E);
            }
#else
            pg8::Gemm g{A2, Wl + W_GU_OFF / 2, M, 2 * DFF, D}; pg8::StaticOrder S; S.init(M, 2 * DFF, G, bx);
            pg8::EpiFfn E{PROJ, SSUM + (size_t)(2 * l + 1) * M, SHW2 + (size_t)l * BATCH * 5632, lds + STAGE_OFF};
#ifdef STAGGER_P6
            {
                const int rem6 = ((M / 256) * (2 * DFF / 256)) % G;
                if (rem6 != 0 && bx >= rem6) { const unsigned long long t0 = __builtin_amdgcn_s_memrealtime(); while (__builtin_amdgcn_s_memrealtime() - t0 < (unsigned long long)(STAGGER_P6)) __builtin_amdgcn_s_sleep(8); }
            }
#endif
            pg8::gemm_phase<pg8::EpiFfn, pg8::StaticOrder, GEMM_ALIGN, GEMM_SP2>(lds, g, S, E);
#ifdef TAIL_DUP
            if (l == 0) {
                const int rem6 = ((M / 256) * (2 * DFF / 256)) % G;
                if (rem6 != 0 && bx >= rem6) { __syncthreads(); const int wi6 = (bx - rem6) * NWAVES + wave; TRANSPOSE_RANGE_SIMPLE(0, TAIL_DUP, wi6, (G - rem6) * NWAVES); }
            }
#endif
#ifdef DEFER_W
            if (l == 0) {
                const int rem6 = ((M / 256) * (2 * DFF / 256)) % G, nb6 = rem6 ? G - rem6 : G;
                if (rem6 == 0 || bx >= rem6) { __syncthreads(); const int trmode_ = 2; const int wi6 = ((rem6 ? bx - rem6 : bx)) * NWAVES + wave; TRANSPOSE_RANGE_SIMPLE(0, N_DEFER, wi6, nb6 * NWAVES); }
            }
#endif
#ifdef DUP_P6
            __syncthreads(); pg8::gemm_phase<pg8::EpiFfn, pg8::StaticOrder, GEMM_ALIGN, GEMM_SP2>(lds, g, S, E);
#endif
#endif
        }
        GRID_BAR();
        const bool has_next = (l + 1 < DEPTH);
        const bool fuse_final = !has_next && (M / 256) * (D / 256) == G;
        {
            pg8::Gemm g{PROJ, Wl + W_DN_OFF / 2, M, D, DFF}; pg8::StaticOrder S; S.init(M, D, G, bx);
            if (fuse_final) {
                pg8::EpiFinal E{X16, out, modl + 5 * D, final_w, SSUM + (size_t)(2 * l + 2) * M, &bar};
                pg8::gemm_phase<pg8::EpiFinal, pg8::StaticOrder, false, GEMM_SP2>(lds, g, S, E);
            } else {
                pg8::EpiRes<false> E{X16, X16, modl + 5 * D, has_next ? norm_mix_w + (l + 1) * D : nullptr, modl + BATCH * (NMOD * D) + D, ABUF, SSUM + (size_t)(2 * l + 2) * M};
                pg8::gemm_phase<pg8::EpiRes<false>, pg8::StaticOrder, true, GEMM_SP2>(lds, g, S, E);
            }
        }
        if (fuse_final) return;
        GRID_BAR();
    }
    {
        int tid_f = threadIdx.x; asm volatile("" : "+v"(tid_f)); const int lane_f = tid_f & 63;
        v4u hold[16][2];
#pragma unroll
        for (int i = 0; i < 16; ++i) { const int row = gw + i * NGW; if (row < M) { hold[i][0] = *((const v4u*)(X16 + (size_t)row * D) + lane_f * 2); hold[i][1] = *((const v4u*)(X16 + (size_t)row * D) + lane_f * 2 + 1); } }
        GRID_BAR();
#pragma unroll
        for (int i = 0; i < 16; ++i) { const int row = gw + i * NGW; if (row < M) {
            const float rs = __builtin_amdgcn_rsqf(SSUM[(size_t)4 * M + row] * (1.f / D) + EPS);
#pragma unroll
            for (int hh = 0; hh < 2; ++hh) { const unsigned w4[4] = {hold[i][hh].x, hold[i][hh].y, hold[i][hh].z, hold[i][hh].w};
#pragma unroll
                for (int q = 0; q < 2; ++q) { const int col = lane_f * 16 + hh * 8 + q * 4; const f32x4 fwv = *(const f32x4*)(final_w + col);
                    f32x4 o; o[0] = pg8::f16lo(w4[2 * q]); o[1] = pg8::f16hi(w4[2 * q]); o[2] = pg8::f16lo(w4[2 * q + 1]); o[3] = pg8::f16hi(w4[2 * q + 1]);
                    *(f32x4*)(out + (size_t)row * D + col) = o * rs * fwv; } } } }
    }
}

extern "C" void kernel_launch(void* const* d_in, const int* in_sizes, int n_in, void* d_out, int out_size, void* d_ws, size_t ws_size, hipStream_t stream) {
    static int grid = 0;
    if (grid == 0) {
        if (n_in != 15 || in_sizes[0] != M * D || out_size != M * D || ws_size < WS_END) { fprintf(stderr, "kernel_launch: unexpected shapes (n_in %d, in0 %d, out %d, ws %zu); nothing launched\n", n_in, n_in > 0 ? in_sizes[0] : -1, out_size, ws_size); grid = -1; return; }
        int dev = 0, cus = 0, per_cu = 0;
        if (hipGetDevice(&dev) != hipSuccess || hipDeviceGetAttribute(&cus, hipDeviceAttributeMultiprocessorCount, dev) != hipSuccess) { fprintf(stderr, "kernel_launch: device query failed\n"); grid = -1; return; }
        if (hipFuncSetAttribute((const void*)fwd_kernel, hipFuncAttributeMaxDynamicSharedMemorySize, LDS_BYTES) != hipSuccess) { fprintf(stderr, "kernel_launch: hipFuncSetAttribute failed\n"); grid = -1; return; }
        if (hipOccupancyMaxActiveBlocksPerMultiprocessor(&per_cu, (const void*)fwd_kernel, NWAVES * 64, LDS_BYTES) != hipSuccess || per_cu < 1)
            fprintf(stderr, "kernel_launch: note: occupancy query reports %d workgroups per CU\n", per_cu);
        (void)hipGetLastError();
        grid = cus;
    }
    if (grid < 0) return;
    if (hipMemsetAsync((char*)d_ws + WS_CTL, 0, CTL_ZERO_BYTES, stream) != hipSuccess) { fprintf(stderr, "kernel_launch: hipMemsetAsync failed\n"); return; }
    Args a{};
    for (int i = 0; i < 15; ++i) a.in[i] = (const float*)d_in[i];
    a.out = (float*)d_out; a.ws = (unsigned char*)d_ws;
    hipLaunchKernelGGL(fwd_kernel, dim3(grid), dim3(NWAVES * 64), LDS_BYTES, stream, a);
    const hipError_t le = hipPeekAtLastError();
    if (le != hipSuccess) fprintf(stderr, "kernel_launch: launch failed: %s\n", hipGetErrorName(le));
}
```

```cpp
#include <hip/hip_runtime.h>
#include <cstdio>
#include <cstdint>
#define LAS __attribute__((address_space(3)))


#define XB_TMO      128
#define XB_XCNT(j)  (256  + 64 * (j))
#define XB_XSUB(j)  (1280 + 64 * (j))
#define XB_XGEN(j)  (2304 + 64 * (j))
#define XB_TOP      3328
#define XB_TOPGEN   3392
#define XCD_BAR_WORDS 3456
#define XB_SPIN_CAP (1u << 18)

__device__ __forceinline__ unsigned xb_ld(unsigned* p)              { return __hip_atomic_load(p, __ATOMIC_RELAXED, __HIP_MEMORY_SCOPE_AGENT); }
__device__ __forceinline__ unsigned xb_add(unsigned* p, unsigned v) { return __hip_atomic_fetch_add(p, v, __ATOMIC_RELAXED, __HIP_MEMORY_SCOPE_AGENT); }
__device__ __forceinline__ unsigned xb_xcc_id() { return (unsigned)__builtin_amdgcn_s_getreg((3 << 11) | 20) & 0xFu; }
#define XB_SPIN(cond, bar) do { unsigned _sp = 0; while (cond) { __builtin_amdgcn_s_sleep(1); \
    if ((++_sp & 255u) == 0u) { if (xb_ld(&(bar)[XB_TMO])) break; if (_sp > XB_SPIN_CAP) { atomicAdd(&(bar)[XB_TMO], 1u); break; } } } } while (0)

struct XcdBarrier {
    unsigned* bar; unsigned x;
    volatile LAS unsigned* st;
};

__device__ __forceinline__ XcdBarrier xcd_barrier_post(unsigned* bar, volatile LAS unsigned* st) {
    XcdBarrier b; b.bar = bar; b.x = xb_xcc_id(); b.st = st;
    if (threadIdx.x == 0) (void)xb_add(&bar[XB_XCNT(b.x)], 1u);
    return b;
}
__device__ __forceinline__ void xcd_barrier_complete(unsigned* bar, unsigned x, unsigned& nloc, unsigned& nx) {
    const unsigned G = gridDim.x * gridDim.y * gridDim.z;
    unsigned sum, cnt, mine, sp = 0u;
    for (;;) {
        sum = 0u; cnt = 0u; mine = 0u;
#pragma unroll
        for (unsigned j = 0; j < 16; ++j) { const unsigned c = xb_ld(&bar[XB_XCNT(j)]); sum += c; cnt += (c > 0u) ? 1u : 0u; mine = (j == x) ? c : mine; }
        if (sum == G) break;
        __builtin_amdgcn_s_sleep(1);
        if ((++sp & 255u) == 0u) { if (xb_ld(&bar[XB_TMO])) break; if (sp > XB_SPIN_CAP) { atomicAdd(&bar[XB_TMO], 1u); break; } }
    }
    nloc = mine > 0u ? mine : 1u; nx = cnt > 0u ? cnt : 1u;
}

__device__ __forceinline__ void xcd_barrier(const XcdBarrier& b) {
    asm volatile("s_waitcnt vmcnt(0)" ::: "memory");
    __syncthreads();
    if (threadIdx.x == 0) {
        unsigned* bar = b.bar; const unsigned bx_ = xb_xcc_id();
        __builtin_amdgcn_s_waitcnt(0);
        unsigned nloc = b.st[0], nx = b.st[1];
        if (nloc == 0u) { xcd_barrier_complete(bar, bx_, nloc, nx); b.st[0] = nloc; b.st[1] = nx; }
        const unsigned old = xb_add(&bar[XB_XSUB(bx_)], 1u);
        const unsigned gen = old / nloc;
        if (old + 1u == (gen + 1u) * nloc) {
            __builtin_amdgcn_fence(__ATOMIC_RELEASE, "agent");
            asm volatile("s_waitcnt vmcnt(0)" ::: "memory");
            const unsigned og = xb_add(&bar[XB_TOP], 1u);
            const unsigned tg = og / nx;
            if (og + 1u == (tg + 1u) * nx) xb_add(&bar[XB_TOPGEN], 1u);
            else XB_SPIN(xb_ld(&bar[XB_TOPGEN]) == tg, bar);
            __builtin_amdgcn_fence(__ATOMIC_ACQUIRE, "agent");
            xb_add(&bar[XB_XGEN(bx_)], 1u);
            asm volatile("s_waitcnt vmcnt(0)" ::: "memory");
        } else {
            XB_SPIN(xb_ld(&bar[XB_XGEN(bx_)]) == gen, bar);
            __builtin_amdgcn_fence(__ATOMIC_ACQUIRE, "agent");
            asm volatile("s_waitcnt vmcnt(0)" ::: "memory");
        }
    }
    __syncthreads();
}

namespace pg8 {
#define PG8_LAS __attribute__((address_space(3)))
typedef unsigned short bf16_t;
typedef short bf16x8 __attribute__((ext_vector_type(8)));
typedef float f32x4 __attribute__((ext_vector_type(4)));
typedef unsigned u32x4 __attribute__((ext_vector_type(4)));
constexpr int BM = 256, BK = 64, HALF = 128, HTB = HALF * BK * 2  , STAGE_BYTES = 8 * HTB, NXCD = 8;
constexpr int WGM = 2;

__host__ __device__ __forceinline__ int lds_byte(int r, int c) { const int st = (r >> 4) * 2 + (c >> 5), rr = r & 15, cc = c & 31, ob = rr * 64 + cc * 2; return st * 1024 + (ob ^ (((ob >> 9) & 1) << 5)); }
__host__ __device__ __forceinline__ void stage_rc(int b, int& R, int& C) { const int st = b / 1024, sb = b % 1024, swz = sb ^ (((sb >> 9) & 1) << 5); R = (st >> 1) * 16 + swz / 64; C = (st & 1) * 32 + (swz % 64) / 2; }
__host__ __device__ __forceinline__ int perm32(int rho) { const int n = rho >> 4, i = rho & 15; return 8 * (i >> 2) + 4 * n + (i & 3); }

struct Unit { int pm, pn; };
struct Gemm { const bf16_t* A; const bf16_t* Bt; int M, N, K; };

struct StaticOrder {
    int nM, nN, nwg, G, c;
    __host__ __device__ void init(int M, int N, int G_, int c_) { nM = M / BM; nN = N / BM; nwg = nM * nN; G = G_; c = c_; }
    __host__ __device__ bool next(int i, Unit& u) const {
        const long L = (long)i * G + c; if (L >= nwg) return false;
        int wgid = (int)L; { const int q = nwg / NXCD, r = nwg % NXCD, xcd = wgid % NXCD, off = wgid / NXCD; wgid = (xcd < r ? xcd * (q + 1) : r * (q + 1) + (xcd - r) * q) + off; }
        const int nig = WGM * nN, gid = wgid / nig, fm = gid * WGM, gsz = (nM - fm) < WGM ? (nM - fm) : WGM;
        u.pm = fm + ((wgid % nig) % gsz); u.pn = (wgid % nig) / gsz; return true;
    }
    __device__ __forceinline__ void a_ready(const Unit&) const {}
    __device__ __forceinline__ void done(const Unit&) const {}
};

struct LimitOrder {
    StaticOrder base; int maxr;
    __device__ bool next(int i, Unit& u) const { return i < maxr && base.next(i, u); }
    __device__ __forceinline__ void a_ready(const Unit&) const {}
    __device__ __forceinline__ void done(const Unit&) const {}
};

typedef float f32x2c_t __attribute__((ext_vector_type(2))); typedef __bf16 bf16x2c_t __attribute__((ext_vector_type(2)));
__device__ __forceinline__ unsigned cvt_pk_bf16(float lo, float hi) { const f32x2c_t v = {lo, hi}; const bf16x2c_t b = __builtin_convertvector(v, bf16x2c_t); return __builtin_bit_cast(unsigned, b); }
typedef float f32x2 __attribute__((ext_vector_type(2)));


constexpr float K_EPS = 1e-6f;
#define PG8_LD1(p) (*(p))
#define PG8_ST(T, p, v) (*(T*)(p) = (v))
__device__ __forceinline__ float silu_f(float v) { return v * __builtin_amdgcn_rcpf(1.f + __expf(-v)); }
__device__ __forceinline__ unsigned pk_f16(float lo, float hi) { const _Float16 a = (_Float16)lo, b = (_Float16)hi; return (unsigned)__builtin_bit_cast(unsigned short, a) | ((unsigned)__builtin_bit_cast(unsigned short, b) << 16); }

struct EpiWin {
    static constexpr bool PERM = true, AFTER_DRAIN = false, STAGED = true; static constexpr int NSTORE = 16;
    bf16_t* proj;
    const float* ssum;
    const float* shw;
    const float2* tab;
    const float* lbw;
    int layer;
    PG8_LAS unsigned char* stage;
    int pn_off;
    __device__ __forceinline__ void prefetch(const Unit& u, int ui, int wid, int lane) const {
        const float* src = wid < 4 ? ssum + u.pm * BM + 64 * wid + lane : shw + (size_t)(u.pm >> 3) * 3584 + (u.pn + pn_off) * BM + 64 * (wid - 4) + lane;
        __builtin_amdgcn_global_load_lds((const unsigned*)src, (PG8_LAS unsigned*)(stage + (ui & 1) * 2048 + wid * 256), 4, 0, 0);
    }
    __device__ __forceinline__ void operator()(const f32x4 (&acc)[2][2][4][2], const Unit& u, int wr, int wc, int fr_in, int fq_in, int ui, bool dry = false) const {
        int fr = fr_in, fq = fq_in; asm volatile("" : "+v"(fr), "+v"(fq));
        const int b = u.pm >> 3, pn = u.pn + pn_off;
        const int colb = pn * BM + wc * 32 + 8 * fq;
        const PG8_LAS float* SS = (const PG8_LAS float*)(stage + (ui & 1) * 2048); const PG8_LAS float* SV = SS + 256;
        const int type = pn == 0 ? 0 : pn == 1 ? 1 : (pn == 2 || pn == 3 || pn == 10 || pn == 11) ? 2 : (pn == 8 || pn == 9) ? 4 : 3;
        f32x4 sv[2][2];
#pragma unroll
        for (int bj = 0; bj < 2; ++bj)
#pragma unroll
            for (int n = 0; n < 2; ++n) sv[bj][n] = *(const PG8_LAS f32x4*)(SV + bj * HALF + wc * 32 + 8 * fq + 4 * n);
        float lb[2][8];
#pragma unroll
        for (int bj = 0; bj < 2; ++bj)
#pragma unroll
            for (int i = 0; i < 8; ++i) lb[bj][i] = 0.f;
        if (type == 4 && layer != 0) {
#pragma unroll
            for (int bj = 0; bj < 2; ++bj)
#pragma unroll
                for (int i = 0; i < 8; ++i) { const int c = colb + bj * HALF + i - 2048; lb[bj][i] = __builtin_amdgcn_rcpf(1.f + __expf(lbw[c] - lbw[512 + c])); }
        }
        if (type <= 1) {
            const float sc = type == 1 ? 0.125f : 1.f;
#pragma unroll
            for (int ap = 0; ap < 4; ++ap) { const int ai = ap >> 1, m0 = (ap & 1) * 2;
                f32x4 tb[2][2][2];
#pragma unroll
                for (int mm = 0; mm < 2; ++mm)
#pragma unroll
                    for (int bj = 0; bj < 2; ++bj) { const int pos = (u.pm * BM + ai * HALF + wr * 64 + (m0 + mm) * 16 + fr) & 2047, i0 = ((colb + bj * HALF) & 63) >> 1;
                        tb[mm][bj][0] = *(const f32x4*)(tab + pos * 32 + i0); tb[mm][bj][1] = *(const f32x4*)(tab + pos * 32 + i0 + 2); }
#pragma unroll
                for (int mm = 0; mm < 2; ++mm) { const int m = m0 + mm; const int row = u.pm * BM + ai * HALF + wr * 64 + m * 16 + fr;
                    const float rs = __builtin_amdgcn_rsqf(SS[ai * HALF + wr * 64 + m * 16 + fr] * (1.f / 1024.f) + K_EPS);
#pragma unroll
                    for (int bj = 0; bj < 2; ++bj) {
                        const f32x4 v0 = acc[ai][bj][m][0] * rs + sv[bj][0], v1 = acc[ai][bj][m][1] * rs + sv[bj][1];
                        const f32x4 t0 = tb[mm][bj][0], t1 = tb[mm][bj][1];
                        float o[8];
                        o[0] = (v0[0] * t0[0] - v0[1] * t0[1]) * sc; o[1] = (v0[0] * t0[1] + v0[1] * t0[0]) * sc;
                        o[2] = (v0[2] * t0[2] - v0[3] * t0[3]) * sc; o[3] = (v0[2] * t0[3] + v0[3] * t0[2]) * sc;
                        o[4] = (v1[0] * t1[0] - v1[1] * t1[1]) * sc; o[5] = (v1[0] * t1[1] + v1[1] * t1[0]) * sc;
                        o[6] = (v1[2] * t1[2] - v1[3] * t1[3]) * sc; o[7] = (v1[2] * t1[3] + v1[3] * t1[2]) * sc;
                        u32x4 w; w.x = cvt_pk_bf16(o[0], o[1]); w.y = cvt_pk_bf16(o[2], o[3]); w.z = cvt_pk_bf16(o[4], o[5]); w.w = cvt_pk_bf16(o[6], o[7]);
                        PG8_ST(u32x4, proj + (size_t)row * 3584 + colb + bj * HALF, w);
                    }
                }
                asm volatile("" ::: "memory");
            }
            return;
        }
#pragma unroll
        for (int ai = 0; ai < 2; ++ai)
#pragma unroll
            for (int m = 0; m < 4; ++m) {
                const int row = u.pm * BM + ai * HALF + wr * 64 + m * 16 + fr;
                const float rs = __builtin_amdgcn_rsqf(SS[ai * HALF + wr * 64 + m * 16 + fr] * (1.f / 1024.f) + K_EPS);
                const int pos = row & 2047;
#pragma unroll
                for (int bj = 0; bj < 2; ++bj) {
                    float v[8];
                    {   const f32x4 v0 = acc[ai][bj][m][0] * rs + sv[bj][0], v1 = acc[ai][bj][m][1] * rs + sv[bj][1];
                        v[0] = v0[0]; v[1] = v0[1]; v[2] = v0[2]; v[3] = v0[3]; v[4] = v1[0]; v[5] = v1[1]; v[6] = v1[2]; v[7] = v1[3]; }
                    u32x4 w;
                    if (type == 2) {
                        w.x = cvt_pk_bf16(v[0], v[1]); w.y = cvt_pk_bf16(v[2], v[3]); w.z = cvt_pk_bf16(v[4], v[5]); w.w = cvt_pk_bf16(v[6], v[7]);
                    } else if (type == 3) {
                        unsigned wv[4];
#pragma unroll
                        for (int q = 0; q < 4; ++q) { const f32x2 x = (f32x2){v[2 * q], v[2 * q + 1]}, xn = x * (-1.44269504089f);
                            f32x2 e; e.x = __builtin_amdgcn_exp2f(xn.x); e.y = __builtin_amdgcn_exp2f(xn.y);
                            const f32x2 d = e + 1.0f; f32x2 r; r.x = __builtin_amdgcn_rcpf(d.x); r.y = __builtin_amdgcn_rcpf(d.y);
                            const f32x2 o = x * r; wv[q] = cvt_pk_bf16(o.x, o.y); }
                        w.x = wv[0]; w.y = wv[1]; w.z = wv[2]; w.w = wv[3];
                    } else {
                        float g[8];
                        if (layer == 0) {
#pragma unroll
                            for (int i = 0; i < 8; ++i) g[i] = fminf(v[i], 0.f) - __logf(1.f + __expf(-fabsf(v[i])));
                        } else {
#pragma unroll
                            for (int i = 0; i < 8; ++i) { const float s = __builtin_amdgcn_rcpf(1.f + __expf(-v[i])); g[i] = __logf(lb[bj][i] + (1.f - lb[bj][i]) * s); }
                        }
                        w.x = pk_f16(g[0], g[1]); w.y = pk_f16(g[2], g[3]); w.z = pk_f16(g[4], g[5]); w.w = pk_f16(g[6], g[7]);
                    }
                    PG8_ST(u32x4, proj + (size_t)row * 3584 + colb + bj * HALF, w);
                }
            }
    }
};

__device__ __forceinline__ float f16lo(unsigned w) { return (float)__builtin_bit_cast(_Float16, (unsigned short)(w & 0xffffu)); }
__device__ __forceinline__ float f16hi(unsigned w) { return (float)__builtin_bit_cast(_Float16, (unsigned short)(w >> 16)); }
template <bool XF32> struct EpiRes {
    static constexpr bool PERM = true, AFTER_DRAIN = false, STAGED = false; static constexpr int NSTORE = 0;
    const void* xres; bf16_t* xout;
    const float* gvec;
    const float* nw; const float* scv;
    bf16_t* anext;
    float* ssum;
    __device__ __forceinline__ void operator()(const f32x4 (&acc)[2][2][4][2], const Unit& u, int wr, int wc, int fr_in, int fq_in) const {
        int fr = fr_in, fq = fq_in; asm volatile("" : "+v"(fr), "+v"(fq));
        const int b = u.pm >> 3;
        const int colb = u.pn * BM + wc * 32 + 8 * fq;
        f32x4 gv[2][2], wm[2][2];
#pragma unroll
        for (int bj = 0; bj < 2; ++bj)
#pragma unroll
            for (int n = 0; n < 2; ++n) {
                const int c = colb + bj * HALF + 4 * n;
                gv[bj][n] = *(const f32x4*)(gvec + (size_t)b * 6144 + c);
                wm[bj][n] = nw ? (*(const f32x4*)(nw + c)) * (1.f + *(const f32x4*)(scv + (size_t)b * 6144 + c)) : (f32x4){0.f, 0.f, 0.f, 0.f};
            }
#pragma unroll
        for (int ap = 0; ap < 4; ++ap) { const int ai = ap >> 1, m0 = (ap & 1) * 2;
            f32x4 pre[2][2][2];
#pragma unroll
            for (int mm = 0; mm < 2; ++mm)
#pragma unroll
                for (int bj = 0; bj < 2; ++bj) { const size_t off = (size_t)(u.pm * BM + ai * HALF + wr * 64 + (m0 + mm) * 16 + fr) * 1024 + colb + bj * HALF;
                    if constexpr (XF32) { pre[mm][bj][0] = *(const f32x4*)((const float*)xres + off); pre[mm][bj][1] = *(const f32x4*)((const float*)xres + off + 4); }
                    else { const u32x4 h = *(const u32x4*)((const bf16_t*)xres + off); pre[mm][bj][0] = __builtin_bit_cast(f32x4, h); } }
#pragma unroll
            for (int mm = 0; mm < 2; ++mm) { const int m = m0 + mm;
                const int row = u.pm * BM + ai * HALF + wr * 64 + m * 16 + fr;
                float ss = 0.f;
#pragma unroll
                for (int bj = 0; bj < 2; ++bj) {
                    const size_t off = (size_t)row * 1024 + colb + bj * HALF;
                    f32x4 r0, r1;
                    if constexpr (XF32) { r0 = pre[mm][bj][0]; r1 = pre[mm][bj][1]; }
                    else { const u32x4 h = __builtin_bit_cast(u32x4, pre[mm][bj][0]); r0 = (f32x4){f16lo(h.x), f16hi(h.x), f16lo(h.y), f16hi(h.y)}; r1 = (f32x4){f16lo(h.z), f16hi(h.z), f16lo(h.w), f16hi(h.w)}; }
                    const f32x4 x0 = r0 + gv[bj][0] * acc[ai][bj][m][0], x1 = r1 + gv[bj][1] * acc[ai][bj][m][1];
                    { u32x4 hx; hx.x = pk_f16(x0[0], x0[1]); hx.y = pk_f16(x0[2], x0[3]); hx.z = pk_f16(x1[0], x1[1]); hx.w = pk_f16(x1[2], x1[3]); PG8_ST(u32x4, xout + off, hx); }
                    ss += (x0[0] * x0[0] + x0[1] * x0[1]) + (x0[2] * x0[2] + x0[3] * x0[3]) + (x1[0] * x1[0] + x1[1] * x1[1]) + (x1[2] * x1[2] + x1[3] * x1[3]);
                    if (nw) { const f32x4 a0 = x0 * wm[bj][0], a1 = x1 * wm[bj][1]; u32x4 w; w.x = cvt_pk_bf16(a0[0], a0[1]); w.y = cvt_pk_bf16(a0[2], a0[3]); w.z = cvt_pk_bf16(a1[0], a1[1]); w.w = cvt_pk_bf16(a1[2], a1[3]);
                        PG8_ST(u32x4, anext + off, w); }
                }
                ss += __shfl_xor(ss, 16); ss += __shfl_xor(ss, 32);
                if (fq == 0) atomicAdd(ssum + row, ss);
            }
            asm volatile("" ::: "memory");
        }
    }
};

struct EpiFinal {
    static constexpr bool PERM = true, AFTER_DRAIN = true, STAGED = false; static constexpr int NSTORE = 0;
    const bf16_t* xres; float* out; const float* gvec; const float* fw; float* ssum; const XcdBarrier* bar;
    __device__ __forceinline__ void fused(f32x4 (&acc)[2][2][4][2], const Unit& u, int wr, int wc, int fr_in, int fq_in, PG8_LAS unsigned char* lds, int wid, int lane) const {
        int fr = fr_in, fq = fq_in; asm volatile("" : "+v"(fr), "+v"(fq));
        const int b = u.pm >> 3;
        const int colb = u.pn * BM + wc * 32 + 8 * fq;
        {
            f32x4 gv[2][2];
#pragma unroll
            for (int bj = 0; bj < 2; ++bj)
#pragma unroll
                for (int n = 0; n < 2; ++n) gv[bj][n] = *(const f32x4*)(gvec + (size_t)b * 6144 + colb + bj * HALF + 4 * n);
#pragma unroll
            for (int ai = 0; ai < 2; ++ai) {
                u32x4 pre[4][2];
#pragma unroll
                for (int m = 0; m < 4; ++m)
#pragma unroll
                    for (int bj = 0; bj < 2; ++bj) pre[m][bj] = *(const u32x4*)(xres + (size_t)(u.pm * BM + ai * HALF + wr * 64 + m * 16 + fr) * 1024 + colb + bj * HALF);
#pragma unroll
                for (int m = 0; m < 4; ++m) {
                    const int row = u.pm * BM + ai * HALF + wr * 64 + m * 16 + fr;
                    float ss = 0.f;
#pragma unroll
                    for (int bj = 0; bj < 2; ++bj) {
                        const u32x4 h = pre[m][bj];
                        const f32x4 r0 = (f32x4){f16lo(h.x), f16hi(h.x), f16lo(h.y), f16hi(h.y)}, r1 = (f32x4){f16lo(h.z), f16hi(h.z), f16lo(h.w), f16hi(h.w)};
                        const f32x4 x0 = r0 + gv[bj][0] * acc[ai][bj][m][0], x1 = r1 + gv[bj][1] * acc[ai][bj][m][1];
                        acc[ai][bj][m][0] = x0; acc[ai][bj][m][1] = x1;
                        ss += (x0[0] * x0[0] + x0[1] * x0[1]) + (x0[2] * x0[2] + x0[3] * x0[3]) + (x1[0] * x1[0] + x1[1] * x1[1]) + (x1[2] * x1[2] + x1[3] * x1[3]);
                    }
                    ss += __shfl_xor(ss, 16); ss += __shfl_xor(ss, 32);
                    if (fq == 0) atomicAdd(ssum + row, ss);
                }
                asm volatile("" ::: "memory");
            }
        }
        xcd_barrier(*bar);
        f32x4 fv[2][2];
#pragma unroll
        for (int bj = 0; bj < 2; ++bj)
#pragma unroll
            for (int n = 0; n < 2; ++n) fv[bj][n] = *(const f32x4*)(fw + colb + bj * HALF + 4 * n);
        float sq[2][4];
#pragma unroll
        for (int ai = 0; ai < 2; ++ai)
#pragma unroll
            for (int m = 0; m < 4; ++m) sq[ai][m] = __hip_atomic_load(ssum + u.pm * BM + ai * HALF + wr * 64 + m * 16 + fr, __ATOMIC_RELAXED, __HIP_MEMORY_SCOPE_AGENT);
#pragma unroll
        for (int ai = 0; ai < 2; ++ai)
#pragma unroll
            for (int m = 0; m < 4; ++m) {
                const int row = u.pm * BM + ai * HALF + wr * 64 + m * 16 + fr;
                const float rs = __builtin_amdgcn_rsqf(sq[ai][m] * (1.f / 1024.f) + K_EPS);
#pragma unroll
                for (int bj = 0; bj < 2; ++bj) {
                    const size_t off = (size_t)row * 1024 + colb + bj * HALF;
                    *(f32x4*)(out + off) = acc[ai][bj][m][0] * rs * fv[bj][0]; *(f32x4*)(out + off + 4) = acc[ai][bj][m][1] * rs * fv[bj][1];
                }
            }
    }
};

struct EpiFfn {
    static constexpr bool PERM = true, AFTER_DRAIN = false, STAGED = true; static constexpr int NSTORE = 8;
    bf16_t* act; const float* ssum; const float* shw;
    PG8_LAS unsigned char* stage;
    __device__ __forceinline__ void prefetch(const Unit& u, int ui, int wid, int lane) const {
        const float* src = wid < 4 ? ssum + u.pm * BM + 64 * wid + lane : shw + (size_t)(u.pm >> 3) * 5632 + u.pn * BM + 64 * (wid - 4) + lane;
        __builtin_amdgcn_global_load_lds((const unsigned*)src, (PG8_LAS unsigned*)(stage + (ui & 1) * 2048 + wid * 256), 4, 0, 0);
    }
    __device__ __forceinline__ void operator()(const f32x4 (&acc)[2][2][4][2], const Unit& u, int wr, int wc, int fr_in, int fq_in, int ui, bool dry = false) const {
        int fr = fr_in, fq = fq_in; asm volatile("" : "+v"(fr), "+v"(fq));
        const int cl = wc * 32 + 8 * fq;
        const PG8_LAS float* SS = (const PG8_LAS float*)(stage + (ui & 1) * 2048); const PG8_LAS float* SV = SS + 256;
        f32x2 sg[4], sgn[4], su[4];
#pragma unroll
        for (int n = 0; n < 2; ++n) { const f32x4 a = *(const PG8_LAS f32x4*)(SV + cl + 4 * n), c = *(const PG8_LAS f32x4*)(SV + HALF + cl + 4 * n);
            sg[2 * n] = (f32x2){a[0], a[1]}; sg[2 * n + 1] = (f32x2){a[2], a[3]}; su[2 * n] = (f32x2){c[0], c[1]}; su[2 * n + 1] = (f32x2){c[2], c[3]}; }
#pragma unroll
        for (int q = 0; q < 4; ++q) sgn[q] = sg[q] * (-1.44269504089f);
#pragma unroll
        for (int ai = 0; ai < 2; ++ai)
#pragma unroll
            for (int m = 0; m < 4; ++m) {
                const int row = u.pm * BM + ai * HALF + wr * 64 + m * 16 + fr;
                const float rs = __builtin_amdgcn_rsqf(SS[ai * HALF + wr * 64 + m * 16 + fr] * (1.f / 1024.f) + K_EPS), nrs = rs * (-1.44269504089f);
                unsigned wv[4];
#pragma unroll
                for (int q = 0; q < 4; ++q) {
                    const f32x4 ag4 = acc[ai][0][m][q >> 1], au4 = acc[ai][1][m][q >> 1];
                    const f32x2 ag = (q & 1) ? (f32x2){ag4[2], ag4[3]} : (f32x2){ag4[0], ag4[1]}, au = (q & 1) ? (f32x2){au4[2], au4[3]} : (f32x2){au4[0], au4[1]};
                    const f32x2 g = ag * rs + sg[q], gn = ag * nrs + sgn[q], uu = au * rs + su[q];
                    f32x2 e; e.x = __builtin_amdgcn_exp2f(gn.x); e.y = __builtin_amdgcn_exp2f(gn.y);
                    const f32x2 d = e + 1.0f;
                    f32x2 r; r.x = __builtin_amdgcn_rcpf(d.x); r.y = __builtin_amdgcn_rcpf(d.y);
                    const f32x2 o = (g * uu) * r;
                    wv[q] = cvt_pk_bf16(o.x, o.y);
                }
                u32x4 w; w.x = wv[0]; w.y = wv[1]; w.z = wv[2]; w.w = wv[3];
                PG8_ST(u32x4, act + (size_t)row * 2816 + u.pn * HALF + cl, w);
            }
    }
    __device__ __forceinline__ void half_epi(const f32x4 (&acc)[2][4][2], const Unit& u, int half, int wr, int wc, int fr_in, int fq_in, int ui) const {
        int fr = fr_in, fq = fq_in; asm volatile("" : "+v"(fr), "+v"(fq));
        const int cl = wc * 32 + 8 * fq;
        const PG8_LAS float* SS = (const PG8_LAS float*)(stage + (ui & 1) * 2048); const PG8_LAS float* SV = SS + 256;
        f32x2 sg[4], sgn[4], su[4];
#pragma unroll
        for (int n = 0; n < 2; ++n) { const f32x4 a = *(const PG8_LAS f32x4*)(SV + cl + 4 * n), c = *(const PG8_LAS f32x4*)(SV + HALF + cl + 4 * n);
            sg[2 * n] = (f32x2){a[0], a[1]}; sg[2 * n + 1] = (f32x2){a[2], a[3]}; su[2 * n] = (f32x2){c[0], c[1]}; su[2 * n + 1] = (f32x2){c[2], c[3]}; }
#pragma unroll
        for (int q = 0; q < 4; ++q) sgn[q] = sg[q] * (-1.44269504089f);
#pragma unroll
        for (int m = 0; m < 4; ++m) {
            const int rl = half * HALF + wr * 64 + m * 16 + fr, row = u.pm * BM + rl;
            const float rs = __builtin_amdgcn_rsqf(SS[rl] * (1.f / 1024.f) + K_EPS), nrs = rs * (-1.44269504089f);
            unsigned wv[4];
#pragma unroll
            for (int q = 0; q < 4; ++q) {
                const f32x4 ag4 = acc[0][m][q >> 1], au4 = acc[1][m][q >> 1];
                const f32x2 ag = (q & 1) ? (f32x2){ag4[2], ag4[3]} : (f32x2){ag4[0], ag4[1]}, au = (q & 1) ? (f32x2){au4[2], au4[3]} : (f32x2){au4[0], au4[1]};
                const f32x2 g = ag * rs + sg[q], gn = ag * nrs + sgn[q], uu = au * rs + su[q];
                f32x2 e; e.x = __builtin_amdgcn_exp2f(gn.x); e.y = __builtin_amdgcn_exp2f(gn.y);
                const f32x2 d = e + 1.0f;
                f32x2 r; r.x = __builtin_amdgcn_rcpf(d.x); r.y = __builtin_amdgcn_rcpf(d.y);
                const f32x2 o = (g * uu) * r;
                wv[q] = cvt_pk_bf16(o.x, o.y);
            }
            u32x4 w; w.x = wv[0]; w.y = wv[1]; w.z = wv[2]; w.w = wv[3];
            *(u32x4*)(act + (size_t)row * 2816 + u.pn * HALF + cl) = w;
        }
    }
};


template <class Epi, class Sched, bool ALIGN_EPI = false, bool SP2 = false>
__device__ __forceinline__ void gemm_phase(PG8_LAS unsigned char* lds, const Gemm g, const Sched& S, const Epi& E) {
    int tid_l = threadIdx.x; asm volatile("" : "+v"(tid_l));
    const int tid = tid_l, wid = __builtin_amdgcn_readfirstlane(tid >> 6), lane = tid & 63, wr = wid >> 2, wc = wid & 3, fr = lane & 15, fq = lane >> 4;
    const int K = g.K, nt = K / BK;
#define PG8_TW(t) (t)
    unsigned voffA[2], voffB[2];
#pragma unroll
    for (int i = 0; i < 2; ++i) { int R, C; stage_rc(tid * 16 + i * 8192, R, C); const int Rb = Epi::PERM ? ((R & ~31) + perm32(R & 31)) : R;
        voffA[i] = (unsigned)(R * K + C) * 2u; voffB[i] = (unsigned)(Rb * K + C) * 2u; }
    const size_t kstep = (size_t)(BK * 2);
    const size_t hstep = (size_t)HALF * K * 2;
    const size_t tstep = 2 * hstep;
    const unsigned ldsw = (unsigned)wid * 1024u;
    const int aoff = lds_byte(wr * 64 + fr, fq * 8), boff = lds_byte(wc * 32 + fr, fq * 8);
#define PG8_SA(b, h) (((b) * 2 + (h)) * HTB)
#define PG8_SB(b, h) ((4 + (b) * 2 + (h)) * HTB)
#define PG8_STAGE(bufoff, gbase, voff) do { _Pragma("unroll") for (int _i = 0; _i < 2; ++_i) \
        __builtin_amdgcn_global_load_lds((const unsigned*)((const char*)(gbase) + (voff)[_i]), (PG8_LAS unsigned*)(lds + (bufoff) + ldsw + _i * 8192), 16, 0, 0); } while (0)
#define PG8_LDA(dst, b, h) do { _Pragma("unroll") for (int m = 0; m < 4; ++m) _Pragma("unroll") for (int k = 0; k < 2; ++k) dst[m][k] = *(const PG8_LAS bf16x8*)(lds + PG8_SA(b, h) + aoff + m * 2048 + k * 1024); } while (0)
#define PG8_LDB(dst, b, h) do { _Pragma("unroll") for (int n = 0; n < 2; ++n) _Pragma("unroll") for (int k = 0; k < 2; ++k) dst[n][k] = *(const PG8_LAS bf16x8*)(lds + PG8_SB(b, h) + boff + n * 2048 + k * 1024); } while (0)
#define PG8_MMA(ai, bj, At, Bt) do { __builtin_amdgcn_s_setprio(1); _Pragma("unroll") for (int m = 0; m < 4; ++m) _Pragma("unroll") for (int n = 0; n < 2; ++n) _Pragma("unroll") for (int k = 0; k < 2; ++k) \
        acc[ai][bj][m][n] = __builtin_amdgcn_mfma_f32_16x16x32_bf16(Bt[n][k], At[m][k], acc[ai][bj][m][n], 0, 0, 0); __builtin_amdgcn_s_setprio(0); } while (0)
#define PG8_WAIT_V(n) asm volatile("s_waitcnt vmcnt(" #n ")" ::: "memory")
#define PG8_WAIT_L(n) asm volatile("s_waitcnt lgkmcnt(" #n ")" ::: "memory")
#define PG8_BAR __builtin_amdgcn_s_barrier()
#define PG8_SCHED __builtin_amdgcn_sched_barrier(0)
    Unit cur, nxt; int ui = 0;
    if (!S.next(0, cur)) return;
    f32x4 acc[2][2][4][2];
#pragma unroll
    for (int a = 0; a < 2; ++a)
#pragma unroll
        for (int b = 0; b < 2; ++b)
#pragma unroll
            for (int m = 0; m < 4; ++m)
#pragma unroll
                for (int n = 0; n < 2; ++n) acc[a][b][m][n] = (f32x4){0.f, 0.f, 0.f, 0.f};
    bf16x8 At[4][2], B0[2][2], B1[2][2];
    const char* cA = (const char*)g.A + (size_t)cur.pm * tstep; const char* cB = (const char*)g.Bt + (size_t)cur.pn * tstep;
    S.a_ready(cur);
    if constexpr (SP2) {
        PG8_STAGE(PG8_SB(0, 0), cB, voffB); PG8_STAGE(PG8_SB(0, 1), cB + hstep, voffB); PG8_STAGE(PG8_SA(0, 0), cA, voffA); PG8_STAGE(PG8_SA(0, 1), cA + hstep, voffA);
        if (wr == 1) PG8_BAR;
        PG8_WAIT_V(2); PG8_BAR;
        PG8_STAGE(PG8_SB(1, 0), cB + kstep, voffB); PG8_STAGE(PG8_SA(1, 0), cA + kstep, voffA); PG8_STAGE(PG8_SB(1, 1), cB + hstep + kstep, voffB);
        PG8_WAIT_V(6); PG8_BAR;
    } else {
        PG8_STAGE(PG8_SB(0, 0), cB, voffB); PG8_STAGE(PG8_SA(0, 0), cA, voffA); PG8_STAGE(PG8_SB(0, 1), cB + hstep, voffB); PG8_STAGE(PG8_SA(0, 1), cA + hstep, voffA);
        if (wr == 1) PG8_BAR;
        PG8_WAIT_V(4); PG8_BAR;
        PG8_STAGE(PG8_SB(1, 0), cB + kstep, voffB); PG8_STAGE(PG8_SA(1, 0), cA + kstep, voffA); PG8_STAGE(PG8_SB(1, 1), cB + hstep + kstep, voffB);
        PG8_WAIT_V(6); PG8_BAR;
    }
    for (;;) {
        const bool has_next = S.next(ui + 1, nxt);
        const char* nA = has_next ? (const char*)g.A + (size_t)nxt.pm * tstep : cA; const char* nB = has_next ? (const char*)g.Bt + (size_t)nxt.pn * tstep : cB;
        if constexpr (Epi::STAGED) E.prefetch(cur, ui, wid, lane);
        for (int t = 0; t < nt; t += 2) {
            const bool last = (t == nt - 2);
            const char* a1 = cA + (size_t)PG8_TW(t + 1) * kstep;
            const char* a2 = last ? nA : cA + (size_t)PG8_TW(t + 2) * kstep; const char* b2 = last ? nB : cB + (size_t)PG8_TW(t + 2) * kstep;
            const char* a3 = a2 + kstep; const char* b3 = b2 + kstep;
            if (last && has_next) S.a_ready(nxt);
            if constexpr (SP2) {
            PG8_LDB(B0, 0, 0); PG8_LDB(B1, 0, 1); PG8_SCHED; PG8_LDA(At, 0, 0); PG8_STAGE(PG8_SA(1, 1), a1 + hstep, voffA);
            PG8_WAIT_V(8); PG8_WAIT_L(0); PG8_BAR; PG8_MMA(0, 0, At, B0); PG8_MMA(0, 1, At, B1); PG8_BAR; PG8_SCHED;
            PG8_LDA(At, 0, 1); PG8_STAGE(PG8_SB(0, 0), b2, voffB); PG8_STAGE(PG8_SB(0, 1), b2 + hstep, voffB); PG8_STAGE(PG8_SA(0, 0), a2, voffA);
            PG8_WAIT_V(8); PG8_WAIT_L(0); PG8_BAR; PG8_MMA(1, 0, At, B0); PG8_MMA(1, 1, At, B1); PG8_BAR; PG8_SCHED;
            PG8_LDB(B0, 1, 0); PG8_LDB(B1, 1, 1); PG8_SCHED; PG8_LDA(At, 1, 0); PG8_STAGE(PG8_SA(0, 1), a2 + hstep, voffA);
            PG8_WAIT_V(8); PG8_WAIT_L(0); PG8_BAR; PG8_MMA(0, 0, At, B0); PG8_MMA(0, 1, At, B1); PG8_BAR; PG8_SCHED;
            PG8_LDA(At, 1, 1); PG8_STAGE(PG8_SB(1, 0), b3, voffB); PG8_STAGE(PG8_SB(1, 1), b3 + hstep, voffB); PG8_STAGE(PG8_SA(1, 0), a3, voffA);
            PG8_WAIT_V(8); PG8_WAIT_L(0); PG8_BAR; PG8_MMA(1, 0, At, B0); PG8_MMA(1, 1, At, B1); PG8_BAR; PG8_SCHED;
            } else {
            PG8_LDB(B0, 0, 0); PG8_SCHED; PG8_LDA(At, 0, 0); PG8_STAGE(PG8_SA(1, 1), a1 + hstep, voffA);
            PG8_WAIT_L(8); PG8_BAR; PG8_WAIT_L(0); PG8_MMA(0, 0, At, B0); PG8_BAR; PG8_SCHED;
            PG8_LDB(B1, 0, 1); PG8_STAGE(PG8_SB(0, 0), b2, voffB);
            PG8_BAR; PG8_WAIT_L(0); PG8_MMA(0, 1, At, B1); PG8_BAR;
            PG8_LDA(At, 0, 1); PG8_STAGE(PG8_SA(0, 0), a2, voffA);
            PG8_BAR; PG8_WAIT_L(0); PG8_MMA(1, 0, At, B0); PG8_BAR; PG8_SCHED;
            PG8_STAGE(PG8_SB(0, 1), b2 + hstep, voffB);
            PG8_WAIT_V(6); PG8_BAR; PG8_MMA(1, 1, At, B1); PG8_BAR;
            PG8_LDB(B0, 1, 0); PG8_SCHED; PG8_LDA(At, 1, 0); PG8_STAGE(PG8_SA(0, 1), a2 + hstep, voffA);
            PG8_WAIT_L(8); PG8_BAR; PG8_WAIT_L(0); PG8_MMA(0, 0, At, B0); PG8_BAR; PG8_SCHED;
            PG8_LDB(B1, 1, 1); PG8_STAGE(PG8_SB(1, 0), b3, voffB);
            PG8_BAR; PG8_WAIT_L(0); PG8_MMA(0, 1, At, B1); PG8_BAR;
            PG8_LDA(At, 1, 1); PG8_STAGE(PG8_SA(1, 0), a3, voffA);
            PG8_BAR; PG8_WAIT_L(0); PG8_MMA(1, 0, At, B0); PG8_BAR; PG8_SCHED;
            PG8_STAGE(PG8_SB(1, 1), b3 + hstep, voffB);
            PG8_WAIT_V(6); PG8_BAR; PG8_MMA(1, 1, At, B1); PG8_BAR;
            }
        }
        if constexpr (ALIGN_EPI) { if (wr == 0) PG8_BAR; }
        if constexpr (!Epi::AFTER_DRAIN) { if constexpr (Epi::STAGED) E(acc, cur, wr, wc, fr, fq, ui); else E(acc, cur, wr, wc, fr, fq); S.done(cur); }
        if (!has_next) break;
#pragma unroll
        for (int a = 0; a < 2; ++a)
#pragma unroll
            for (int b = 0; b < 2; ++b)
#pragma unroll
                for (int m = 0; m < 4; ++m)
#pragma unroll
                    for (int n = 0; n < 2; ++n) acc[a][b][m][n] = (f32x4){0.f, 0.f, 0.f, 0.f};
        cur = nxt; cA = nA; cB = nB; ++ui;
        if constexpr (ALIGN_EPI) { if (wr == 1) PG8_BAR; }
    }
    PG8_WAIT_V(0);
    if constexpr (!ALIGN_EPI) { if (wr == 0) PG8_BAR; }
    PG8_BAR;
    if constexpr (Epi::AFTER_DRAIN) { E.fused(acc, cur, wr, wc, fr, fq, lds, wid, lane); S.done(cur); }
#undef PG8_SA
#undef PG8_SB
#undef PG8_STAGE
#undef PG8_LDA
#undef PG8_LDB
#undef PG8_MMA
#undef PG8_WAIT_V
#undef PG8_WAIT_L
#undef PG8_BAR
#undef PG8_SCHED
}
template <class Epi>
__device__ __forceinline__ void gemm_half_unit(PG8_LAS unsigned char* lds, const Gemm g, const Unit u, const int half, const Epi& E, const int ui) {
    int tid_l = threadIdx.x; asm volatile("" : "+v"(tid_l));
    const int tid = tid_l, wid = __builtin_amdgcn_readfirstlane(tid >> 6), lane = tid & 63, wr = wid >> 2, wc = wid & 3, fr = lane & 15, fq = lane >> 4;
    const int K = g.K, nt = K / BK;
    unsigned voffA[2], voffB[2];
#pragma unroll
    for (int i = 0; i < 2; ++i) { int R, C; stage_rc(tid * 16 + i * 8192, R, C); const int Rb = Epi::PERM ? ((R & ~31) + perm32(R & 31)) : R;
        voffA[i] = (unsigned)(R * K + C) * 2u; voffB[i] = (unsigned)(Rb * K + C) * 2u; }
    const size_t kstep = (size_t)(BK * 2), hstep = (size_t)HALF * K * 2, tstep = 2 * hstep;
    const unsigned ldsw = (unsigned)wid * 1024u;
    const int aoff = lds_byte(wr * 64 + fr, fq * 8), boff = lds_byte(wc * 32 + fr, fq * 8);
#define PGH_A(q) ((q) * 3 * HTB)
#define PGH_B(q, h) ((q) * 3 * HTB + (1 + (h)) * HTB)
#define PGH_STAGE(bufoff, gbase, voff) do { _Pragma("unroll") for (int _i = 0; _i < 2; ++_i) \
        __builtin_amdgcn_global_load_lds((const unsigned*)((const char*)(gbase) + (voff)[_i]), (PG8_LAS unsigned*)(lds + (bufoff) + ldsw + _i * 8192), 16, 0, 0); } while (0)
#define PGH_TILE(q, kt) do { PGH_STAGE(PGH_B(q, 0), cB + (size_t)(kt) * kstep, voffB); PGH_STAGE(PGH_B(q, 1), cB + hstep + (size_t)(kt) * kstep, voffB); PGH_STAGE(PGH_A(q), cA + (size_t)(kt) * kstep, voffA); } while (0)
#define PGH_LDA(dst, off) do { _Pragma("unroll") for (int m = 0; m < 4; ++m) _Pragma("unroll") for (int k = 0; k < 2; ++k) dst[m][k] = *(const PG8_LAS bf16x8*)(lds + (off) + aoff + m * 2048 + k * 1024); } while (0)
#define PGH_LDB(dst, off) do { _Pragma("unroll") for (int n = 0; n < 2; ++n) _Pragma("unroll") for (int k = 0; k < 2; ++k) dst[n][k] = *(const PG8_LAS bf16x8*)(lds + (off) + boff + n * 2048 + k * 1024); } while (0)
#define PGH_MMA(bj, At, Bt) do { __builtin_amdgcn_s_setprio(1); _Pragma("unroll") for (int m = 0; m < 4; ++m) _Pragma("unroll") for (int n = 0; n < 2; ++n) _Pragma("unroll") for (int k = 0; k < 2; ++k) \
        acc[bj][m][n] = __builtin_amdgcn_mfma_f32_16x16x32_bf16(Bt[n][k], At[m][k], acc[bj][m][n], 0, 0, 0); __builtin_amdgcn_s_setprio(0); } while (0)
    f32x4 acc[2][4][2];
#pragma unroll
    for (int b = 0; b < 2; ++b)
#pragma unroll
        for (int m = 0; m < 4; ++m)
#pragma unroll
            for (int n = 0; n < 2; ++n) acc[b][m][n] = (f32x4){0.f, 0.f, 0.f, 0.f};
    bf16x8 At[4][2], B0[2][2], B1[2][2];
    const char* cA = (const char*)g.A + (size_t)u.pm * tstep + (size_t)half * hstep; const char* cB = (const char*)g.Bt + (size_t)u.pn * tstep;
    E.prefetch(u, ui, wid, lane);
    PGH_TILE(0, 0); PGH_TILE(1, 1);
    if (wr == 1) __builtin_amdgcn_s_barrier();
    asm volatile("s_waitcnt vmcnt(6)" ::: "memory");
    __builtin_amdgcn_s_barrier(); __builtin_amdgcn_s_barrier();
    for (int t = 0; t < nt; ++t) {
        const int q = t % 3, q2 = (t + 2) % 3;
        PGH_LDB(B0, PGH_B(q, 0)); PGH_LDB(B1, PGH_B(q, 1)); __builtin_amdgcn_sched_barrier(0); PGH_LDA(At, PGH_A(q));
        if (t + 2 < nt) { PGH_TILE(q2, t + 2); asm volatile("s_waitcnt vmcnt(6)" ::: "memory"); } else { asm volatile("s_waitcnt vmcnt(0)" ::: "memory"); }
        asm volatile("s_waitcnt lgkmcnt(0)" ::: "memory"); __builtin_amdgcn_s_barrier();
        PGH_MMA(0, At, B0); PGH_MMA(1, At, B1);
        __builtin_amdgcn_s_barrier(); __builtin_amdgcn_sched_barrier(0);
    }
    if (wr == 0) __builtin_amdgcn_s_barrier();
    E.half_epi(acc, u, half, wr, wc, fr, fq, ui);
#undef PGH_A
#undef PGH_B
#undef PGH_STAGE
#undef PGH_TILE
#undef PGH_LDA
#undef PGH_LDB
#undef PGH_MMA
}
}


constexpr int NWAVES = 8;
constexpr int D = 1024, BATCH = 8, SEQ = 2048, DEPTH = 2, M = BATCH * SEQ, INW = 3584, DFF = 2816, NMOD = 6, NCH = SEQ / 64;
constexpr float EPS = 1e-6f;
#ifndef CTL_MEMSET_MIB
#define CTL_MEMSET_MIB 1
#endif
constexpr size_t MiB = 1u << 20, KiB = 1u << 10;
constexpr size_t WS_CTL = 0, CTL_ZERO_BYTES = CTL_MEMSET_MIB * MiB;
constexpr size_t CTL_REGION = CTL_ZERO_BYTES;
constexpr size_t WS_MOD = 64 * KiB;
constexpr size_t WS_SSUM = 448 * KiB;
constexpr size_t WS_TAB = 1 * MiB;
constexpr size_t WS_SHW1 = WS_TAB + 512 * KiB;
constexpr size_t WS_SHW2 = WS_SHW1 + 2 * 8 * 3584 * 4;
constexpr size_t WS_BL = 3 * MiB;
constexpr size_t WS_W = 4 * MiB;
constexpr size_t W_IN_OFF = 0, W_OUT_OFF = (size_t)INW * D * 2, W_GU_OFF = W_OUT_OFF + (size_t)D * D * 2, W_DN_OFF = W_GU_OFF + (size_t)2 * DFF * D * 2, W_LAYER = W_DN_OFF + (size_t)DFF * D * 2;
constexpr size_t WS_A = 56 * MiB;
constexpr size_t WS_PROJ = 88 * MiB;
constexpr size_t WS_URET = 200 * MiB;
constexpr size_t WS_UHG = 216 * MiB;
constexpr size_t WS_A2 = 200 * MiB;
constexpr size_t WS_END = 248 * MiB;
static_assert(WS_SHW2 + 2 * 8 * 5632 * 4 <= WS_BL && WS_W + 2 * W_LAYER <= WS_A && WS_A + (size_t)M * D * 2 <= WS_PROJ && WS_PROJ + (size_t)M * INW * 2 <= WS_URET, "d_ws map");
static_assert(WS_MOD + 2 * 8 * 6144 * 4 <= WS_SSUM && WS_SSUM + 5 * M * 4 <= CTL_REGION, "ctl map");
constexpr int CW_BAR = 4096;
static_assert((CW_BAR + 3456) * 4 <= CTL_ZERO_BYTES, "barrier words inside the per-call memset");
constexpr int RING_BYTES = 131072;
constexpr int MISC_BASE = 147456;
constexpr int LDS_BYTES = 163840;
constexpr int LDSCTL_OFF = MISC_BASE, MISC_OFF = LDSCTL_OFF + 320;
constexpr int STAGE_OFF = MISC_BASE + 4096;

#define GAS __attribute__((address_space(1)))
#define LAS __attribute__((address_space(3)))
typedef unsigned short bf16;
typedef unsigned v4u __attribute__((ext_vector_type(4)));
typedef unsigned v2u __attribute__((ext_vector_type(2)));
typedef float f32x4 __attribute__((ext_vector_type(4)));
typedef short bf16x8 __attribute__((ext_vector_type(8)));
typedef GAS unsigned gu32;
#define RLX_AGENT __ATOMIC_RELAXED, __HIP_MEMORY_SCOPE_AGENT
#define LDS_WAIT() asm volatile("s_waitcnt lgkmcnt(0)" ::: "memory")
#define LD_LAST(p) (*(p))
#define LD_ONCE(p) __builtin_nontemporal_load(p)
typedef float f32x2_t __attribute__((ext_vector_type(2)));
typedef __bf16 bf16x2_t __attribute__((ext_vector_type(2)));
__device__ __forceinline__ unsigned pk2(float lo, float hi) { const f32x2_t v = {lo, hi}; const bf16x2_t b = __builtin_convertvector(v, bf16x2_t); return __builtin_bit_cast(unsigned, b); }
__device__ __forceinline__ unsigned f2bf(float f) { return (unsigned)__builtin_bit_cast(unsigned short, (__bf16)f); }
__device__ __forceinline__ float bf2f(unsigned short u) { return __builtin_bit_cast(float, (unsigned)u << 16); }
__device__ __forceinline__ float h2f(unsigned short u) { return (float)__builtin_bit_cast(_Float16, u); }
__device__ __forceinline__ float dpp_f(float v, int ctrl_sel) {
    const int x = __builtin_bit_cast(int, v);
    int r;
    if (ctrl_sel == 0) r = __builtin_amdgcn_mov_dpp(x, 0xB1, 0xF, 0xF, true);
    else if (ctrl_sel == 1) r = __builtin_amdgcn_mov_dpp(x, 0x4E, 0xF, 0xF, true);
    else if (ctrl_sel == 2) r = __builtin_amdgcn_mov_dpp(x, 0x141, 0xF, 0xF, true);
    else r = __builtin_amdgcn_mov_dpp(x, 0x140, 0xF, 0xF, true);
    return __builtin_bit_cast(float, r);
}
__device__ __forceinline__ float row16_sum(float v) { v += dpp_f(v, 0); v += dpp_f(v, 1); v += dpp_f(v, 2); v += dpp_f(v, 3); return v; }
__device__ __forceinline__ float wave_sum(float v) {
    v = row16_sum(v);
    const int x = __builtin_bit_cast(int, v);
    return __builtin_bit_cast(float, __builtin_amdgcn_readlane(x, 0)) + __builtin_bit_cast(float, __builtin_amdgcn_readlane(x, 16))
         + __builtin_bit_cast(float, __builtin_amdgcn_readlane(x, 32)) + __builtin_bit_cast(float, __builtin_amdgcn_readlane(x, 48));
}


__device__ __forceinline__ f32x4 mfma16(bf16x8 a, bf16x8 b, f32x4 c) { return __builtin_amdgcn_mfma_f32_16x16x32_bf16(a, b, c, 0, 0, 0); }

struct TrItem { const float* W; bf16* WT; int K, N, item, mode; };
__device__ __forceinline__ void transpose_load(f32x4 (&v)[8], const TrItem& t, int lane) {
    const int nblk = t.N / 32, kb = t.item / nblk, nb = t.item % nblk, k0 = 64 * kb, n0 = 32 * nb;
    const float* src = t.W + (size_t)(k0 + (lane >> 3)) * t.N + n0 + (lane & 7) * 4;
#pragma unroll
    for (int i = 0; i < 8; ++i) v[i] = LD_ONCE((const f32x4*)(src + (size_t)(8 * i) * t.N));
}
__device__ __forceinline__ void transpose_store(const f32x4 (&v)[8], const TrItem& t, LAS float* scr, int lane) {
    const int nblk = t.N / 32, kb = t.item / nblk, nb = t.item % nblk, k0 = 64 * kb, n0 = 32 * nb;
    const int drow = t.mode == 0 ? n0 : (256 * (n0 >> 7) + (n0 & 127) + (t.mode == 2 ? 128 : 0));
#pragma unroll
    for (int i = 0; i < 8; ++i) { LAS float* p = scr + (8 * i + (lane >> 3)) * 33 + (lane & 7) * 4; p[0] = v[i][0]; p[1] = v[i][1]; p[2] = v[i][2]; p[3] = v[i][3]; }
    LDS_WAIT(); asm volatile("" ::: "memory");
    const int c = lane & 7;
#pragma unroll
    for (int j = 0; j < 4; ++j) { const int n = (lane >> 3) + 8 * j; const LAS float* s = scr + (8 * c) * 33 + n;
        v4u o; o.x = pk2(s[0 * 33], s[1 * 33]); o.y = pk2(s[2 * 33], s[3 * 33]); o.z = pk2(s[4 * 33], s[5 * 33]); o.w = pk2(s[6 * 33], s[7 * 33]);
        *(GAS v4u*)(t.WT + (size_t)(drow + n) * t.K + k0 + 8 * c) = o; }
    LDS_WAIT(); asm volatile("" ::: "memory");
}

typedef short v4i16_t __attribute__((ext_vector_type(4)));
__device__ __forceinline__ unsigned off_b(unsigned row, unsigned ch) { return 256u * row + 16u * (ch ^ (((row & 3) << 2) | ((row >> 2) & 3))); }
__device__ __forceinline__ unsigned tr_addr16(unsigned lane, unsigned c, unsigned ks, unsigned t) {
    const unsigned g = lane >> 4, q = (lane & 15) >> 2, p = lane & 3;
    return off_b(32 * ks + 8 * g + 4 * t + q, 2 * c + (p >> 1)) + 8 * (p & 1);
}
__device__ __forceinline__ bf16x8 tr_frag(LAS unsigned char* img, unsigned lane, unsigned c, unsigned ks) {
    const v4i16_t a = __builtin_amdgcn_ds_read_tr16_b64_v4i16((LAS v4i16_t*)(img + tr_addr16(lane, c, ks, 0)));
    const v4i16_t b = __builtin_amdgcn_ds_read_tr16_b64_v4i16((LAS v4i16_t*)(img + tr_addr16(lane, c, ks, 1)));
    return (bf16x8){a[0], a[1], a[2], a[3], b[0], b[1], b[2], b[3]};
}

template <int DK> struct StRegs { v4u k[DK / 64]; v4u v[2]; };
template <int DK, bool RET>
__device__ __forceinline__ void mix_state_load(StRegs<DK>& R, const bf16* proj, int it, int tid) {
    const int b = it >> 7, h = (it >> 5) & 3, c = it & 31;
    const size_t r0 = (size_t)b * 2048 + c * 64;
#pragma unroll
    for (int k = 0; k < 2; ++k) { const bf16* base = proj + (r0 + (tid >> 4) + 32 * k) * 3584 + (tid & 15) * 8 + h * 128;
        R.v[k] = *(const v4u*)(base + (RET ? 512 : 2560));
        if (!RET) R.k[k] = *(const v4u*)(base + 2048); }
    if (RET) R.k[0] = *(const v4u*)(proj + (r0 + (tid >> 3)) * 3584 + 256 + h * 64 + (tid & 7) * 8);
}
template <int DK, bool RET>
__device__ __forceinline__ void mix_state_item(LAS unsigned char* lds, const StRegs<DK>& R, bf16* ST, float* BL, int it, int tid) {
    constexpr int NSEG = 512 / DK, TS = 64 / NSEG;
    const int lane = tid & 63, wave = tid >> 6, d = tid % DK, seg = tid / DK, fr = lane & 15, fq = lane >> 4;
    const int h = (it >> 5) & 3;
    LAS unsigned char* VI = lds; LAS unsigned char* RAW = lds + 16384; LAS unsigned char* KI = lds + 32768; LAS float* TOT = (LAS float*)(lds + 49152);
#pragma unroll
    for (int k = 0; k < 2; ++k) { *(LAS v4u*)(VI + off_b((tid >> 4) + 32 * k, tid & 15)) = R.v[k];
        if (!RET) *(LAS v4u*)(RAW + ((tid >> 4) + 32 * k) * 256 + (tid & 15) * 16) = R.k[k]; }
    if (RET) *(LAS v4u*)(RAW + (tid >> 3) * 128 + (tid & 7) * 16) = R.k[0];
    __syncthreads();
    float kp[TS];
    if (RET) {
        const float lg2 = __log2f(1.f - exp2f(-5.f - (float)h)), gam = 1.f - exp2f(-5.f - (float)h);
        float f = __builtin_amdgcn_exp2f((float)(63 - seg * TS - (TS - 1)) * lg2);
#pragma unroll
        for (int i = TS - 1; i >= 0; --i) { const int t = seg * TS + i; kp[i] = bf2f(*(const LAS unsigned short*)(RAW + t * 128 + d * 2)) * f; f *= gam; }
    } else {
        float g[TS], bs[TS]; float run = 0.f;
#pragma unroll
        for (int i = 0; i < TS; ++i) { g[i] = h2f(*(const LAS unsigned short*)(RAW + (seg * TS + i) * 256 + d * 2)) * 1.44269504089f; run += g[i]; bs[i] = run; }
        TOT[seg * DK + d] = run;
        __syncthreads();
        float pre = 0.f, bl = 0.f;
#pragma unroll
        for (int s2 = 0; s2 < NSEG; ++s2) { const float t = TOT[s2 * DK + d]; bl += t; if (s2 < seg) pre += t; }
#pragma unroll
        for (int i = 0; i < TS; ++i) { const float bb = pre + bs[i]; kp[i] = (1.f - __builtin_amdgcn_exp2f(g[i])) * __builtin_amdgcn_exp2f(bl - bb); }
        if (seg == 0) BL[(size_t)it * 128 + d] = bl;
    }
#pragma unroll
    for (int i = 0; i < TS; i += 2) { const unsigned w = pk2(kp[i], kp[i + 1]);
        *(LAS unsigned short*)(KI + off_b(seg * TS + i, d >> 3) + (d & 7) * 2) = (unsigned short)w; *(LAS unsigned short*)(KI + off_b(seg * TS + i + 1, d >> 3) + (d & 7) * 2) = (unsigned short)(w >> 16); }
    __syncthreads();
    {
        bf16x8 bfr[2];
#pragma unroll
        for (int ks = 0; ks < 2; ++ks) bfr[ks] = tr_frag(VI, lane, wave, ks);
        bf16* dst = ST + (size_t)it * (128 * DK) + (size_t)(16 * wave + fr) * DK + 4 * fq;
#pragma unroll
        for (int dt = 0; dt < DK / 16; ++dt) {
            f32x4 acc = (f32x4){0.f, 0.f, 0.f, 0.f};
#pragma unroll
            for (int ks = 0; ks < 2; ++ks) acc = mfma16(tr_frag(KI, lane, dt, ks), bfr[ks], acc);
            v2u w; w.x = pk2(acc[0], acc[1]); w.y = pk2(acc[2], acc[3]);
            *(v2u*)(dst + 16 * dt) = w;
        }
    }
    __syncthreads();
}

template <int DK> struct OutRegs { v4u q[DK / 64]; v4u g[DK / 64]; v4u v[2]; v4u gate[2]; bf16x8 s[DK / 32]; float nwv; };
template <int DK, bool RET>
__device__ __forceinline__ void mix_out_load(OutRegs<DK>& R, const bf16* proj, const bf16* ST, const float* nw, int it, int tid) {
    const int lane = tid & 63, wave = tid >> 6, fr = lane & 15, fq = lane >> 4;
    const int b = it >> 7, h = (it >> 5) & 3, c = it & 31;
    const size_t r0 = (size_t)b * 2048 + c * 64;
#pragma unroll
    for (int k = 0; k < 2; ++k) { const bf16* base = proj + (r0 + (tid >> 4) + 32 * k) * 3584 + (tid & 15) * 8 + h * 128;
        R.v[k] = LD_LAST((const v4u*)(base + (RET ? 512 : 2560))); R.gate[k] = LD_LAST((const v4u*)(base + (RET ? 1024 : 3072)));
        if (!RET) { R.q[k] = LD_LAST((const v4u*)(base + 1536)); R.g[k] = LD_LAST((const v4u*)(base + 2048)); } }
    if (RET) { const bf16* base = proj + (r0 + (tid >> 3)) * 3584 + h * 64 + (tid & 7) * 8; R.q[0] = LD_LAST((const v4u*)base); R.g[0] = LD_LAST((const v4u*)(base + 256)); }
#pragma unroll
    for (int kd = 0; kd < DK / 32; ++kd) R.s[kd] = *(const bf16x8*)(ST + (size_t)it * (128 * DK) + (size_t)(16 * wave + fr) * DK + 32 * kd + 8 * fq);
    R.nwv = nw[h * 128 + 16 * wave + fr];
}
template <int DK, bool RET>
__device__ __forceinline__ void mix_out_park(LAS unsigned char* lds, const OutRegs<DK>& R, int tid) {
    LAS unsigned char* VI = lds; LAS unsigned char* RAWQ = lds + 16384; LAS unsigned char* RAWG = lds + 32768; LAS float* RED = (LAS float*)(lds + 128000);
#pragma unroll
    for (int k = 0; k < 2; ++k) { *(LAS v4u*)(VI + off_b((tid >> 4) + 32 * k, tid & 15)) = R.v[k];
        if (!RET) { *(LAS v4u*)(RAWQ + ((tid >> 4) + 32 * k) * 256 + (tid & 15) * 16) = R.q[k]; *(LAS v4u*)(RAWG + ((tid >> 4) + 32 * k) * 256 + (tid & 15) * 16) = R.g[k]; } }
    if (RET) { *(LAS v4u*)(RAWQ + (tid >> 3) * 128 + (tid & 7) * 16) = R.q[0]; *(LAS v4u*)(RAWG + (tid >> 3) * 128 + (tid & 7) * 16) = R.g[0]; }
    if (tid < 64) RED[tid] = 0.f;
    __syncthreads();
}
template <int DK, bool RET>
__device__ __forceinline__ void mix_out_item(LAS unsigned char* lds, const v4u (&gate)[2], const bf16x8 (&sfr)[DK / 32], float nwv, bf16* O, int it, int tid) {
    constexpr int NSEG = 512 / DK, TS = 64 / NSEG, PITCH = DK * 2 + 16, KD = DK / 32, RP = DK * 2;
    const int lane = tid & 63, wave = tid >> 6, d = tid % DK, seg = tid / DK, fr = lane & 15, fq = lane >> 4;
    const int b = it >> 7, h = (it >> 5) & 3, c = it & 31;
    const size_t r0 = (size_t)b * 2048 + c * 64;
    LAS unsigned char* VI = lds; LAS unsigned char* RAWQ = lds + 16384; LAS unsigned char* RAWG = lds + 32768;
    LAS unsigned char* QA = lds + 49152; LAS unsigned char* KC = lds + 66560; LAS unsigned char* QB = lds + 83968; LAS unsigned char* P = lds + 101376;
    LAS float* TOT = (LAS float*)(lds + 101376);
    LAS unsigned char* OT = lds + 110592; LAS float* RED = (LAS float*)(lds + 128000);
    {
    float qa[TS], kc[TS], qb[TS];
    if (RET) {
        const float lg2 = __log2f(1.f - exp2f(-5.f - (float)h)), gam = 1.f - exp2f(-5.f - (float)h), eref = __builtin_amdgcn_exp2f(32.f * lg2);
        const int tb = seg * TS;
        float fa = __builtin_amdgcn_exp2f((float)(tb - 31) * lg2), fk = __builtin_amdgcn_exp2f((float)(31 - tb - (TS - 1)) * lg2);
#pragma unroll
        for (int i = 0; i < TS; ++i) { const float q = bf2f(*(const LAS unsigned short*)(RAWQ + (tb + i) * RP + d * 2)); qa[i] = q * fa; qb[i] = qa[i] * eref; fa *= gam; }
#pragma unroll
        for (int i = TS - 1; i >= 0; --i) { kc[i] = bf2f(*(const LAS unsigned short*)(RAWG + (tb + i) * RP + d * 2)) * fk; fk *= gam; }
    } else {
        float g[TS], bs[TS], q[TS]; float run = 0.f;
#pragma unroll
        for (int i = 0; i < TS; ++i) { const int t = seg * TS + i; q[i] = bf2f(*(const LAS unsigned short*)(RAWQ + t * RP + d * 2)); g[i] = h2f(*(const LAS unsigned short*)(RAWG + t * RP + d * 2)) * 1.44269504089f; run += g[i]; bs[i] = run; }
        TOT[seg * DK + d] = run;
        __syncthreads();
        float pre = 0.f, ref = 0.f;
#pragma unroll
        for (int s2 = 0; s2 < NSEG; ++s2) { const float t = TOT[s2 * DK + d]; if (s2 < NSEG / 2) ref += t; if (s2 < seg) pre += t; }
        const float eref = __builtin_amdgcn_exp2f(ref);
#pragma unroll
        for (int i = 0; i < TS; ++i) { const float e1 = __builtin_amdgcn_fmed3f(pre + bs[i] - ref, -115.f, 115.f);
            qa[i] = q[i] * __builtin_amdgcn_exp2f(e1); kc[i] = (1.f - __builtin_amdgcn_exp2f(g[i])) * __builtin_amdgcn_exp2f(-e1); qb[i] = qa[i] * eref; }
    }
#pragma unroll
    for (int i = 0; i < TS; i += 2) { const int t = seg * TS + i; const unsigned wa = pk2(qa[i], qa[i + 1]), wk = pk2(kc[i], kc[i + 1]), wb = pk2(qb[i], qb[i + 1]);
        *(LAS unsigned short*)(QA + t * PITCH + d * 2) = (unsigned short)wa; *(LAS unsigned short*)(QA + (t + 1) * PITCH + d * 2) = (unsigned short)(wa >> 16);
        *(LAS unsigned short*)(KC + t * PITCH + d * 2) = (unsigned short)wk; *(LAS unsigned short*)(KC + (t + 1) * PITCH + d * 2) = (unsigned short)(wk >> 16);
        *(LAS unsigned short*)(QB + t * PITCH + d * 2) = (unsigned short)wb; *(LAS unsigned short*)(QB + (t + 1) * PITCH + d * 2) = (unsigned short)(wb >> 16); }
    __syncthreads();
    }
    {
        const int tt = wave & 3, sp = wave >> 2;
#pragma unroll
        for (int hh = 0; hh < 2; ++hh) {
            const int st = 2 * sp + hh;
            f32x4 acc = (f32x4){0.f, 0.f, 0.f, 0.f};
#pragma unroll
            for (int kd = 0; kd < KD; ++kd) { const bf16x8 a = *(const LAS bf16x8*)(KC + (16 * st + fr) * PITCH + (32 * kd + 8 * fq) * 2), bq = *(const LAS bf16x8*)(QA + (16 * tt + fr) * PITCH + (32 * kd + 8 * fq) * 2);
                acc = mfma16(a, bq, acc); }
            const int t = 16 * tt + fr, s0 = 16 * st + 4 * fq;
            const float p0 = (s0 + 0 <= t) ? acc[0] : 0.f, p1 = (s0 + 1 <= t) ? acc[1] : 0.f, p2 = (s0 + 2 <= t) ? acc[2] : 0.f, p3 = (s0 + 3 <= t) ? acc[3] : 0.f;
            v2u w; w.x = pk2(p0, p1); w.y = pk2(p2, p3);
            *(LAS v2u*)(P + t * 144 + s0 * 2) = w;
        }
    }
    __syncthreads();
    f32x4 o[4];
    {
        f32x4 accX[4];
#pragma unroll
        for (int tt = 0; tt < 4; ++tt) { o[tt] = (f32x4){0.f, 0.f, 0.f, 0.f}; accX[tt] = (f32x4){0.f, 0.f, 0.f, 0.f}; }
#pragma unroll
        for (int ks = 0; ks < 2; ++ks) { const bf16x8 bv = tr_frag(VI, lane, wave, ks);
#pragma unroll
            for (int tt = 0; tt < 4; ++tt) { const bf16x8 a = *(const LAS bf16x8*)(P + (16 * tt + fr) * 144 + (32 * ks + 8 * fq) * 2); o[tt] = mfma16(a, bv, o[tt]); } }
#pragma unroll
        for (int kd = 0; kd < KD; ++kd)
#pragma unroll
            for (int tt = 0; tt < 4; ++tt) { const bf16x8 a = *(const LAS bf16x8*)(QB + (16 * tt + fr) * PITCH + (32 * kd + 8 * fq) * 2); accX[tt] = mfma16(a, sfr[kd], accX[tt]); }
#pragma unroll
        for (int tt = 0; tt < 4; ++tt) o[tt] = o[tt] + accX[tt];
    }
#pragma unroll
    for (int tt = 0; tt < 4; ++tt)
#pragma unroll
        for (int r = 0; r < 4; ++r) { float s = row16_sum(o[tt][r] * o[tt][r]);
            if (fr == 0) __hip_atomic_fetch_add(RED + 16 * tt + 4 * fq + r, s, __ATOMIC_RELAXED, __HIP_MEMORY_SCOPE_WORKGROUP); }
    __syncthreads();
#pragma unroll
    for (int tt = 0; tt < 4; ++tt)
#pragma unroll
        for (int r = 0; r < 4; r += 2) { const int t = 16 * tt + 4 * fq + r; const float rs0 = __builtin_amdgcn_rsqf(RED[t] * (1.f / 128.f) + EPS), rs1 = __builtin_amdgcn_rsqf(RED[t + 1] * (1.f / 128.f) + EPS);
            const unsigned w = pk2(o[tt][r] * rs0 * nwv, o[tt][r + 1] * rs1 * nwv);
            *(LAS unsigned short*)(OT + t * 272 + (16 * wave + fr) * 2) = (unsigned short)w; *(LAS unsigned short*)(OT + (t + 1) * 272 + (16 * wave + fr) * 2) = (unsigned short)(w >> 16); }
    __syncthreads();
    {
        const int ocol = (RET ? 0 : 512) + h * 128;
#pragma unroll
        for (int k = 0; k < 2; ++k) { const int row = (tid >> 4) + 32 * k, ch = tid & 15;
            const v4u ov = *(const LAS v4u*)(OT + row * 272 + ch * 16); const v4u gv = gate[k];
            const unsigned oo[4] = {ov.x, ov.y, ov.z, ov.w}, gg[4] = {gv.x, gv.y, gv.z, gv.w}; unsigned w[4];
#pragma unroll
            for (int e = 0; e < 4; ++e) w[e] = pk2(__builtin_bit_cast(float, oo[e] << 16) * __builtin_bit_cast(float, gg[e] << 16), __builtin_bit_cast(float, oo[e] & 0xffff0000u) * __builtin_bit_cast(float, gg[e] & 0xffff0000u));
            v4u wv; wv.x = w[0]; wv.y = w[1]; wv.z = w[2]; wv.w = w[3];
            *(v4u*)(O + (r0 + row) * 1024 + ocol + ch * 8) = wv; }
    }
}

template <int DK, bool RET>
__device__ __forceinline__ void mix_state_loop(LAS unsigned char* lds, const bf16* proj, bf16* ST, float* BL, int first, int step, int end, int tid_in) {
    int tid = tid_in; asm volatile("" : "+v"(tid));
    if (first >= end) return;
    StRegs<DK> cur; mix_state_load<DK, RET>(cur, proj, first, tid);
    for (int it = first; it < end; it += step) {
        StRegs<DK> nxt = cur;
        const bool more = it + step < end;
        if (more) mix_state_load<DK, RET>(nxt, proj, it + step, tid);
        mix_state_item<DK, RET>(lds, cur, ST, BL, it, tid);
        cur = nxt;
    }
}

__device__ __forceinline__ void mix_out_both(LAS unsigned char* lds, const bf16* proj, const bf16* STH, const bf16* STR, const float* nwH, const float* nwR, bf16* O, int first, int step, int tid_in) {
    int tid = tid_in; asm volatile("" : "+v"(tid));
    if (first >= 1024) return;
    OutRegs<128> ch; mix_out_load<128, false>(ch, proj, STH, nwH, first, tid);
    OutRegs<64> cr;
    for (int it = first; it < 1024; it += step) {
        mix_out_park<128, false>(lds, ch, tid);
        const v4u gate[2] = {ch.gate[0], ch.gate[1]}; bf16x8 sfr[4]; const float nwv = ch.nwv;
#pragma unroll
        for (int kd = 0; kd < 4; ++kd) sfr[kd] = ch.s[kd];
        if (it + step < 1024) mix_out_load<128, false>(ch, proj, STH, nwH, it + step, tid); else mix_out_load<64, true>(cr, proj, STR, nwR, first, tid);
        mix_out_item<128, false>(lds, gate, sfr, nwv, O, it, tid);
    }
    for (int it = first; it < 1024; it += step) {
        mix_out_park<64, true>(lds, cr, tid);
        const v4u gate[2] = {cr.gate[0], cr.gate[1]}; bf16x8 sfr[2]; const float nwv = cr.nwv;
#pragma unroll
        for (int kd = 0; kd < 2; ++kd) sfr[kd] = cr.s[kd];
        if (it + step < 1024) mix_out_load<64, true>(cr, proj, STR, nwR, it + step, tid);
        mix_out_item<64, true>(lds, gate, sfr, nwv, O, it, tid);
    }
}


#ifndef GEMM_SP2
#define GEMM_SP2 true
#endif
#ifndef GEMM_ALIGN
#define GEMM_ALIGN true
#endif
constexpr int I_IN = 16 * 112, I_OUT = 16 * 32, I_G = 16 * 88, I_DN = 44 * 32, I_LAYER = I_IN + I_OUT + 2 * I_G + I_DN;
#define TR_MAPF(x) (x)
#define TR_DECODE(T, IT0_) do { const int IT_ = TR_MAPF(IT0_); const int l_ = (IT_) / I_LAYER; int r_ = (IT_) % I_LAYER; bf16* Wl_ = (bf16*)(ws + WS_W + (size_t)l_ * W_LAYER); \
    if (r_ < I_IN) { T.W = w_in + (size_t)l_ * D * INW; T.WT = Wl_ + W_IN_OFF / 2; T.K = D; T.N = INW; T.item = r_; T.mode = 0; } \
    else if (r_ < I_IN + I_OUT) { T.W = w_out + (size_t)l_ * D * D; T.WT = Wl_ + W_OUT_OFF / 2; T.K = D; T.N = D; T.item = r_ - I_IN; T.mode = 0; } \
    else if (r_ < I_IN + I_OUT + I_G) { T.W = w_gate + (size_t)l_ * D * DFF; T.WT = Wl_ + W_GU_OFF / 2; T.K = D; T.N = DFF; T.item = r_ - I_IN - I_OUT; T.mode = 1; } \
    else if (r_ < I_IN + I_OUT + 2 * I_G) { T.W = w_up + (size_t)l_ * D * DFF; T.WT = Wl_ + W_GU_OFF / 2; T.K = D; T.N = DFF; T.item = r_ - I_IN - I_OUT - I_G; T.mode = 2; } \
    else { T.W = w_down + (size_t)l_ * DFF * D; T.WT = Wl_ + W_DN_OFF / 2; T.K = DFF; T.N = D; T.item = r_ - I_IN - I_OUT - 2 * I_G; T.mode = 0; } } while (0)
#define TRANSPOSE_RANGE(IT0, IT1, WIDX, NW) do { LAS float* scr_ = (LAS float*)(lds + wave * 16384); int it_ = (IT0) + (WIDX); \
    if (it_ < (IT1)) { TrItem cur_; TR_DECODE(cur_, it_); f32x4 v_[8]; transpose_load(v_, cur_, lane); \
        for (;;) { const int nx_ = it_ + (NW); const bool more_ = nx_ < (IT1); TrItem nt_ = cur_; f32x4 vn_[8]; \
            if (more_) { TR_DECODE(nt_, nx_); transpose_load(vn_, nt_, lane); } \
            transpose_store(v_, cur_, scr_, lane); \
            if (!more_) break; \
            cur_ = nt_; it_ = nx_; \
            _Pragma("unroll") for (int i_ = 0; i_ < 8; ++i_) v_[i_] = vn_[i_]; } } } while (0)
#define TRANSPOSE_RANGE_SIMPLE(IT0, IT1, WIDX, NW) do { LAS float* scr_ = (LAS float*)(lds + wave * 16384); \
    for (int it_ = (IT0) + (WIDX); it_ < (IT1); it_ += (NW)) { TrItem cur_; TR_DECODE(cur_, it_); f32x4 v_[8]; transpose_load(v_, cur_, lane); transpose_store(v_, cur_, scr_, lane); } } while (0)
#define SHW_MFMA_ALL() do { __syncthreads(); \
    for (int i_ = tid; i_ < 4 * BATCH * 128; i_ += NWAVES * 64) { const int grp_ = i_ >> 10, b_ = (i_ >> 7) & 7, ch_ = i_ & 127; \
        const float* src_ = MOD + ((size_t)(grp_ >> 1) * BATCH + b_) * (NMOD * D) + ((grp_ & 1) ? 3 * D : 0) + ch_ * 8; \
        const f32x4 a_ = *(const f32x4*)src_, c_ = *(const f32x4*)(src_ + 4); \
        v4u hi_, lo_; hi_.x = pk2(a_[0], a_[1]); hi_.y = pk2(a_[2], a_[3]); hi_.z = pk2(c_[0], c_[1]); hi_.w = pk2(c_[2], c_[3]); \
        lo_.x = pk2(a_[0] - __builtin_bit_cast(float, hi_.x << 16), a_[1] - __builtin_bit_cast(float, hi_.x & 0xffff0000u)); lo_.y = pk2(a_[2] - __builtin_bit_cast(float, hi_.y << 16), a_[3] - __builtin_bit_cast(float, hi_.y & 0xffff0000u)); \
        lo_.z = pk2(c_[0] - __builtin_bit_cast(float, hi_.z << 16), c_[1] - __builtin_bit_cast(float, hi_.z & 0xffff0000u)); lo_.w = pk2(c_[2] - __builtin_bit_cast(float, hi_.w << 16), c_[3] - __builtin_bit_cast(float, hi_.w & 0xffff0000u)); \
        *(LAS v4u*)(lds + grp_ * 32768 + b_ * 2048 + ((ch_ ^ b_) << 4)) = hi_; *(LAS v4u*)(lds + grp_ * 32768 + (8 + b_) * 2048 + ((ch_ ^ (8 + b_)) << 4)) = lo_; } \
    __syncthreads(); \
    for (int it_ = wave * G + vcu; it_ < DEPTH * 9216 / 16; it_ += NWAVES * G) { \
        const int r0_ = it_ * 16, l_ = r0_ / 9216, rr_ = r0_ % 9216, type_ = rr_ >= INW ? 1 : 0, np0_ = type_ ? rr_ - INW : rr_, fr_ = lane & 15, fq_ = lane >> 4; \
        const bf16* wrow_ = (const bf16*)(ws + WS_W + (size_t)l_ * W_LAYER + (type_ ? W_GU_OFF : W_IN_OFF)) + (size_t)(np0_ + fr_) * D + 8 * fq_; \
        LAS unsigned char* ab_ = lds + (l_ * 2 + type_) * 32768 + fr_ * 2048; \
        f32x4 c_ = {0.f, 0.f, 0.f, 0.f}; \
        { bf16x8 bw_[32];                                     \
            _Pragma("unroll") for (int j_ = 0; j_ < 32; ++j_) bw_[j_] = *(const bf16x8*)(wrow_ + j_ * 32); \
            _Pragma("unroll") for (int j_ = 0; j_ < 32; ++j_) { const int ch_ = 4 * j_ + fq_; c_ = mfma16(*(const LAS bf16x8*)(ab_ + ((ch_ ^ fr_) << 4)), bw_[j_], c_); } } \
        _Pragma("unroll") for (int r_ = 0; r_ < 4; ++r_) { const float t_ = c_[r_] + __shfl_xor(c_[r_], 32); \
            if (lane < 32) { const int bt_ = 4 * fq_ + r_; if (type_) SHW2[((size_t)l_ * BATCH + bt_) * 5632 + np0_ + fr_] = t_; else SHW1[((size_t)l_ * BATCH + bt_) * INW + np0_ + fr_] = t_; } } } } while (0)
#ifndef A0_ROWS
#define A0_ROWS 8
#endif
struct Args { const float* in[15]; float* out; unsigned char* ws; };
__global__ void __launch_bounds__(NWAVES * 64, 2) fwd_kernel(Args args) {
    extern __shared__ __attribute__((aligned(16))) unsigned char lds_raw[];
    LAS unsigned char* lds = (LAS unsigned char*)lds_raw;
    volatile LAS unsigned* MISC = (volatile LAS unsigned*)(lds + MISC_OFF);
    const int tid = threadIdx.x, lane = tid & 63, wave = __builtin_amdgcn_readfirstlane(tid >> 6);
    const int G = gridDim.x, bx = blockIdx.x;
    const int vcu = (G % 8 == 0) ? (bx % 8) * (G / 8) + bx / 8 : bx;
    const int gw = vcu * NWAVES + wave, NGW = G * NWAVES;
    unsigned char* ws = args.ws;
    const float* x = args.in[0]; const float* cvec = args.in[1]; const float* w_ada = args.in[2]; const float* b_ada = args.in[3];
    const float* norm_mix_w = args.in[4]; const float* w_in = args.in[5]; const float* ret_norm_w = args.in[6]; const float* hg_lb = args.in[7];
    const float* hg_norm_w = args.in[8]; const float* w_out = args.in[9]; const float* norm_ffn_w = args.in[10]; const float* w_gate = args.in[11];
    const float* w_up = args.in[12]; const float* w_down = args.in[13]; const float* final_w = args.in[14];
    float* out = args.out; bf16* X16 = (bf16*)args.out;
    gu32* ctl = (gu32*)(ws + WS_CTL);
    float* MOD = (float*)(ws + WS_MOD); float* SSUM = (float*)(ws + WS_SSUM); float2* TAB = (float2*)(ws + WS_TAB);
    float* SHW1 = (float*)(ws + WS_SHW1); float* SHW2 = (float*)(ws + WS_SHW2); float* BL = (float*)(ws + WS_BL);
    bf16* ABUF = (bf16*)(ws + WS_A); bf16* PROJ = (bf16*)(ws + WS_PROJ); bf16* URET = (bf16*)(ws + WS_URET); bf16* UHG = (bf16*)(ws + WS_UHG); bf16* A2 = (bf16*)(ws + WS_A2);

    for (int u = tid; u < (LDS_BYTES - LDSCTL_OFF) / 4; u += NWAVES * 64) ((LAS unsigned*)(lds + LDSCTL_OFF))[u] = 0u;
    __syncthreads();
    XcdBarrier bar = xcd_barrier_post((unsigned*)(ctl + CW_BAR), MISC + 8);
#define GRID_BAR() xcd_barrier(bar)

    {
        LAS float* cs = (LAS float*)lds;
        for (int i = tid; i < BATCH * D; i += NWAVES * 64) cs[i] = pg8::silu_f(cvec[i]);
        __syncthreads();
        const int rep_ = 1;
        for (int uidx = vcu; uidx < 240; uidx += G) {
            const int l = uidx / 120, r = uidx % 120, cg = r / 10, ks = r % 10, k0 = (ks * 1024) / 10, k1 = ((ks + 1) * 1024) / 10, n = cg * 512 + tid;
            float acc[BATCH];
#pragma unroll
            for (int b = 0; b < BATCH; ++b) acc[b] = 0.f;
            const float* w = w_ada + (size_t)l * D * (NMOD * D) + n;
#pragma unroll 17
            for (int k = k0; k < k1; ++k) { const float wv = LD_ONCE(w + (size_t)k * (NMOD * D));
#pragma unroll
                for (int b = 0; b < BATCH; ++b) acc[b] += cs[b * D + k] * wv; }
            const float bb = ks == 0 ? b_ada[l * NMOD * D + n] : 0.f;
#pragma unroll
            for (int b = 0; b < BATCH; ++b) atomicAdd((rep_ == 1 ? MOD : (float*)(ws + WS_URET)) + ((size_t)l * BATCH + b) * (NMOD * D) + n, acc[b] + bb);
        }
        __syncthreads();
        TRANSPOSE_RANGE(0, DEPTH * I_LAYER, gw, NGW);
        for (int idx = vcu * (NWAVES * 64) + tid; idx < SEQ * 32; idx += G * NWAVES * 64) {
            const int pos = idx >> 5, i = idx & 31;
            const float lin = (float)i / 31.0f;
            const float inv = (float)exp(-(double)lin * 9.210340371976184);
            const float theta = (float)pos * inv;
            const double rev = (double)theta * 0.15915494309189535;
            const double ang = (rev - rint(rev)) * 6.283185307179586;
            TAB[idx] = make_float2((float)cos(ang), (float)sin(ang));
        }
    }
    GRID_BAR();
    {
        for (int rg = gw; rg < M / A0_ROWS; rg += NGW) {
            const int row0 = rg * A0_ROWS, b = row0 >> 11;
            f32x4 v[A0_ROWS][4];
#pragma unroll
            for (int r = 0; r < A0_ROWS; ++r)
#pragma unroll
                for (int j = 0; j < 4; ++j) v[r][j] = LD_ONCE((const f32x4*)(x + (size_t)(row0 + r) * D) + lane + 64 * j);
            f32x4 wm[4];
#pragma unroll
            for (int j = 0; j < 4; ++j) { const int col = (lane + 64 * j) * 4; wm[j] = (*(const f32x4*)(norm_mix_w + col)) * (1.f + *(const f32x4*)(MOD + (size_t)b * (NMOD * D) + D + col)); }
#pragma unroll
            for (int r = 0; r < A0_ROWS; ++r) {
                float s = 0.f;
#pragma unroll
                for (int j = 0; j < 4; ++j) s += (v[r][j][0] * v[r][j][0] + v[r][j][1] * v[r][j][1]) + (v[r][j][2] * v[r][j][2] + v[r][j][3] * v[r][j][3]);
                s = wave_sum(s);
                if (lane == 0) SSUM[row0 + r] = s;
                v2u* o8 = (v2u*)(ABUF + (size_t)(row0 + r) * D) + lane;
#pragma unroll
                for (int j = 0; j < 4; ++j) { const f32x4 a = v[r][j] * wm[j]; v2u w; w.x = pk2(a[0], a[1]); w.y = pk2(a[2], a[3]); o8[64 * j] = w; }
            }
        }
        SHW_MFMA_ALL();
    }
    GRID_BAR();
    for (int l = 0; l < DEPTH; ++l) {
        const bf16* Wl = (const bf16*)(ws + WS_W + (size_t)l * W_LAYER);
        const float* modl = MOD + (size_t)l * BATCH * (NMOD * D);
        {
            const int nM = M / 256;
            const bool split = (nM * 12) % G == 0 && nM * 4 == G;
            for (int part = 0; part < 2; ++part) {
                const int t0 = part == 0 ? 0 : (split ? 12 : 14), ntl = part == 0 ? (split ? 12 : 14) : (split ? 2 : 0);
                pg8::Gemm g{ABUF, Wl + W_IN_OFF / 2 + (size_t)t0 * 256 * D, M, ntl * 256, D}; pg8::StaticOrder S; S.init(M, ntl * 256, G, bx);
                pg8::EpiWin E{PROJ, SSUM + (size_t)(2 * l) * M, SHW1 + (size_t)l * BATCH * INW, TAB, hg_lb, l, lds + STAGE_OFF, t0};
                pg8::gemm_phase<pg8::EpiWin, pg8::StaticOrder, GEMM_ALIGN, GEMM_SP2>(lds, g, S, E);
                if (part == 0) GRID_BAR();
            }
            int first = bx, step = G;
            if (split) { const int nb = nM * 2; if (bx < nb) { first = bx; step = 1024; } else { first = bx; step = G - nb; } }
            mix_state_loop<128, false>(lds, PROJ, UHG, BL, first, step, 1024, tid);
            mix_state_loop<64, true>(lds, PROJ, URET, BL, first, step, 1024, tid);
        }
        GRID_BAR();
        {
            int tid3 = threadIdx.x; asm volatile("" : "+v"(tid3));
            for (int w = bx * (NWAVES * 64) + tid3; w < 32768; w += G * NWAVES * 64) {
                const int bh = w >> 10; bf16* base = URET + (size_t)bh * 32 * 8192 + (size_t)(w & 1023) * 8;
                const float dret = __builtin_amdgcn_exp2f(64.f * __log2f(1.f - exp2f(-5.f - (float)(bh & 3))));
                float S[8];
#pragma unroll
                for (int e = 0; e < 8; ++e) S[e] = 0.f;
                for (int cb = 0; cb < NCH; cb += 8) {
                    v4u uv[8];
#pragma unroll
                    for (int k = 0; k < 8; ++k) uv[k] = *(const v4u*)(base + (size_t)(cb + k) * 8192);
#pragma unroll
                    for (int k = 0; k < 8; ++k) {
                        v4u sv; sv.x = pk2(S[0], S[1]); sv.y = pk2(S[2], S[3]); sv.z = pk2(S[4], S[5]); sv.w = pk2(S[6], S[7]);
                        *(v4u*)(base + (size_t)(cb + k) * 8192) = sv;
                        const unsigned uu[4] = {uv[k].x, uv[k].y, uv[k].z, uv[k].w};
#pragma unroll
                        for (int e = 0; e < 4; ++e) { S[2 * e] = dret * S[2 * e] + __builtin_bit_cast(float, uu[e] << 16); S[2 * e + 1] = dret * S[2 * e + 1] + __builtin_bit_cast(float, uu[e] & 0xffff0000u); }
                    }
                }
            }
            for (int w2 = bx * (NWAVES * 64) + tid3; w2 < 65536; w2 += G * NWAVES * 64) {
                const int bh = w2 >> 11, d0 = (w2 & 15) * 8; bf16* base = UHG + (size_t)bh * 32 * 16384 + (size_t)(w2 & 2047) * 8; const float* blp = BL + (size_t)bh * 32 * 128 + d0;
                float S[8];
#pragma unroll
                for (int e = 0; e < 8; ++e) S[e] = 0.f;
                for (int cb = 0; cb < NCH; cb += 4) {
                    v4u uv[4]; f32x4 bl0[4], bl1[4];
#pragma unroll
                    for (int k = 0; k < 4; ++k) { uv[k] = *(const v4u*)(base + (size_t)(cb + k) * 16384); bl0[k] = *(const f32x4*)(blp + (cb + k) * 128); bl1[k] = *(const f32x4*)(blp + (cb + k) * 128 + 4); }
#pragma unroll
                    for (int k = 0; k < 4; ++k) {
                        float dec[8];
#pragma unroll
                        for (int e = 0; e < 4; ++e) { dec[e] = __builtin_amdgcn_exp2f(bl0[k][e]); dec[4 + e] = __builtin_amdgcn_exp2f(bl1[k][e]); }
                        v4u sv; sv.x = pk2(S[0], S[1]); sv.y = pk2(S[2], S[3]); sv.z = pk2(S[4], S[5]); sv.w = pk2(S[6], S[7]);
                        *(v4u*)(base + (size_t)(cb + k) * 16384) = sv;
                        const unsigned uu[4] = {uv[k].x, uv[k].y, uv[k].z, uv[k].w};
#pragma unroll
                        for (int e = 0; e < 4; ++e) { S[2 * e] = dec[2 * e] * S[2 * e] + __builtin_bit_cast(float, uu[e] << 16); S[2 * e + 1] = dec[2 * e + 1] * S[2 * e + 1] + __builtin_bit_cast(float, uu[e] & 0xffff0000u); }
                    }
                }
            }
        }
        GRID_BAR();
        {
            { mix_out_both(lds, PROJ, UHG, URET, hg_norm_w + l * 512, ret_norm_w + l * 512, ABUF, bx, G, tid); __syncthreads(); }
        }
        GRID_BAR();
        {
            pg8::Gemm g{ABUF, Wl + W_OUT_OFF / 2, M, D, D}; pg8::StaticOrder S; S.init(M, D, G, bx);
            if (l == 0) { pg8::EpiRes<true> E{x, X16, modl + 2 * D, norm_ffn_w + l * D, modl + 4 * D, A2, SSUM + (size_t)(2 * l + 1) * M};
                pg8::gemm_phase<pg8::EpiRes<true>, pg8::StaticOrder, true, GEMM_SP2>(lds, g, S, E); }
            else { pg8::EpiRes<false> E{X16, X16, modl + 2 * D, norm_ffn_w + l * D, modl + 4 * D, A2, SSUM + (size_t)(2 * l + 1) * M};
                pg8::gemm_phase<pg8::EpiRes<false>, pg8::StaticOrder, true, GEMM_SP2>(lds, g, S, E); }
        }
        GRID_BAR();
        {
            pg8::Gemm g{A2, Wl + W_GU_OFF / 2, M, 2 * DFF, D};
            const int nwg6 = (M / 256) * (2 * DFF / 256), remh = nwg6 % G, nfull6 = nwg6 / G; const bool halft = remh != 0 && 2 * remh == G;
            pg8::EpiFfn E{PROJ, SSUM + (size_t)(2 * l + 1) * M, SHW2 + (size_t)l * BATCH * 5632, lds + STAGE_OFF};
            if (halft) {
                pg8::LimitOrder SL; SL.base.init(M, 2 * DFF, G, bx); SL.maxr = nfull6;
                pg8::gemm_phase<pg8::EpiFfn, pg8::LimitOrder, GEMM_ALIGN, GEMM_SP2>(lds, g, SL, E);
                pg8::StaticOrder T; T.init(M, 2 * DFF, G, bx % remh); pg8::Unit uh; T.next(nfull6, uh);
                pg8::gemm_half_unit<pg8::EpiFfn>(lds, g, uh, bx / remh, E, 0);
            } else {
            pg8::StaticOrder S; S.init(M, 2 * DFF, G, bx);
            pg8::gemm_phase<pg8::EpiFfn, pg8::StaticOrder, GEMM_ALIGN, GEMM_SP2>(lds, g, S, E);
            }
        }
        GRID_BAR();
        const bool has_next = (l + 1 < DEPTH);
        const bool fuse_final = !has_next && (M / 256) * (D / 256) == G;
        {
            pg8::Gemm g{PROJ, Wl + W_DN_OFF / 2, M, D, DFF}; pg8::StaticOrder S; S.init(M, D, G, bx);
            if (fuse_final) {
                pg8::EpiFinal E{X16, out, modl + 5 * D, final_w, SSUM + (size_t)(2 * l + 2) * M, &bar};
                pg8::gemm_phase<pg8::EpiFinal, pg8::StaticOrder, false, GEMM_SP2>(lds, g, S, E);
            } else {
                pg8::EpiRes<false> E{X16, X16, modl + 5 * D, has_next ? norm_mix_w + (l + 1) * D : nullptr, modl + BATCH * (NMOD * D) + D, ABUF, SSUM + (size_t)(2 * l + 2) * M};
                pg8::gemm_phase<pg8::EpiRes<false>, pg8::StaticOrder, true, GEMM_SP2>(lds, g, S, E);
            }
        }
        if (fuse_final) return;
        GRID_BAR();
    }
    {
        int tid_f = threadIdx.x; asm volatile("" : "+v"(tid_f)); const int lane_f = tid_f & 63;
        v4u hold[16][2];
#pragma unroll
        for (int i = 0; i < 16; ++i) { const int row = gw + i * NGW; if (row < M) { hold[i][0] = *((const v4u*)(X16 + (size_t)row * D) + lane_f * 2); hold[i][1] = *((const v4u*)(X16 + (size_t)row * D) + lane_f * 2 + 1); } }
        GRID_BAR();
#pragma unroll
        for (int i = 0; i < 16; ++i) { const int row = gw + i * NGW; if (row < M) {
            const float rs = __builtin_amdgcn_rsqf(SSUM[(size_t)4 * M + row] * (1.f / D) + EPS);
#pragma unroll
            for (int hh = 0; hh < 2; ++hh) { const unsigned w4[4] = {hold[i][hh].x, hold[i][hh].y, hold[i][hh].z, hold[i][hh].w};
#pragma unroll
                for (int q = 0; q < 2; ++q) { const int col = lane_f * 16 + hh * 8 + q * 4; const f32x4 fwv = *(const f32x4*)(final_w + col);
                    f32x4 o; o[0] = pg8::f16lo(w4[2 * q]); o[1] = pg8::f16hi(w4[2 * q]); o[2] = pg8::f16lo(w4[2 * q + 1]); o[3] = pg8::f16hi(w4[2 * q + 1]);
                    *(f32x4*)(out + (size_t)row * D + col) = o * rs * fwv; } } } }
    }
}

extern "C" void kernel_launch(void* const* d_in, const int* in_sizes, int n_in, void* d_out, int out_size, void* d_ws, size_t ws_size, hipStream_t stream) {
    static int grid = 0;
    if (grid == 0) {
        if (n_in != 15 || in_sizes[0] != M * D || out_size != M * D || ws_size < WS_END) { fprintf(stderr, "kernel_launch: unexpected shapes (n_in %d, in0 %d, out %d, ws %zu); nothing launched\n", n_in, n_in > 0 ? in_sizes[0] : -1, out_size, ws_size); grid = -1; return; }
        int dev = 0, cus = 0, per_cu = 0;
        if (hipGetDevice(&dev) != hipSuccess || hipDeviceGetAttribute(&cus, hipDeviceAttributeMultiprocessorCount, dev) != hipSuccess) { fprintf(stderr, "kernel_launch: device query failed\n"); grid = -1; return; }
        if (hipFuncSetAttribute((const void*)fwd_kernel, hipFuncAttributeMaxDynamicSharedMemorySize, LDS_BYTES) != hipSuccess) { fprintf(stderr, "kernel_launch: hipFuncSetAttribute failed\n"); grid = -1; return; }
        if (hipOccupancyMaxActiveBlocksPerMultiprocessor(&per_cu, (const void*)fwd_kernel, NWAVES * 64, LDS_BYTES) != hipSuccess || per_cu < 1)
            fprintf(stderr, "kernel_launch: note: occupancy query reports %d workgroups per CU\n", per_cu);
        (void)hipGetLastError();
        grid = cus;
    }
    if (grid < 0) return;
    if (hipMemsetAsync((char*)d_ws + WS_CTL, 0, CTL_ZERO_BYTES, stream) != hipSuccess) { fprintf(stderr, "kernel_launch: hipMemsetAsync failed\n"); return; }
    Args a{};
    for (int i = 0; i < 15; ++i) a.in[i] = (const float*)d_in[i];
    a.out = (float*)d_out; a.ws = (unsigned char*)d_ws;
    hipLaunchKernelGGL(fwd_kernel, dim3(grid), dim3(NWAVES * 64), LDS_BYTES, stream, a);
    const hipError_t le = hipPeekAtLastError();
    if (le != hipSuccess) fprintf(stderr, "kernel_launch: launch failed: %s\n", hipGetErrorName(le));
}
```

```cpp
#include <hip/hip_runtime.h>
#include <cstdio>
#include <cstdint>
#define LAS __attribute__((address_space(3)))
#define SHW_FILL_ALL 8


#define XB_TMO      128
#define XB_XCNT(j)  (256  + 64 * (j))
#define XB_XSUB(j)  (1280 + 64 * (j))
#define XB_XGEN(j)  (2304 + 64 * (j))
#define XB_TOP      3328
#define XB_TOPGEN   3392
#define XCD_BAR_WORDS 3456
#define XB_SPIN_CAP (1u << 18)

__device__ __forceinline__ unsigned xb_ld(unsigned* p)              { return __hip_atomic_load(p, __ATOMIC_RELAXED, __HIP_MEMORY_SCOPE_AGENT); }
__device__ __forceinline__ unsigned xb_add(unsigned* p, unsigned v) { return __hip_atomic_fetch_add(p, v, __ATOMIC_RELAXED, __HIP_MEMORY_SCOPE_AGENT); }
__device__ __forceinline__ unsigned xb_xcc_id() { return (unsigned)__builtin_amdgcn_s_getreg((3 << 11) | 20) & 0xFu; }
#define XB_SPIN(cond, bar) do { unsigned _sp = 0; while (cond) { __builtin_amdgcn_s_sleep(1); \
    if ((++_sp & 255u) == 0u) { if (xb_ld(&(bar)[XB_TMO])) break; if (_sp > XB_SPIN_CAP) { atomicAdd(&(bar)[XB_TMO], 1u); break; } } } } while (0)

#ifndef XB_DEPTH
#define XB_DEPTH 2
#endif
#ifndef XB_STAGGER
#define XB_STAGGER 8
#endif
__device__ __forceinline__ void xb_spin2(unsigned* p, unsigned target, unsigned* bar) {
    unsigned sp = 0u, a = xb_ld(p);
    __builtin_amdgcn_s_sleep(XB_STAGGER);
    for (;;) {
        const unsigned b = xb_ld(p); if (a == target) break;
        a = xb_ld(p); if (b == target) break;
        if ((++sp & 127u) == 0u) { if (xb_ld(&bar[XB_TMO])) break; if (sp > (XB_SPIN_CAP >> 1)) { atomicAdd(&bar[XB_TMO], 1u); break; } }
    }
}

struct XcdBarrier {
    unsigned* bar; unsigned x;
    volatile LAS unsigned* st;
};

__device__ __forceinline__ XcdBarrier xcd_barrier_post(unsigned* bar, volatile LAS unsigned* st) {
    XcdBarrier b; b.bar = bar; b.x = xb_xcc_id(); b.st = st;
    if (threadIdx.x == 0) (void)xb_add(&bar[XB_XCNT(b.x)], 1u);
    return b;
}
__device__ __forceinline__ void xcd_barrier_complete(unsigned* bar, unsigned x, unsigned& nloc, unsigned& nx) {
    const unsigned G = gridDim.x * gridDim.y * gridDim.z;
    unsigned sum, cnt, mine, sp = 0u;
    for (;;) {
        sum = 0u; cnt = 0u; mine = 0u;
#pragma unroll 1
        for (unsigned j = 0; j < 16; ++j) { const unsigned c = xb_ld(&bar[XB_XCNT(j)]); sum += c; cnt += (c > 0u) ? 1u : 0u; mine = (j == x) ? c : mine; }
        if (sum == G) break;
        __builtin_amdgcn_s_sleep(1);
        if ((++sp & 255u) == 0u) { if (xb_ld(&bar[XB_TMO])) break; if (sp > XB_SPIN_CAP) { atomicAdd(&bar[XB_TMO], 1u); break; } }
    }
    nloc = mine > 0u ? mine : 1u; nx = cnt > 0u ? cnt : 1u;
}

__device__ __forceinline__ void xcd_barrier(const XcdBarrier& b) {
    asm volatile("s_waitcnt vmcnt(0)" ::: "memory");
    __syncthreads();
    if (threadIdx.x == 0) {
        unsigned* bar = b.bar; const unsigned bx_ = xb_xcc_id();
        __builtin_amdgcn_s_waitcnt(0);
        unsigned nloc = b.st[0], nx = b.st[1];
        if (nloc == 0u) { xcd_barrier_complete(bar, bx_, nloc, nx); b.st[0] = nloc; b.st[1] = nx; }
        const unsigned gen = b.st[2]; b.st[2] = gen + 1u;
        const unsigned old = xb_add(&bar[XB_XSUB(bx_)], 1u);
        if (old + 1u == (gen + 1u) * nloc) {
            __builtin_amdgcn_fence(__ATOMIC_RELEASE, "agent");
            asm volatile("s_waitcnt vmcnt(0)" ::: "memory");
            asm volatile("buffer_inv sc1" ::: "memory");
            const unsigned og = xb_add(&bar[XB_TOP], 1u);
            asm volatile("s_waitcnt vmcnt(0)" ::: "memory");
            xb_add(&bar[XB_XGEN(bx_)], 1u);
            if (og + 1u == (gen + 1u) * nx) {
                unsigned zo = 0u; asm volatile("" : "+v"(zo)); unsigned* gb = bar + XB_XGEN(0) + zo;
#pragma unroll
                for (unsigned j = 0; j < 16u; ++j) xb_add(gb + 64u * j, 1u);
            }
            xb_spin2(&bar[XB_XGEN(bx_)], 2u * gen + 2u, bar);
            asm volatile("s_waitcnt vmcnt(0)" ::: "memory");
        } else {
            asm volatile("buffer_inv sc1" ::: "memory");
            xb_spin2(&bar[XB_XGEN(bx_)], 2u * gen + 2u, bar);
            asm volatile("s_waitcnt vmcnt(0)" ::: "memory");
        }
    }
    __syncthreads();
}

template <class F>
__device__ __forceinline__ void xcd_barrier_hook(const XcdBarrier& b, F early) {
    asm volatile("s_waitcnt vmcnt(0)" ::: "memory");
    __syncthreads();
    early();
    if (threadIdx.x == 0) {
        unsigned* bar = b.bar; const unsigned bx_ = xb_xcc_id();
        __builtin_amdgcn_s_waitcnt(0);
        unsigned nloc = b.st[0], nx = b.st[1];
        if (nloc == 0u) { xcd_barrier_complete(bar, bx_, nloc, nx); b.st[0] = nloc; b.st[1] = nx; }
        const unsigned gen = b.st[2]; b.st[2] = gen + 1u;
        const unsigned old = xb_add(&bar[XB_XSUB(bx_)], 1u);
        if (old + 1u == (gen + 1u) * nloc) {
            __builtin_amdgcn_fence(__ATOMIC_RELEASE, "agent");
            asm volatile("s_waitcnt vmcnt(0)" ::: "memory");
            asm volatile("buffer_inv sc1" ::: "memory");
            const unsigned og = xb_add(&bar[XB_TOP], 1u);
            asm volatile("s_waitcnt vmcnt(0)" ::: "memory");
            xb_add(&bar[XB_XGEN(bx_)], 1u);
            if (og + 1u == (gen + 1u) * nx) {
                unsigned zo = 0u; asm volatile("" : "+v"(zo)); unsigned* gb = bar + XB_XGEN(0) + zo;
#pragma unroll
                for (unsigned j = 0; j < 16u; ++j) xb_add(gb + 64u * j, 1u);
            }
            xb_spin2(&bar[XB_XGEN(bx_)], 2u * gen + 2u, bar);
            asm volatile("s_waitcnt vmcnt(0)" ::: "memory");
        } else {
            asm volatile("buffer_inv sc1" ::: "memory");
            xb_spin2(&bar[XB_XGEN(bx_)], 2u * gen + 2u, bar);
            asm volatile("s_waitcnt vmcnt(0)" ::: "memory");
        }
    }
    __syncthreads();
}

namespace pg8 {
#define PG8_LAS __attribute__((address_space(3)))
typedef unsigned short bf16_t;
typedef short bf16x8 __attribute__((ext_vector_type(8)));
typedef float f32x4 __attribute__((ext_vector_type(4)));
typedef unsigned u32x4 __attribute__((ext_vector_type(4)));
constexpr int BM = 256, BK = 64, HALF = 128, HTB = HALF * BK * 2  , STAGE_BYTES = 8 * HTB, NXCD = 8;
constexpr int WGM = 2;

__host__ __device__ __forceinline__ int lds_byte(int r, int c) { const int st = (r >> 4) * 2 + (c >> 5), rr = r & 15, cc = c & 31, ob = rr * 64 + cc * 2; return st * 1024 + (ob ^ (((ob >> 9) & 1) << 5)); }
__host__ __device__ __forceinline__ void stage_rc(int b, int& R, int& C) { const int st = b / 1024, sb = b % 1024, swz = sb ^ (((sb >> 9) & 1) << 5); R = (st >> 1) * 16 + swz / 64; C = (st & 1) * 32 + (swz % 64) / 2; }
__host__ __device__ __forceinline__ int perm32(int rho) { const int n = rho >> 4, i = rho & 15; return 8 * (i >> 2) + 4 * n + (i & 3); }

struct Unit { int pm, pn; };
struct Gemm { const bf16_t* A; const bf16_t* Bt; int M, N, K; int lda; };

struct StaticOrder {
    static constexpr bool HAS_TAIL = false;
    int nM, nN, nwg, G, c;
    __host__ __device__ void init(int M, int N, int G_, int c_) { nM = M / BM; nN = N / BM; nwg = nM * nN; G = G_; c = c_; }
    __host__ __device__ __forceinline__ bool next(int i, Unit& u) const {
        const long L = (long)i * G + c; if (L >= nwg) return false;
        int wgid = (int)L; { const int q = nwg / NXCD, r = nwg % NXCD, xcd = wgid % NXCD, off = wgid / NXCD; wgid = (xcd < r ? xcd * (q + 1) : r * (q + 1) + (xcd - r) * q) + off; }
        const int nig = WGM * nN, gid = wgid / nig, fm = gid * WGM, gsz = (nM - fm) < WGM ? (nM - fm) : WGM;
        u.pm = fm + ((wgid % nig) % gsz); u.pn = (wgid % nig) / gsz; return true;
    }
    __device__ __forceinline__ void a_ready(const Unit&) const {}
    __device__ __forceinline__ void done(const Unit&) const {}
};

struct LimitOrder {
    static constexpr bool HAS_TAIL = true;
    StaticOrder base; int maxr; const char* tA; const char* tB;
    __device__ __forceinline__ bool next(int i, Unit& u) const { return i < maxr && base.next(i, u); }
    __device__ __forceinline__ void a_ready(const Unit&) const {}
    __device__ __forceinline__ void done(const Unit&) const {}
};

struct HalfStream {
    StaticOrder base, tail; int nfull, thalf, has_tail;
    __device__ __forceinline__ int count() const { return 2 * nfull + has_tail; }
    __device__ __forceinline__ void get(int j, Unit& u, int& half) const { if (j < 2 * nfull) { base.next(j >> 1, u); half = j & 1; } else { tail.next(nfull, u); half = thalf; } }
};

typedef float f32x2c_t __attribute__((ext_vector_type(2))); typedef __bf16 bf16x2c_t __attribute__((ext_vector_type(2)));
__device__ __forceinline__ unsigned cvt_pk_bf16(float lo, float hi) { const f32x2c_t v = {lo, hi}; const bf16x2c_t b = __builtin_convertvector(v, bf16x2c_t); return __builtin_bit_cast(unsigned, b); }
typedef float f32x2 __attribute__((ext_vector_type(2)));


constexpr float K_EPS = 1e-6f;
#define PG8_LD1(p) (*(p))
#define PG8_ST(T, p, v) (*(T*)(p) = (v))
__device__ __forceinline__ float silu_f(float v) { return v * __builtin_amdgcn_rcpf(1.f + __expf(-v)); }
__device__ __forceinline__ unsigned pk_f16(float lo, float hi) { const _Float16 a = (_Float16)lo, b = (_Float16)hi; return (unsigned)__builtin_bit_cast(unsigned short, a) | ((unsigned)__builtin_bit_cast(unsigned short, b) << 16); }

struct EpiWin {
    static constexpr bool PERM = true, AFTER_DRAIN = false, STAGED = true; static constexpr int NSTORE = 16;
    bf16_t* proj;
    const float* ssum;
    const float* shw;
    const float2* tab;
    const float* lbw;
    int layer;
    PG8_LAS unsigned char* stage;
    int pn_off;
    __device__ __forceinline__ void prefetch(const Unit& u, int ui, int wid, int lane) const {
        const float* src = wid < 4 ? ssum + u.pm * BM + 64 * wid + lane : shw + (size_t)(u.pm >> 3) * 3584 + (u.pn + pn_off) * BM + 64 * (wid - 4) + lane;
        __builtin_amdgcn_global_load_lds((const unsigned*)src, (PG8_LAS unsigned*)(stage + (ui & 1) * 2048 + wid * 256), 4, 0, 0);
    }
    __device__ __forceinline__ void operator()(const f32x4 (&acc)[2][2][4][2], const Unit& u, int wr, int wc, int fr_in, int fq_in, int ui, bool dry = false) const {
        int fr = fr_in, fq = fq_in; asm volatile("" : "+v"(fr), "+v"(fq));
        const int b = u.pm >> 3, pn = u.pn + pn_off;
        const int colb = pn * BM + wc * 32 + 8 * fq;
        const PG8_LAS float* SS = (const PG8_LAS float*)(stage + (ui & 1) * 2048); const PG8_LAS float* SV = SS + 256;
        const int type = pn == 0 ? 0 : pn == 1 ? 1 : (pn == 2 || pn == 3 || pn == 10 || pn == 11) ? 2 : (pn == 8 || pn == 9) ? 4 : 3;
        f32x4 sv[2][2];
#pragma unroll
        for (int bj = 0; bj < 2; ++bj)
#pragma unroll
            for (int n = 0; n < 2; ++n) sv[bj][n] = *(const PG8_LAS f32x4*)(SV + bj * HALF + wc * 32 + 8 * fq + 4 * n);
        float lb[2][8];
#pragma unroll
        for (int bj = 0; bj < 2; ++bj)
#pragma unroll
            for (int i = 0; i < 8; ++i) lb[bj][i] = 0.f;
        if (type == 4 && layer != 0) {
#pragma unroll
            for (int bj = 0; bj < 2; ++bj)
#pragma unroll
                for (int i = 0; i < 8; ++i) { const int c = colb + bj * HALF + i - 2048; lb[bj][i] = __builtin_amdgcn_rcpf(1.f + __expf(lbw[c] - lbw[512 + c])); }
        }
        if (type <= 1) {
            const float sc = type == 1 ? 0.125f : 1.f;
#pragma unroll
            for (int ap = 0; ap < 4; ++ap) { const int ai = ap >> 1, m0 = (ap & 1) * 2;
                f32x4 tb[2][2][2];
#pragma unroll
                for (int mm = 0; mm < 2; ++mm)
#pragma unroll
                    for (int bj = 0; bj < 2; ++bj) { const int pos = (u.pm * BM + ai * HALF + wr * 64 + (m0 + mm) * 16 + fr) & 2047, i0 = ((colb + bj * HALF) & 63) >> 1;
                        tb[mm][bj][0] = *(const f32x4*)(tab + pos * 32 + i0); tb[mm][bj][1] = *(const f32x4*)(tab + pos * 32 + i0 + 2); }
#pragma unroll
                for (int mm = 0; mm < 2; ++mm) { const int m = m0 + mm; const int row = u.pm * BM + ai * HALF + wr * 64 + m * 16 + fr;
                    const float rs = __builtin_amdgcn_rsqf(SS[ai * HALF + wr * 64 + m * 16 + fr] * (1.f / 1024.f) + K_EPS);
#pragma unroll
                    for (int bj = 0; bj < 2; ++bj) {
                        const f32x4 v0 = acc[ai][bj][m][0] * rs + sv[bj][0], v1 = acc[ai][bj][m][1] * rs + sv[bj][1];
                        const f32x4 t0 = tb[mm][bj][0], t1 = tb[mm][bj][1];
                        float o[8];
                        o[0] = (v0[0] * t0[0] - v0[1] * t0[1]) * sc; o[1] = (v0[0] * t0[1] + v0[1] * t0[0]) * sc;
                        o[2] = (v0[2] * t0[2] - v0[3] * t0[3]) * sc; o[3] = (v0[2] * t0[3] + v0[3] * t0[2]) * sc;
                        o[4] = (v1[0] * t1[0] - v1[1] * t1[1]) * sc; o[5] = (v1[0] * t1[1] + v1[1] * t1[0]) * sc;
                        o[6] = (v1[2] * t1[2] - v1[3] * t1[3]) * sc; o[7] = (v1[2] * t1[3] + v1[3] * t1[2]) * sc;
                        u32x4 w; w.x = cvt_pk_bf16(o[0], o[1]); w.y = cvt_pk_bf16(o[2], o[3]); w.z = cvt_pk_bf16(o[4], o[5]); w.w = cvt_pk_bf16(o[6], o[7]);
                        PG8_ST(u32x4, proj + (size_t)row * 3584 + colb + bj * HALF, w);
                    }
                }
                asm volatile("" ::: "memory");
            }
            return;
        }
#pragma unroll
        for (int ai = 0; ai < 2; ++ai)
#pragma unroll
            for (int m = 0; m < 4; ++m) {
                const int row = u.pm * BM + ai * HALF + wr * 64 + m * 16 + fr;
                const float rs = __builtin_amdgcn_rsqf(SS[ai * HALF + wr * 64 + m * 16 + fr] * (1.f / 1024.f) + K_EPS);
                const int pos = row & 2047;
#pragma unroll
                for (int bj = 0; bj < 2; ++bj) {
                    float v[8];
                    {   const f32x4 v0 = acc[ai][bj][m][0] * rs + sv[bj][0], v1 = acc[ai][bj][m][1] * rs + sv[bj][1];
                        v[0] = v0[0]; v[1] = v0[1]; v[2] = v0[2]; v[3] = v0[3]; v[4] = v1[0]; v[5] = v1[1]; v[6] = v1[2]; v[7] = v1[3]; }
                    u32x4 w;
                    if (type == 2) {
                        w.x = cvt_pk_bf16(v[0], v[1]); w.y = cvt_pk_bf16(v[2], v[3]); w.z = cvt_pk_bf16(v[4], v[5]); w.w = cvt_pk_bf16(v[6], v[7]);
                    } else if (type == 3) {
                        unsigned wv[4];
#pragma unroll
                        for (int q = 0; q < 4; ++q) { const f32x2 x = (f32x2){v[2 * q], v[2 * q + 1]}, xn = x * (-1.44269504089f);
                            f32x2 e; e.x = __builtin_amdgcn_exp2f(xn.x); e.y = __builtin_amdgcn_exp2f(xn.y);
                            const f32x2 d = e + 1.0f; f32x2 r; r.x = __builtin_amdgcn_rcpf(d.x); r.y = __builtin_amdgcn_rcpf(d.y);
                            const f32x2 o = x * r; wv[q] = cvt_pk_bf16(o.x, o.y); }
                        w.x = wv[0]; w.y = wv[1]; w.z = wv[2]; w.w = wv[3];
                    } else {
                        float g[8];
                        if (layer == 0) {
#pragma unroll
                            for (int i = 0; i < 8; ++i) g[i] = fminf(v[i], 0.f) - __logf(1.f + __expf(-fabsf(v[i])));
                        } else {
#pragma unroll
                            for (int i = 0; i < 8; ++i) { const float s = __builtin_amdgcn_rcpf(1.f + __expf(-v[i])); g[i] = __logf(lb[bj][i] + (1.f - lb[bj][i]) * s); }
                        }
                        w.x = pk_f16(g[0], g[1]); w.y = pk_f16(g[2], g[3]); w.z = pk_f16(g[4], g[5]); w.w = pk_f16(g[6], g[7]);
                    }
                    PG8_ST(u32x4, proj + (size_t)row * 3584 + colb + bj * HALF, w);
                }
            }
    }
};

__device__ __forceinline__ float f16lo(unsigned w) { return (float)__builtin_bit_cast(_Float16, (unsigned short)(w & 0xffffu)); }
__device__ __forceinline__ float f16hi(unsigned w) { return (float)__builtin_bit_cast(_Float16, (unsigned short)(w >> 16)); }
template <bool XF32> struct EpiRes {
    static constexpr bool PERM = true, AFTER_DRAIN = false, STAGED = false; static constexpr int NSTORE = 0;
    const void* xres; bf16_t* xout;
    const float* gvec;
    const float* nw; const float* scv;
    bf16_t* anext;
    float* ssum;
    int apitch;
    __device__ __forceinline__ void operator()(const f32x4 (&acc)[2][2][4][2], const Unit& u, int wr, int wc, int fr_in, int fq_in) const {
        int fr = fr_in, fq = fq_in; asm volatile("" : "+v"(fr), "+v"(fq));
        const int b = u.pm >> 3;
        const int colb = u.pn * BM + wc * 32 + 8 * fq;
        f32x4 gv[2][2], wm[2][2];
        if (nw) {
            f32x4 nv[2][2], sv2[2][2];
#pragma unroll
            for (int bj = 0; bj < 2; ++bj)
#pragma unroll
                for (int n = 0; n < 2; ++n) { const int c = colb + bj * HALF + 4 * n; nv[bj][n] = *(const f32x4*)(nw + c); sv2[bj][n] = *(const f32x4*)(scv + (size_t)b * 6144 + c); }
#pragma unroll
            for (int bj = 0; bj < 2; ++bj)
#pragma unroll
                for (int n = 0; n < 2; ++n) wm[bj][n] = nv[bj][n] * (1.f + sv2[bj][n]);
        } else {
#pragma unroll
            for (int bj = 0; bj < 2; ++bj)
#pragma unroll
                for (int n = 0; n < 2; ++n) wm[bj][n] = (f32x4){0.f, 0.f, 0.f, 0.f};
        }
#pragma unroll
        for (int bj = 0; bj < 2; ++bj)
#pragma unroll
            for (int n = 0; n < 2; ++n) gv[bj][n] = *(const f32x4*)(gvec + (size_t)b * 6144 + colb + bj * HALF + 4 * n);
#ifndef RES_NG32
#define RES_NG32 2
#endif
        constexpr int NG = XF32 ? RES_NG32 : 4;
#pragma unroll
        for (int g0 = 0; g0 < 8; g0 += NG) {
            f32x4 pre[NG][2][XF32 ? 2 : 1];
#pragma unroll
            for (int gg = 0; gg < NG; ++gg)
#pragma unroll
                for (int bj = 0; bj < 2; ++bj) { const int g = g0 + gg; if (g >= 8) continue; const size_t off = (size_t)(u.pm * BM + (g >> 2) * HALF + wr * 64 + (g & 3) * 16 + fr) * 1024 + colb + bj * HALF;
                    if constexpr (XF32) { pre[gg][bj][0] = *(const f32x4*)((const float*)xres + off); pre[gg][bj][XF32 ? 1 : 0] = *(const f32x4*)((const float*)xres + off + 4); }
                    else { const u32x4 h = *(const u32x4*)((const bf16_t*)xres + off); pre[gg][bj][0] = __builtin_bit_cast(f32x4, h); } }
#pragma unroll
            for (int gg = 0; gg < NG; ++gg) { const int g = g0 + gg, ai = g >> 2, m = g & 3; if (g >= 8) continue;
                const int row = u.pm * BM + ai * HALF + wr * 64 + m * 16 + fr;
                float ss = 0.f;
#pragma unroll
                for (int bj = 0; bj < 2; ++bj) {
                    const size_t off = (size_t)row * 1024 + colb + bj * HALF;
                    f32x4 r0, r1;
                    if constexpr (XF32) { r0 = pre[gg][bj][0]; r1 = pre[gg][bj][XF32 ? 1 : 0]; }
                    else { const u32x4 h = __builtin_bit_cast(u32x4, pre[gg][bj][0]); r0 = (f32x4){f16lo(h.x), f16hi(h.x), f16lo(h.y), f16hi(h.y)}; r1 = (f32x4){f16lo(h.z), f16hi(h.z), f16lo(h.w), f16hi(h.w)}; }
                    const f32x4 x0 = r0 + gv[bj][0] * acc[ai][bj][m][0], x1 = r1 + gv[bj][1] * acc[ai][bj][m][1];
                    { u32x4 hx; hx.x = pk_f16(x0[0], x0[1]); hx.y = pk_f16(x0[2], x0[3]); hx.z = pk_f16(x1[0], x1[1]); hx.w = pk_f16(x1[2], x1[3]); PG8_ST(u32x4, xout + off, hx); }
                    ss += (x0[0] * x0[0] + x0[1] * x0[1]) + (x0[2] * x0[2] + x0[3] * x0[3]) + (x1[0] * x1[0] + x1[1] * x1[1]) + (x1[2] * x1[2] + x1[3] * x1[3]);
                    if (nw) { const f32x4 a0 = x0 * wm[bj][0], a1 = x1 * wm[bj][1]; u32x4 w; w.x = cvt_pk_bf16(a0[0], a0[1]); w.y = cvt_pk_bf16(a0[2], a0[3]); w.z = cvt_pk_bf16(a1[0], a1[1]); w.w = cvt_pk_bf16(a1[2], a1[3]);
                        PG8_ST(u32x4, anext + (size_t)row * (apitch ? apitch : 1024) + colb + bj * HALF, w); }
                }
                ss += __shfl_xor(ss, 16); ss += __shfl_xor(ss, 32);
                if (fq == 0) atomicAdd(ssum + row, ss);
            }
            asm volatile("" ::: "memory");
        }
    }
};

struct EpiFinal {
    static constexpr bool PERM = true, AFTER_DRAIN = true, STAGED = false; static constexpr int NSTORE = 0;
    const bf16_t* xres; float* out; const float* gvec; const float* fw; float* ssum; const XcdBarrier* bar;
    __device__ __forceinline__ void fused(f32x4 (&acc)[2][2][4][2], const Unit& u, int wr, int wc, int fr_in, int fq_in, PG8_LAS unsigned char* lds, int wid, int lane) const {
        int fr = fr_in, fq = fq_in; asm volatile("" : "+v"(fr), "+v"(fq));
        const int b = u.pm >> 3;
        const int colb = u.pn * BM + wc * 32 + 8 * fq;
        {
            f32x4 gv[2][2];
#pragma unroll
            for (int bj = 0; bj < 2; ++bj)
#pragma unroll
                for (int n = 0; n < 2; ++n) gv[bj][n] = *(const f32x4*)(gvec + (size_t)b * 6144 + colb + bj * HALF + 4 * n);
#pragma unroll
            for (int ai = 0; ai < 2; ++ai) {
                u32x4 pre[4][2];
#pragma unroll
                for (int m = 0; m < 4; ++m)
#pragma unroll
                    for (int bj = 0; bj < 2; ++bj) pre[m][bj] = *(const u32x4*)(xres + (size_t)(u.pm * BM + ai * HALF + wr * 64 + m * 16 + fr) * 1024 + colb + bj * HALF);
#pragma unroll
                for (int m = 0; m < 4; ++m) {
                    const int row = u.pm * BM + ai * HALF + wr * 64 + m * 16 + fr;
                    float ss = 0.f;
#pragma unroll
                    for (int bj = 0; bj < 2; ++bj) {
                        const u32x4 h = pre[m][bj];
                        const f32x4 r0 = (f32x4){f16lo(h.x), f16hi(h.x), f16lo(h.y), f16hi(h.y)}, r1 = (f32x4){f16lo(h.z), f16hi(h.z), f16lo(h.w), f16hi(h.w)};
                        const f32x4 x0 = r0 + gv[bj][0] * acc[ai][bj][m][0], x1 = r1 + gv[bj][1] * acc[ai][bj][m][1];
                        acc[ai][bj][m][0] = x0; acc[ai][bj][m][1] = x1;
                        ss += (x0[0] * x0[0] + x0[1] * x0[1]) + (x0[2] * x0[2] + x0[3] * x0[3]) + (x1[0] * x1[0] + x1[1] * x1[1]) + (x1[2] * x1[2] + x1[3] * x1[3]);
                    }
                    ss += __shfl_xor(ss, 16); ss += __shfl_xor(ss, 32);
                    if (fq == 0) atomicAdd(ssum + row, ss);
                }
                asm volatile("" ::: "memory");
            }
        }
        xcd_barrier(*bar);
        f32x4 fv[2][2];
#pragma unroll
        for (int bj = 0; bj < 2; ++bj)
#pragma unroll
            for (int n = 0; n < 2; ++n) fv[bj][n] = *(const f32x4*)(fw + colb + bj * HALF + 4 * n);
        float sq[2][4];
#pragma unroll
        for (int ai = 0; ai < 2; ++ai)
#pragma unroll
            for (int m = 0; m < 4; ++m) sq[ai][m] = __hip_atomic_load(ssum + u.pm * BM + ai * HALF + wr * 64 + m * 16 + fr, __ATOMIC_RELAXED, __HIP_MEMORY_SCOPE_AGENT);
#pragma unroll
        for (int ai = 0; ai < 2; ++ai)
#pragma unroll
            for (int m = 0; m < 4; ++m) {
                const int row = u.pm * BM + ai * HALF + wr * 64 + m * 16 + fr;
                const float rs = __builtin_amdgcn_rsqf(sq[ai][m] * (1.f / 1024.f) + K_EPS);
#pragma unroll
                for (int bj = 0; bj < 2; ++bj) {
                    const size_t off = (size_t)row * 1024 + colb + bj * HALF;
                    *(f32x4*)(out + off) = acc[ai][bj][m][0] * rs * fv[bj][0]; *(f32x4*)(out + off + 4) = acc[ai][bj][m][1] * rs * fv[bj][1];
                }
            }
    }
};

struct EpiFfn {
    static constexpr bool PERM = true, AFTER_DRAIN = false, STAGED = true; static constexpr int NSTORE = 8;
    bf16_t* act; const float* ssum; const float* shw;
    PG8_LAS unsigned char* stage;
    __device__ __forceinline__ void prefetch(const Unit& u, int ui, int wid, int lane) const {
        const float* src = wid < 4 ? ssum + u.pm * BM + 64 * wid + lane : shw + (size_t)(u.pm >> 3) * 5632 + u.pn * BM + 64 * (wid - 4) + lane;
        __builtin_amdgcn_global_load_lds((const unsigned*)src, (PG8_LAS unsigned*)(stage + (ui & 1) * 2048 + wid * 256), 4, 0, 0);
    }
    __device__ __forceinline__ void operator()(const f32x4 (&acc)[2][2][4][2], const Unit& u, int wr, int wc, int fr_in, int fq_in, int ui, bool dry = false) const {
        int fr = fr_in, fq = fq_in; asm volatile("" : "+v"(fr), "+v"(fq));
        const int cl = wc * 32 + 8 * fq;
        const PG8_LAS float* SS = (const PG8_LAS float*)(stage + (ui & 1) * 2048); const PG8_LAS float* SV = SS + 256;
        f32x2 sg[4], sgn[4], su[4];
#pragma unroll
        for (int n = 0; n < 2; ++n) { const f32x4 a = *(const PG8_LAS f32x4*)(SV + cl + 4 * n), c = *(const PG8_LAS f32x4*)(SV + HALF + cl + 4 * n);
            sg[2 * n] = (f32x2){a[0], a[1]}; sg[2 * n + 1] = (f32x2){a[2], a[3]}; su[2 * n] = (f32x2){c[0], c[1]}; su[2 * n + 1] = (f32x2){c[2], c[3]}; }
#pragma unroll
        for (int q = 0; q < 4; ++q) sgn[q] = sg[q] * (-1.44269504089f);
#pragma unroll
        for (int ai = 0; ai < 2; ++ai)
#pragma unroll
            for (int m = 0; m < 4; ++m) {
                const int row = u.pm * BM + ai * HALF + wr * 64 + m * 16 + fr;
                const float rs = __builtin_amdgcn_rsqf(SS[ai * HALF + wr * 64 + m * 16 + fr] * (1.f / 1024.f) + K_EPS), nrs = rs * (-1.44269504089f);
                unsigned wv[4];
#pragma unroll
                for (int q = 0; q < 4; ++q) {
                    const f32x4 ag4 = acc[ai][0][m][q >> 1], au4 = acc[ai][1][m][q >> 1];
                    const f32x2 ag = (q & 1) ? (f32x2){ag4[2], ag4[3]} : (f32x2){ag4[0], ag4[1]}, au = (q & 1) ? (f32x2){au4[2], au4[3]} : (f32x2){au4[0], au4[1]};
                    const f32x2 g = ag * rs + sg[q], gn = ag * nrs + sgn[q], uu = au * rs + su[q];
                    f32x2 e; e.x = __builtin_amdgcn_exp2f(gn.x); e.y = __builtin_amdgcn_exp2f(gn.y);
                    const f32x2 d = e + 1.0f;
                    f32x2 r; r.x = __builtin_amdgcn_rcpf(d.x); r.y = __builtin_amdgcn_rcpf(d.y);
                    const f32x2 o = (g * uu) * r;
                    wv[q] = cvt_pk_bf16(o.x, o.y);
                }
                u32x4 w; w.x = wv[0]; w.y = wv[1]; w.z = wv[2]; w.w = wv[3];
                PG8_ST(u32x4, act + (size_t)row * 2816 + u.pn * HALF + cl, w);
            }
    }
    __device__ __forceinline__ void half_epi(const f32x4 (&acc)[2][4][2], const Unit& u, int half, int wr, int wc, int fr_in, int fq_in, int ui) const {
        int fr = fr_in, fq = fq_in; asm volatile("" : "+v"(fr), "+v"(fq));
        const int cl = wc * 32 + 8 * fq;
        const PG8_LAS float* SS = (const PG8_LAS float*)(stage + (ui & 1) * 2048); const PG8_LAS float* SV = SS + 256;
        f32x2 sg[4], sgn[4], su[4];
#pragma unroll
        for (int n = 0; n < 2; ++n) { const f32x4 a = *(const PG8_LAS f32x4*)(SV + cl + 4 * n), c = *(const PG8_LAS f32x4*)(SV + HALF + cl + 4 * n);
            sg[2 * n] = (f32x2){a[0], a[1]}; sg[2 * n + 1] = (f32x2){a[2], a[3]}; su[2 * n] = (f32x2){c[0], c[1]}; su[2 * n + 1] = (f32x2){c[2], c[3]}; }
#pragma unroll
        for (int q = 0; q < 4; ++q) sgn[q] = sg[q] * (-1.44269504089f);
#pragma unroll
        for (int m = 0; m < 4; ++m) {
            const int rl = half * HALF + wr * 64 + m * 16 + fr, row = u.pm * BM + rl;
            const float rs = __builtin_amdgcn_rsqf(SS[rl] * (1.f / 1024.f) + K_EPS), nrs = rs * (-1.44269504089f);
            unsigned wv[4];
#pragma unroll
            for (int q = 0; q < 4; ++q) {
                const f32x4 ag4 = acc[0][m][q >> 1], au4 = acc[1][m][q >> 1];
                const f32x2 ag = (q & 1) ? (f32x2){ag4[2], ag4[3]} : (f32x2){ag4[0], ag4[1]}, au = (q & 1) ? (f32x2){au4[2], au4[3]} : (f32x2){au4[0], au4[1]};
                const f32x2 g = ag * rs + sg[q], gn = ag * nrs + sgn[q], uu = au * rs + su[q];
                f32x2 e; e.x = __builtin_amdgcn_exp2f(gn.x); e.y = __builtin_amdgcn_exp2f(gn.y);
                const f32x2 d = e + 1.0f;
                f32x2 r; r.x = __builtin_amdgcn_rcpf(d.x); r.y = __builtin_amdgcn_rcpf(d.y);
                const f32x2 o = (g * uu) * r;
                wv[q] = cvt_pk_bf16(o.x, o.y);
            }
            u32x4 w; w.x = wv[0]; w.y = wv[1]; w.z = wv[2]; w.w = wv[3];
            *(u32x4*)(act + (size_t)row * 2816 + u.pn * HALF + cl) = w;
        }
    }
};


template <class Epi, class Sched, bool ALIGN_EPI = false, bool SP2 = false>
__device__ __forceinline__ void gemm_phase(PG8_LAS unsigned char* lds, const Gemm g, const Sched& S, const Epi& E) {
    int tid_l = threadIdx.x; asm volatile("" : "+v"(tid_l));
    const int tid = tid_l, wid = __builtin_amdgcn_readfirstlane(tid >> 6), lane = tid & 63, wr = wid >> 2, wc = wid & 3, fr = lane & 15, fq = lane >> 4;
    const int K = g.K, nt = K / BK;
#define PG8_TW(t) (t)
    const int LDA = g.lda ? g.lda : g.K;
    unsigned voffA[2], voffB[2];
#pragma unroll
    for (int i = 0; i < 2; ++i) { int R, C; stage_rc(tid * 16 + i * 8192, R, C); const int Rb = Epi::PERM ? ((R & ~31) + perm32(R & 31)) : R;
        voffA[i] = (unsigned)(R * LDA + C) * 2u; voffB[i] = (unsigned)(Rb * K + C) * 2u; }
    const size_t kstep = (size_t)(BK * 2);
    const size_t hstep = (size_t)HALF * K * 2;
    const size_t tstep = 2 * hstep;
    const size_t hstepA = (size_t)HALF * LDA * 2, tstepA = 2 * hstepA;
    const unsigned ldsw = (unsigned)wid * 1024u;
    const int aoff = lds_byte(wr * 64 + fr, fq * 8), boff = lds_byte(wc * 32 + fr, fq * 8);
#define PG8_SA(b, h) (((b) * 2 + (h)) * HTB)
#define PG8_SB(b, h) ((4 + (b) * 2 + (h)) * HTB)
#define PG8_STAGE(bufoff, gbase, voff) do { _Pragma("unroll") for (int _i = 0; _i < 2; ++_i) \
        __builtin_amdgcn_global_load_lds((const unsigned*)((const char*)(gbase) + (voff)[_i]), (PG8_LAS unsigned*)(lds + (bufoff) + ldsw + _i * 8192), 16, 0, 0); } while (0)
#define PG8_LDA(dst, b, h) do { _Pragma("unroll") for (int m = 0; m < 4; ++m) _Pragma("unroll") for (int k = 0; k < 2; ++k) dst[m][k] = *(const PG8_LAS bf16x8*)(lds + PG8_SA(b, h) + aoff + m * 2048 + k * 1024); } while (0)
#define PG8_LDB(dst, b, h) do { _Pragma("unroll") for (int n = 0; n < 2; ++n) _Pragma("unroll") for (int k = 0; k < 2; ++k) dst[n][k] = *(const PG8_LAS bf16x8*)(lds + PG8_SB(b, h) + boff + n * 2048 + k * 1024); } while (0)
#define PG8_MMA(ai, bj, At, Bt) do { __builtin_amdgcn_s_setprio(1); _Pragma("unroll") for (int m = 0; m < 4; ++m) _Pragma("unroll") for (int n = 0; n < 2; ++n) _Pragma("unroll") for (int k = 0; k < 2; ++k) \
        acc[ai][bj][m][n] = __builtin_amdgcn_mfma_f32_16x16x32_bf16(Bt[n][k], At[m][k], acc[ai][bj][m][n], 0, 0, 0); __builtin_amdgcn_s_setprio(0); } while (0)
#define PG8_WAIT_V(n) asm volatile("s_waitcnt vmcnt(" #n ")" ::: "memory")
#define PG8_WAIT_L(n) asm volatile("s_waitcnt lgkmcnt(" #n ")" ::: "memory")
#define PG8_BAR __builtin_amdgcn_s_barrier()
#define PG8_SCHED __builtin_amdgcn_sched_barrier(0)
    Unit cur, nxt; int ui = 0;
    if (!S.next(0, cur)) return;
    f32x4 acc[2][2][4][2];
#pragma unroll
    for (int a = 0; a < 2; ++a)
#pragma unroll
        for (int b = 0; b < 2; ++b)
#pragma unroll
            for (int m = 0; m < 4; ++m)
#pragma unroll
                for (int n = 0; n < 2; ++n) acc[a][b][m][n] = (f32x4){0.f, 0.f, 0.f, 0.f};
    bf16x8 At[4][2], B0[2][2], B1[2][2];
    const char* cA = (const char*)g.A + (size_t)cur.pm * tstepA; const char* cB = (const char*)g.Bt + (size_t)cur.pn * tstep;
    S.a_ready(cur);
    if constexpr (SP2) {
        PG8_STAGE(PG8_SB(0, 0), cB, voffB); PG8_STAGE(PG8_SB(0, 1), cB + hstep, voffB); PG8_STAGE(PG8_SA(0, 0), cA, voffA); PG8_STAGE(PG8_SA(0, 1), cA + hstepA, voffA);
        if (wr == 1) PG8_BAR;
        PG8_WAIT_V(2); PG8_BAR;
        PG8_STAGE(PG8_SB(1, 0), cB + kstep, voffB); PG8_STAGE(PG8_SA(1, 0), cA + kstep, voffA); PG8_STAGE(PG8_SB(1, 1), cB + hstep + kstep, voffB);
        PG8_WAIT_V(6); PG8_BAR;
    } else {
        PG8_STAGE(PG8_SB(0, 0), cB, voffB); PG8_STAGE(PG8_SA(0, 0), cA, voffA); PG8_STAGE(PG8_SB(0, 1), cB + hstep, voffB); PG8_STAGE(PG8_SA(0, 1), cA + hstepA, voffA);
        if (wr == 1) PG8_BAR;
        PG8_WAIT_V(4); PG8_BAR;
        PG8_STAGE(PG8_SB(1, 0), cB + kstep, voffB); PG8_STAGE(PG8_SA(1, 0), cA + kstep, voffA); PG8_STAGE(PG8_SB(1, 1), cB + hstep + kstep, voffB);
        PG8_WAIT_V(6); PG8_BAR;
    }
    for (;;) {
        const bool has_next = S.next(ui + 1, nxt);
        const char* nA = has_next ? (const char*)g.A + (size_t)nxt.pm * tstepA : cA; const char* nB = has_next ? (const char*)g.Bt + (size_t)nxt.pn * tstep : cB;
        if constexpr (Sched::HAS_TAIL) { if (!has_next && S.tA) { nA = S.tA; nB = S.tB; } }
        if constexpr (Epi::STAGED) E.prefetch(cur, ui, wid, lane);
        for (int t = 0; t < nt; t += 2) {
            const bool last = (t == nt - 2);
            const char* a1 = cA + (size_t)PG8_TW(t + 1) * kstep;
            const char* a2 = last ? nA : cA + (size_t)PG8_TW(t + 2) * kstep; const char* b2 = last ? nB : cB + (size_t)PG8_TW(t + 2) * kstep;
            const char* a3 = a2 + kstep; const char* b3 = b2 + kstep;
            if (last && has_next) S.a_ready(nxt);
            if constexpr (SP2) {
            PG8_LDB(B0, 0, 0); PG8_LDB(B1, 0, 1); PG8_SCHED; PG8_LDA(At, 0, 0); PG8_STAGE(PG8_SA(1, 1), a1 + hstepA, voffA);
            PG8_WAIT_V(8); PG8_WAIT_L(0); PG8_BAR; PG8_MMA(0, 0, At, B0); PG8_MMA(0, 1, At, B1); PG8_BAR; PG8_SCHED;
            PG8_LDA(At, 0, 1); PG8_STAGE(PG8_SB(0, 0), b2, voffB); PG8_STAGE(PG8_SB(0, 1), b2 + hstep, voffB); PG8_STAGE(PG8_SA(0, 0), a2, voffA);
            PG8_WAIT_V(8); PG8_WAIT_L(0); PG8_BAR; PG8_MMA(1, 0, At, B0); PG8_MMA(1, 1, At, B1); PG8_BAR; PG8_SCHED;
            PG8_LDB(B0, 1, 0); PG8_LDB(B1, 1, 1); PG8_SCHED; PG8_LDA(At, 1, 0); PG8_STAGE(PG8_SA(0, 1), a2 + hstepA, voffA);
            PG8_WAIT_V(8); PG8_WAIT_L(0); PG8_BAR; PG8_MMA(0, 0, At, B0); PG8_MMA(0, 1, At, B1); PG8_BAR; PG8_SCHED;
            PG8_LDA(At, 1, 1); PG8_STAGE(PG8_SB(1, 0), b3, voffB); PG8_STAGE(PG8_SB(1, 1), b3 + hstep, voffB); PG8_STAGE(PG8_SA(1, 0), a3, voffA);
            PG8_WAIT_V(8); PG8_WAIT_L(0); PG8_BAR; PG8_MMA(1, 0, At, B0); PG8_MMA(1, 1, At, B1); PG8_BAR; PG8_SCHED;
            } else {
            PG8_LDB(B0, 0, 0); PG8_SCHED; PG8_LDA(At, 0, 0); PG8_STAGE(PG8_SA(1, 1), a1 + hstepA, voffA);
            PG8_WAIT_L(8); PG8_BAR; PG8_WAIT_L(0); PG8_MMA(0, 0, At, B0); PG8_BAR; PG8_SCHED;
            PG8_LDB(B1, 0, 1); PG8_STAGE(PG8_SB(0, 0), b2, voffB);
            PG8_BAR; PG8_WAIT_L(0); PG8_MMA(0, 1, At, B1); PG8_BAR;
            PG8_LDA(At, 0, 1); PG8_STAGE(PG8_SA(0, 0), a2, voffA);
            PG8_BAR; PG8_WAIT_L(0); PG8_MMA(1, 0, At, B0); PG8_BAR; PG8_SCHED;
            PG8_STAGE(PG8_SB(0, 1), b2 + hstep, voffB);
            PG8_WAIT_V(6); PG8_BAR; PG8_MMA(1, 1, At, B1); PG8_BAR;
            PG8_LDB(B0, 1, 0); PG8_SCHED; PG8_LDA(At, 1, 0); PG8_STAGE(PG8_SA(0, 1), a2 + hstepA, voffA);
            PG8_WAIT_L(8); PG8_BAR; PG8_WAIT_L(0); PG8_MMA(0, 0, At, B0); PG8_BAR; PG8_SCHED;
            PG8_LDB(B1, 1, 1); PG8_STAGE(PG8_SB(1, 0), b3, voffB);
            PG8_BAR; PG8_WAIT_L(0); PG8_MMA(0, 1, At, B1); PG8_BAR;
            PG8_LDA(At, 1, 1); PG8_STAGE(PG8_SA(1, 0), a3, voffA);
            PG8_BAR; PG8_WAIT_L(0); PG8_MMA(1, 0, At, B0); PG8_BAR; PG8_SCHED;
            PG8_STAGE(PG8_SB(1, 1), b3 + hstep, voffB);
            PG8_WAIT_V(6); PG8_BAR; PG8_MMA(1, 1, At, B1); PG8_BAR;
            }
        }
        if constexpr (ALIGN_EPI) { if (wr == 0) PG8_BAR; }
        if constexpr (!Epi::AFTER_DRAIN) { if constexpr (Epi::STAGED) E(acc, cur, wr, wc, fr, fq, ui); else E(acc, cur, wr, wc, fr, fq); S.done(cur); }
        if (!has_next) break;
#pragma unroll
        for (int a = 0; a < 2; ++a)
#pragma unroll
            for (int b = 0; b < 2; ++b)
#pragma unroll
                for (int m = 0; m < 4; ++m)
#pragma unroll
                    for (int n = 0; n < 2; ++n) acc[a][b][m][n] = (f32x4){0.f, 0.f, 0.f, 0.f};
        cur = nxt; cA = nA; cB = nB; ++ui;
        if constexpr (ALIGN_EPI) { if (wr == 1) PG8_BAR; }
    }
    PG8_WAIT_V(0);
    if constexpr (!ALIGN_EPI) { if (wr == 0) PG8_BAR; }
    PG8_BAR;
    if constexpr (Epi::AFTER_DRAIN) { E.fused(acc, cur, wr, wc, fr, fq, lds, wid, lane); S.done(cur); }
#undef PG8_SA
#undef PG8_SB
#undef PG8_STAGE
#undef PG8_LDA
#undef PG8_LDB
#undef PG8_MMA
#undef PG8_WAIT_V
#undef PG8_WAIT_L
#undef PG8_BAR
#undef PG8_SCHED
}
template <class Epi, bool WARM = false>
__device__ __forceinline__ void gemm_half_unit(PG8_LAS unsigned char* lds, const Gemm g, const Unit u, const int half, const Epi& E, const int ui) {
    int tid_l = threadIdx.x; asm volatile("" : "+v"(tid_l));
    const int tid = tid_l, wid = __builtin_amdgcn_readfirstlane(tid >> 6), lane = tid & 63, wr = wid >> 2, wc = wid & 3, fr = lane & 15, fq = lane >> 4;
    const int K = g.K, nt = K / BK, LDA = g.lda ? g.lda : g.K;
    unsigned voffA[2], voffB[2];
#pragma unroll
    for (int i = 0; i < 2; ++i) { int R, C; stage_rc(tid * 16 + i * 8192, R, C); const int Rb = Epi::PERM ? ((R & ~31) + perm32(R & 31)) : R;
        voffA[i] = (unsigned)(R * LDA + C) * 2u; voffB[i] = (unsigned)(Rb * K + C) * 2u; }
    const size_t kstep = (size_t)(BK * 2), hstep = (size_t)HALF * K * 2, tstep = 2 * hstep, hstepA = (size_t)HALF * LDA * 2, tstepA = 2 * hstepA;
    const unsigned ldsw = (unsigned)wid * 1024u;
    const int aoff = lds_byte(wr * 64 + fr, fq * 8), boff = lds_byte(wc * 32 + fr, fq * 8);
#define PGH_A(q) (WARM ? (int)((0x120u >> (4 * (q))) & 15u) * HTB : (q) * 3 * HTB)
#define PGH_B(q, h) (WARM ? (int)((((h) ? 0x875u : 0x364u) >> (4 * (q))) & 15u) * HTB : (q) * 3 * HTB + (1 + (h)) * HTB)
#define PGH_STAGE(bufoff, gbase, voff) do { _Pragma("unroll") for (int _i = 0; _i < 2; ++_i) \
        __builtin_amdgcn_global_load_lds((const unsigned*)((const char*)(gbase) + (voff)[_i]), (PG8_LAS unsigned*)(lds + (bufoff) + ldsw + _i * 8192), 16, 0, 0); } while (0)
#define PGH_TILE(q, kt) do { PGH_STAGE(PGH_B(q, 0), cB + (size_t)(kt) * kstep, voffB); PGH_STAGE(PGH_B(q, 1), cB + hstep + (size_t)(kt) * kstep, voffB); PGH_STAGE(PGH_A(q), cA + (size_t)(kt) * kstep, voffA); } while (0)
#define PGH_LDA(dst, off) do { _Pragma("unroll") for (int m = 0; m < 4; ++m) _Pragma("unroll") for (int k = 0; k < 2; ++k) dst[m][k] = *(const PG8_LAS bf16x8*)(lds + (off) + aoff + m * 2048 + k * 1024); } while (0)
#define PGH_LDB(dst, off) do { _Pragma("unroll") for (int n = 0; n < 2; ++n) _Pragma("unroll") for (int k = 0; k < 2; ++k) dst[n][k] = *(const PG8_LAS bf16x8*)(lds + (off) + boff + n * 2048 + k * 1024); } while (0)
#define PGH_MMA(bj, At, Bt) do { __builtin_amdgcn_s_setprio(1); _Pragma("unroll") for (int m = 0; m < 4; ++m) _Pragma("unroll") for (int n = 0; n < 2; ++n) _Pragma("unroll") for (int k = 0; k < 2; ++k) \
        acc[bj][m][n] = __builtin_amdgcn_mfma_f32_16x16x32_bf16(Bt[n][k], At[m][k], acc[bj][m][n], 0, 0, 0); __builtin_amdgcn_s_setprio(0); } while (0)
    f32x4 acc[2][4][2];
#pragma unroll
    for (int b = 0; b < 2; ++b)
#pragma unroll
        for (int m = 0; m < 4; ++m)
#pragma unroll
            for (int n = 0; n < 2; ++n) acc[b][m][n] = (f32x4){0.f, 0.f, 0.f, 0.f};
    bf16x8 At[4][2], B0[2][2], B1[2][2];
    const char* cA = (const char*)g.A + (size_t)u.pm * tstepA + (size_t)half * hstepA; const char* cB = (const char*)g.Bt + (size_t)u.pn * tstep;
    E.prefetch(u, ui, wid, lane);
    if constexpr (!WARM) { PGH_TILE(0, 0); PGH_TILE(1, 1); }
    if (wr == 1) __builtin_amdgcn_s_barrier();
    if constexpr (!WARM) {
        asm volatile("s_waitcnt vmcnt(6)" ::: "memory");
        __builtin_amdgcn_s_barrier(); __builtin_amdgcn_s_barrier();
    }
    for (int t = 0; t < nt; ++t) {
        const int q = t % 3, q2 = (t + 2) % 3;
        PGH_LDB(B0, PGH_B(q, 0)); PGH_LDB(B1, PGH_B(q, 1)); __builtin_amdgcn_sched_barrier(0); PGH_LDA(At, PGH_A(q));
        if (t + 2 < nt) { PGH_TILE(q2, t + 2); asm volatile("s_waitcnt vmcnt(6)" ::: "memory"); } else { asm volatile("s_waitcnt vmcnt(0)" ::: "memory"); }
        asm volatile("s_waitcnt lgkmcnt(0)" ::: "memory"); __builtin_amdgcn_s_barrier();
        PGH_MMA(0, At, B0); PGH_MMA(1, At, B1);
        __builtin_amdgcn_s_barrier(); __builtin_amdgcn_sched_barrier(0);
    }
    if (wr == 0) __builtin_amdgcn_s_barrier();
    E.half_epi(acc, u, half, wr, wc, fr, fq, ui);
#undef PGH_A
#undef PGH_B
#undef PGH_STAGE
#undef PGH_TILE
#undef PGH_LDA
#undef PGH_LDB
#undef PGH_MMA
}
}


constexpr int NWAVES = 8;
constexpr int D = 1024, BATCH = 8, SEQ = 2048, DEPTH = 2, M = BATCH * SEQ, INW = 3584, DFF = 2816, NMOD = 6, NCH = SEQ / 64;
constexpr float EPS = 1e-6f;
#ifndef CTL_MEMSET_MIB
#define CTL_MEMSET_MIB 1
#endif
constexpr size_t MiB = 1u << 20, KiB = 1u << 10;
constexpr size_t WS_CTL = 0, CTL_ZERO_BYTES = CTL_MEMSET_MIB * MiB;
constexpr size_t CTL_REGION = CTL_ZERO_BYTES;
constexpr size_t WS_MOD = 64 * KiB;
constexpr size_t WS_SSUM = 448 * KiB;
constexpr size_t WS_TAB = 1 * MiB;
constexpr size_t WS_SHW1 = WS_TAB + 512 * KiB;
constexpr size_t WS_SHW2 = WS_SHW1 + 2 * 8 * 3584 * 4;
constexpr size_t WS_BL = 3 * MiB;
constexpr size_t WS_W = 4 * MiB;
constexpr size_t W_IN_OFF = 0, W_OUT_OFF = (size_t)INW * D * 2, W_GU_OFF = W_OUT_OFF + (size_t)D * D * 2, W_DN_OFF = W_GU_OFF + (size_t)2 * DFF * D * 2, W_LAYER = W_DN_OFF + (size_t)DFF * D * 2;
constexpr size_t WS_A = 56 * MiB;
constexpr size_t WS_PROJ = 88 * MiB;
constexpr size_t WS_URET = 200 * MiB;
constexpr size_t WS_UHG = 216 * MiB;
constexpr size_t WS_A2 = 200 * MiB;
constexpr size_t WS_END = 248 * MiB;
static_assert(WS_SHW2 + 2 * 8 * 5632 * 4 <= WS_BL && WS_W + 2 * W_LAYER <= WS_A && WS_A + (size_t)M * D * 2 <= WS_PROJ && WS_PROJ + (size_t)M * INW * 2 <= WS_URET, "d_ws map");
static_assert(WS_MOD + 2 * 8 * 6144 * 4 <= WS_SSUM && WS_SSUM + 5 * M * 4 <= CTL_REGION, "ctl map");
constexpr int CW_BAR = 4096;
static_assert((CW_BAR + 3456) * 4 <= CTL_ZERO_BYTES, "barrier words inside the per-call memset");
constexpr int RING_BYTES = 131072;
constexpr int MISC_BASE = 147456;
constexpr int LDS_BYTES = 163840;
constexpr int LDSCTL_OFF = MISC_BASE, MISC_OFF = LDSCTL_OFF + 320;
constexpr int STAGE_OFF = MISC_BASE + 4096;

#define GAS __attribute__((address_space(1)))
#define LAS __attribute__((address_space(3)))
typedef unsigned short bf16;
typedef unsigned v4u __attribute__((ext_vector_type(4)));
typedef unsigned v2u __attribute__((ext_vector_type(2)));
typedef float f32x4 __attribute__((ext_vector_type(4)));
typedef short bf16x8 __attribute__((ext_vector_type(8)));
typedef GAS unsigned gu32;
#define RLX_AGENT __ATOMIC_RELAXED, __HIP_MEMORY_SCOPE_AGENT
#define LDS_WAIT() asm volatile("s_waitcnt lgkmcnt(0)" ::: "memory")
#define LD_LAST(p) (*(p))
#define LD_ONCE(p) __builtin_nontemporal_load(p)
typedef float f32x2_t __attribute__((ext_vector_type(2)));
typedef __bf16 bf16x2_t __attribute__((ext_vector_type(2)));
__device__ __forceinline__ unsigned pk2(float lo, float hi) { const f32x2_t v = {lo, hi}; const bf16x2_t b = __builtin_convertvector(v, bf16x2_t); return __builtin_bit_cast(unsigned, b); }
__device__ __forceinline__ unsigned f2bf(float f) { return (unsigned)__builtin_bit_cast(unsigned short, (__bf16)f); }
__device__ __forceinline__ float bf2f(unsigned short u) { return __builtin_bit_cast(float, (unsigned)u << 16); }
__device__ __forceinline__ float h2f(unsigned short u) { return (float)__builtin_bit_cast(_Float16, u); }
__device__ __forceinline__ float dpp_f(float v, int ctrl_sel) {
    const int x = __builtin_bit_cast(int, v);
    int r;
    if (ctrl_sel == 0) r = __builtin_amdgcn_mov_dpp(x, 0xB1, 0xF, 0xF, true);
    else if (ctrl_sel == 1) r = __builtin_amdgcn_mov_dpp(x, 0x4E, 0xF, 0xF, true);
    else if (ctrl_sel == 2) r = __builtin_amdgcn_mov_dpp(x, 0x141, 0xF, 0xF, true);
    else r = __builtin_amdgcn_mov_dpp(x, 0x140, 0xF, 0xF, true);
    return __builtin_bit_cast(float, r);
}
__device__ __forceinline__ float row16_sum(float v) { v += dpp_f(v, 0); v += dpp_f(v, 1); v += dpp_f(v, 2); v += dpp_f(v, 3); return v; }
__device__ __forceinline__ float wave_sum(float v) {
    v = row16_sum(v);
    const int x = __builtin_bit_cast(int, v);
    return __builtin_bit_cast(float, __builtin_amdgcn_readlane(x, 0)) + __builtin_bit_cast(float, __builtin_amdgcn_readlane(x, 16))
         + __builtin_bit_cast(float, __builtin_amdgcn_readlane(x, 32)) + __builtin_bit_cast(float, __builtin_amdgcn_readlane(x, 48));
}


__device__ __forceinline__ f32x4 mfma16(bf16x8 a, bf16x8 b, f32x4 c) { return __builtin_amdgcn_mfma_f32_16x16x32_bf16(a, b, c, 0, 0, 0); }

struct TrItem { const float* W; bf16* WT; int K, N, item, mode; };
__device__ __forceinline__ void transpose_load(f32x4 (&v)[8], const TrItem& t, int lane) {
    const int nblk = t.N / 32, kb = t.item / nblk, nb = t.item % nblk, k0 = 64 * kb, n0 = 32 * nb;
    const float* src = t.W + (size_t)(k0 + (lane >> 3)) * t.N + n0 + (lane & 7) * 4;
#pragma unroll
    for (int i = 0; i < 8; ++i) v[i] = LD_ONCE((const f32x4*)(src + (size_t)(8 * i) * t.N));
}
__device__ __forceinline__ void transpose_store(const f32x4 (&v)[8], const TrItem& t, LAS float* scr, int lane) {
    const int nblk = t.N / 32, kb = t.item / nblk, nb = t.item % nblk, k0 = 64 * kb, n0 = 32 * nb;
    const int drow = t.mode == 0 ? n0 : (256 * (n0 >> 7) + (n0 & 127) + (t.mode == 2 ? 128 : 0));
#pragma unroll
    for (int i = 0; i < 8; ++i) { LAS float* p = scr + (8 * i + (lane >> 3)) * 33 + (lane & 7) * 4; p[0] = v[i][0]; p[1] = v[i][1]; p[2] = v[i][2]; p[3] = v[i][3]; }
    LDS_WAIT(); asm volatile("" ::: "memory");
    const int c = lane & 7;
#pragma unroll
    for (int j = 0; j < 4; ++j) { const int n = (lane >> 3) + 8 * j; const LAS float* s = scr + (8 * c) * 33 + n;
        v4u o; o.x = pk2(s[0 * 33], s[1 * 33]); o.y = pk2(s[2 * 33], s[3 * 33]); o.z = pk2(s[4 * 33], s[5 * 33]); o.w = pk2(s[6 * 33], s[7 * 33]);
        *(GAS v4u*)(t.WT + (size_t)(drow + n) * t.K + k0 + 8 * c) = o; }
    LDS_WAIT(); asm volatile("" ::: "memory");
}

typedef short v4i16_t __attribute__((ext_vector_type(4)));
__device__ __forceinline__ unsigned off_b(unsigned row, unsigned ch) { return 256u * row + 16u * (ch ^ (((row & 3) << 2) | ((row >> 2) & 3))); }
__device__ __forceinline__ unsigned tr_addr16(unsigned lane, unsigned c, unsigned ks, unsigned t) {
    const unsigned g = lane >> 4, q = (lane & 15) >> 2, p = lane & 3;
    return off_b(32 * ks + 8 * g + 4 * t + q, 2 * c + (p >> 1)) + 8 * (p & 1);
}
__device__ __forceinline__ bf16x8 tr_frag(LAS unsigned char* img, unsigned lane, unsigned c, unsigned ks) {
    const v4i16_t a = __builtin_amdgcn_ds_read_tr16_b64_v4i16((LAS v4i16_t*)(img + tr_addr16(lane, c, ks, 0)));
    const v4i16_t b = __builtin_amdgcn_ds_read_tr16_b64_v4i16((LAS v4i16_t*)(img + tr_addr16(lane, c, ks, 1)));
    return (bf16x8){a[0], a[1], a[2], a[3], b[0], b[1], b[2], b[3]};
}

template <int DK> struct StRegs { v4u k[DK / 64]; v4u v[2]; };
template <int DK, bool RET>
__device__ __forceinline__ void mix_state_load(StRegs<DK>& R, const bf16* proj, int it, int tid) {
    const int b = it >> 7, h = (it >> 5) & 3, c = it & 31;
    const size_t r0 = (size_t)b * 2048 + c * 64;
#pragma unroll
    for (int k = 0; k < 2; ++k) { const bf16* base = proj + (r0 + (tid >> 4) + 32 * k) * 3584 + (tid & 15) * 8 + h * 128;
        R.v[k] = *(const v4u*)(base + (RET ? 512 : 2560));
        if (!RET) R.k[k] = *(const v4u*)(base + 2048); }
    if (RET) R.k[0] = *(const v4u*)(proj + (r0 + (tid >> 3)) * 3584 + 256 + h * 64 + (tid & 7) * 8);
}
template <int DK, bool RET>
__device__ __forceinline__ void mix_state_item(LAS unsigned char* lds, const StRegs<DK>& R, bf16* ST, float* BL, int it, int tid) {
    constexpr int NSEG = 512 / DK, TS = 64 / NSEG;
    const int lane = tid & 63, wave = tid >> 6, d = tid % DK, seg = tid / DK, fr = lane & 15, fq = lane >> 4;
    const int h = (it >> 5) & 3;
    LAS unsigned char* VI = lds; LAS unsigned char* RAW = lds + 16384; LAS unsigned char* KI = lds + 32768; LAS float* TOT = (LAS float*)(lds + 49152);
#pragma unroll
    for (int k = 0; k < 2; ++k) { *(LAS v4u*)(VI + off_b((tid >> 4) + 32 * k, tid & 15)) = R.v[k];
        if (!RET) *(LAS v4u*)(RAW + ((tid >> 4) + 32 * k) * 256 + (tid & 15) * 16) = R.k[k]; }
    if (RET) *(LAS v4u*)(RAW + (tid >> 3) * 128 + (tid & 7) * 16) = R.k[0];
    __syncthreads();
    float kp[TS];
    if (RET) {
        const float lg2 = __log2f(1.f - exp2f(-5.f - (float)h)), gam = 1.f - exp2f(-5.f - (float)h);
        float f = __builtin_amdgcn_exp2f((float)(63 - seg * TS - (TS - 1)) * lg2);
#pragma unroll
        for (int i = TS - 1; i >= 0; --i) { const int t = seg * TS + i; kp[i] = bf2f(*(const LAS unsigned short*)(RAW + t * 128 + d * 2)) * f; f *= gam; }
    } else {
        float g[TS], bs[TS]; float run = 0.f;
#pragma unroll
        for (int i = 0; i < TS; ++i) { g[i] = h2f(*(const LAS unsigned short*)(RAW + (seg * TS + i) * 256 + d * 2)) * 1.44269504089f; run += g[i]; bs[i] = run; }
        TOT[seg * DK + d] = run;
        __syncthreads();
        float pre = 0.f, bl = 0.f;
#pragma unroll
        for (int s2 = 0; s2 < NSEG; ++s2) { const float t = TOT[s2 * DK + d]; bl += t; if (s2 < seg) pre += t; }
#pragma unroll
        for (int i = 0; i < TS; ++i) { const float bb = pre + bs[i]; kp[i] = (1.f - __builtin_amdgcn_exp2f(g[i])) * __builtin_amdgcn_exp2f(bl - bb); }
        if (seg == 0) BL[(size_t)it * 128 + d] = bl;
    }
#pragma unroll
    for (int i = 0; i < TS; i += 2) { const unsigned w = pk2(kp[i], kp[i + 1]);
        *(LAS unsigned short*)(KI + off_b(seg * TS + i, d >> 3) + (d & 7) * 2) = (unsigned short)w; *(LAS unsigned short*)(KI + off_b(seg * TS + i + 1, d >> 3) + (d & 7) * 2) = (unsigned short)(w >> 16); }
    __syncthreads();
    {
        bf16x8 bfr[2];
#pragma unroll
        for (int ks = 0; ks < 2; ++ks) bfr[ks] = tr_frag(VI, lane, wave, ks);
        bf16* dst = ST + (size_t)it * (128 * DK) + (size_t)(16 * wave + fr) * DK + 4 * fq;
#pragma unroll
        for (int dt = 0; dt < DK / 16; ++dt) {
            f32x4 acc = (f32x4){0.f, 0.f, 0.f, 0.f};
#pragma unroll
            for (int ks = 0; ks < 2; ++ks) acc = mfma16(tr_frag(KI, lane, dt, ks), bfr[ks], acc);
            v2u w; w.x = pk2(acc[0], acc[1]); w.y = pk2(acc[2], acc[3]);
            *(v2u*)(dst + 16 * dt) = w;
        }
    }
    __syncthreads();
}

template <int DK> struct OutRegs { v4u q[DK / 64]; v4u g[DK / 64]; v4u v[2]; v4u gate[2]; bf16x8 s[DK / 32]; float nwv; };
template <int DK, bool RET>
__device__ __forceinline__ void mix_out_load(OutRegs<DK>& R, const bf16* proj, const bf16* ST, const float* nw, int it, int tid) {
    const int lane = tid & 63, wave = tid >> 6, fr = lane & 15, fq = lane >> 4;
    const int b = it >> 7, h = (it >> 5) & 3, c = it & 31;
    const size_t r0 = (size_t)b * 2048 + c * 64;
#pragma unroll
    for (int k = 0; k < 2; ++k) { const bf16* base = proj + (r0 + (tid >> 4) + 32 * k) * 3584 + (tid & 15) * 8 + h * 128;
        R.v[k] = LD_LAST((const v4u*)(base + (RET ? 512 : 2560))); R.gate[k] = LD_LAST((const v4u*)(base + (RET ? 1024 : 3072)));
        if (!RET) { R.q[k] = LD_LAST((const v4u*)(base + 1536)); R.g[k] = LD_LAST((const v4u*)(base + 2048)); } }
    if (RET) { const bf16* base = proj + (r0 + (tid >> 3)) * 3584 + h * 64 + (tid & 7) * 8; R.q[0] = LD_LAST((const v4u*)base); R.g[0] = LD_LAST((const v4u*)(base + 256)); }
#pragma unroll
    for (int kd = 0; kd < DK / 32; ++kd) R.s[kd] = *(const bf16x8*)(ST + (size_t)it * (128 * DK) + (size_t)(16 * wave + fr) * DK + 32 * kd + 8 * fq);
    R.nwv = nw[h * 128 + 16 * wave + fr];
}
template <int DK, bool RET>
__device__ __forceinline__ void mix_out_park(LAS unsigned char* lds, const OutRegs<DK>& R, int tid) {
    LAS unsigned char* VI = lds; LAS unsigned char* RAWQ = lds + 16384; LAS unsigned char* RAWG = lds + 32768; LAS float* RED = (LAS float*)(lds + 128000);
#pragma unroll
    for (int k = 0; k < 2; ++k) { *(LAS v4u*)(VI + off_b((tid >> 4) + 32 * k, tid & 15)) = R.v[k];
        if (!RET) { *(LAS v4u*)(RAWQ + ((tid >> 4) + 32 * k) * 256 + (tid & 15) * 16) = R.q[k]; *(LAS v4u*)(RAWG + ((tid >> 4) + 32 * k) * 256 + (tid & 15) * 16) = R.g[k]; } }
    if (RET) { *(LAS v4u*)(RAWQ + (tid >> 3) * 128 + (tid & 7) * 16) = R.q[0]; *(LAS v4u*)(RAWG + (tid >> 3) * 128 + (tid & 7) * 16) = R.g[0]; }
    if (tid < 64) RED[tid] = 0.f;
    __syncthreads();
}
template <int DK, bool RET>
__device__ __forceinline__ void mix_out_item(LAS unsigned char* lds, const v4u (&gate)[2], const bf16x8 (&sfr)[DK / 32], float nwv, bf16* O, int it, int tid) {
    constexpr int NSEG = 512 / DK, TS = 64 / NSEG, PITCH = DK * 2 + 16, KD = DK / 32, RP = DK * 2;
    const int lane = tid & 63, wave = tid >> 6, d = tid % DK, seg = tid / DK, fr = lane & 15, fq = lane >> 4;
    const int b = it >> 7, h = (it >> 5) & 3, c = it & 31;
    const size_t r0 = (size_t)b * 2048 + c * 64;
    LAS unsigned char* VI = lds; LAS unsigned char* RAWQ = lds + 16384; LAS unsigned char* RAWG = lds + 32768;
    LAS unsigned char* QA = lds + 49152; LAS unsigned char* KC = lds + 66560; LAS unsigned char* QB = lds + 83968; LAS unsigned char* P = lds + 101376;
    LAS float* TOT = (LAS float*)(lds + 101376);
    LAS unsigned char* OT = lds + 110592; LAS float* RED = (LAS float*)(lds + 128000);
    {
    float qa[TS], kc[TS], qb[TS];
    if (RET) {
        const float lg2 = __log2f(1.f - exp2f(-5.f - (float)h)), gam = 1.f - exp2f(-5.f - (float)h), eref = __builtin_amdgcn_exp2f(32.f * lg2);
        const int tb = seg * TS;
        float fa = __builtin_amdgcn_exp2f((float)(tb - 31) * lg2), fk = __builtin_amdgcn_exp2f((float)(31 - tb - (TS - 1)) * lg2);
#pragma unroll
        for (int i = 0; i < TS; ++i) { const float q = bf2f(*(const LAS unsigned short*)(RAWQ + (tb + i) * RP + d * 2)); qa[i] = q * fa; qb[i] = qa[i] * eref; fa *= gam; }
#pragma unroll
        for (int i = TS - 1; i >= 0; --i) { kc[i] = bf2f(*(const LAS unsigned short*)(RAWG + (tb + i) * RP + d * 2)) * fk; fk *= gam; }
    } else {
        float g[TS], bs[TS], q[TS]; float run = 0.f;
#pragma unroll
        for (int i = 0; i < TS; ++i) { const int t = seg * TS + i; q[i] = bf2f(*(const LAS unsigned short*)(RAWQ + t * RP + d * 2)); g[i] = h2f(*(const LAS unsigned short*)(RAWG + t * RP + d * 2)) * 1.44269504089f; run += g[i]; bs[i] = run; }
        TOT[seg * DK + d] = run;
        __syncthreads();
        float pre = 0.f, ref = 0.f;
#pragma unroll
        for (int s2 = 0; s2 < NSEG; ++s2) { const float t = TOT[s2 * DK + d]; if (s2 < NSEG / 2) ref += t; if (s2 < seg) pre += t; }
        const float eref = __builtin_amdgcn_exp2f(ref);
#pragma unroll
        for (int i = 0; i < TS; ++i) { const float e1 = __builtin_amdgcn_fmed3f(pre + bs[i] - ref, -115.f, 115.f);
            qa[i] = q[i] * __builtin_amdgcn_exp2f(e1); kc[i] = (1.f - __builtin_amdgcn_exp2f(g[i])) * __builtin_amdgcn_exp2f(-e1); qb[i] = qa[i] * eref; }
    }
#pragma unroll
    for (int i = 0; i < TS; i += 2) { const int t = seg * TS + i; const unsigned wa = pk2(qa[i], qa[i + 1]), wk = pk2(kc[i], kc[i + 1]), wb = pk2(qb[i], qb[i + 1]);
        *(LAS unsigned short*)(QA + t * PITCH + d * 2) = (unsigned short)wa; *(LAS unsigned short*)(QA + (t + 1) * PITCH + d * 2) = (unsigned short)(wa >> 16);
        *(LAS unsigned short*)(KC + t * PITCH + d * 2) = (unsigned short)wk; *(LAS unsigned short*)(KC + (t + 1) * PITCH + d * 2) = (unsigned short)(wk >> 16);
        *(LAS unsigned short*)(QB + t * PITCH + d * 2) = (unsigned short)wb; *(LAS unsigned short*)(QB + (t + 1) * PITCH + d * 2) = (unsigned short)(wb >> 16); }
    __syncthreads();
    }
    {
        const int tt = wave & 3, sp = wave >> 2;
#pragma unroll
        for (int hh = 0; hh < 2; ++hh) {
            const int st = 2 * sp + hh;
            f32x4 acc = (f32x4){0.f, 0.f, 0.f, 0.f};
#pragma unroll
            for (int kd = 0; kd < KD; ++kd) { const bf16x8 a = *(const LAS bf16x8*)(KC + (16 * st + fr) * PITCH + (32 * kd + 8 * fq) * 2), bq = *(const LAS bf16x8*)(QA + (16 * tt + fr) * PITCH + (32 * kd + 8 * fq) * 2);
                acc = mfma16(a, bq, acc); }
            const int t = 16 * tt + fr, s0 = 16 * st + 4 * fq;
            const float p0 = (s0 + 0 <= t) ? acc[0] : 0.f, p1 = (s0 + 1 <= t) ? acc[1] : 0.f, p2 = (s0 + 2 <= t) ? acc[2] : 0.f, p3 = (s0 + 3 <= t) ? acc[3] : 0.f;
            v2u w; w.x = pk2(p0, p1); w.y = pk2(p2, p3);
            *(LAS v2u*)(P + t * 144 + s0 * 2) = w;
        }
    }
    __syncthreads();
    f32x4 o[4];
    {
        f32x4 accX[4];
#pragma unroll
        for (int tt = 0; tt < 4; ++tt) { o[tt] = (f32x4){0.f, 0.f, 0.f, 0.f}; accX[tt] = (f32x4){0.f, 0.f, 0.f, 0.f}; }
#pragma unroll
        for (int ks = 0; ks < 2; ++ks) { const bf16x8 bv = tr_frag(VI, lane, wave, ks);
#pragma unroll
            for (int tt = 0; tt < 4; ++tt) { const bf16x8 a = *(const LAS bf16x8*)(P + (16 * tt + fr) * 144 + (32 * ks + 8 * fq) * 2); o[tt] = mfma16(a, bv, o[tt]); } }
#pragma unroll
        for (int kd = 0; kd < KD; ++kd)
#pragma unroll
            for (int tt = 0; tt < 4; ++tt) { const bf16x8 a = *(const LAS bf16x8*)(QB + (16 * tt + fr) * PITCH + (32 * kd + 8 * fq) * 2); accX[tt] = mfma16(a, sfr[kd], accX[tt]); }
#pragma unroll
        for (int tt = 0; tt < 4; ++tt) o[tt] = o[tt] + accX[tt];
    }
#pragma unroll
    for (int tt = 0; tt < 4; ++tt)
#pragma unroll
        for (int r = 0; r < 4; ++r) { float s = row16_sum(o[tt][r] * o[tt][r]);
            if (fr == 0) __hip_atomic_fetch_add(RED + 16 * tt + 4 * fq + r, s, __ATOMIC_RELAXED, __HIP_MEMORY_SCOPE_WORKGROUP); }
    __syncthreads();
#pragma unroll
    for (int tt = 0; tt < 4; ++tt)
#pragma unroll
        for (int r = 0; r < 4; r += 2) { const int t = 16 * tt + 4 * fq + r; const float rs0 = __builtin_amdgcn_rsqf(RED[t] * (1.f / 128.f) + EPS), rs1 = __builtin_amdgcn_rsqf(RED[t + 1] * (1.f / 128.f) + EPS);
            const unsigned w = pk2(o[tt][r] * rs0 * nwv, o[tt][r + 1] * rs1 * nwv);
            *(LAS unsigned short*)(OT + t * 272 + (16 * wave + fr) * 2) = (unsigned short)w; *(LAS unsigned short*)(OT + (t + 1) * 272 + (16 * wave + fr) * 2) = (unsigned short)(w >> 16); }
    __syncthreads();
    {
        const int ocol = (RET ? 0 : 512) + h * 128;
#pragma unroll
        for (int k = 0; k < 2; ++k) { const int row = (tid >> 4) + 32 * k, ch = tid & 15;
            const v4u ov = *(const LAS v4u*)(OT + row * 272 + ch * 16); const v4u gv = gate[k];
            const unsigned oo[4] = {ov.x, ov.y, ov.z, ov.w}, gg[4] = {gv.x, gv.y, gv.z, gv.w}; unsigned w[4];
#pragma unroll
            for (int e = 0; e < 4; ++e) w[e] = pk2(__builtin_bit_cast(float, oo[e] << 16) * __builtin_bit_cast(float, gg[e] << 16), __builtin_bit_cast(float, oo[e] & 0xffff0000u) * __builtin_bit_cast(float, gg[e] & 0xffff0000u));
            v4u wv; wv.x = w[0]; wv.y = w[1]; wv.z = w[2]; wv.w = w[3];
            *(v4u*)(O + (r0 + row) * 1024 + ocol + ch * 8) = wv; }
    }
}

template <int DK, bool RET>
__device__ __forceinline__ void mix_state_loop(LAS unsigned char* lds, const bf16* proj, bf16* ST, float* BL, int first, int step, int end, int tid_in) {
    int tid = tid_in; asm volatile("" : "+v"(tid));
    if (first >= end) return;
    StRegs<DK> cur; mix_state_load<DK, RET>(cur, proj, first, tid);
    for (int it = first; it < end; it += step) {
        StRegs<DK> nxt = cur;
        const bool more = it + step < end;
        if (more) mix_state_load<DK, RET>(nxt, proj, it + step, tid);
        mix_state_item<DK, RET>(lds, cur, ST, BL, it, tid);
        cur = nxt;
    }
}

__device__ __forceinline__ void mix_out_both(LAS unsigned char* lds, const bf16* proj, const bf16* STH, const bf16* STR, const float* nwH, const float* nwR, bf16* O, int first, int step, int tid_in) {
    int tid = tid_in; asm volatile("" : "+v"(tid));
    if (first >= 1024) return;
    OutRegs<128> ch; mix_out_load<128, false>(ch, proj, STH, nwH, first, tid);
    OutRegs<64> cr;
    for (int it = first; it < 1024; it += step) {
        mix_out_park<128, false>(lds, ch, tid);
        const v4u gate[2] = {ch.gate[0], ch.gate[1]}; bf16x8 sfr[4]; const float nwv = ch.nwv;
#pragma unroll
        for (int kd = 0; kd < 4; ++kd) sfr[kd] = ch.s[kd];
        if (it + step < 1024) mix_out_load<128, false>(ch, proj, STH, nwH, it + step, tid); else mix_out_load<64, true>(cr, proj, STR, nwR, first, tid);
        mix_out_item<128, false>(lds, gate, sfr, nwv, O, it, tid);
    }
    for (int it = first; it < 1024; it += step) {
        mix_out_park<64, true>(lds, cr, tid);
        const v4u gate[2] = {cr.gate[0], cr.gate[1]}; bf16x8 sfr[2]; const float nwv = cr.nwv;
#pragma unroll
        for (int kd = 0; kd < 2; ++kd) sfr[kd] = cr.s[kd];
        if (it + step < 1024) mix_out_load<64, true>(cr, proj, STR, nwR, it + step, tid);
        mix_out_item<64, true>(lds, gate, sfr, nwv, O, it, tid);
    }
}


#ifndef GEMM_SP2
#define GEMM_SP2 true
#endif
#ifndef GEMM_ALIGN
#define GEMM_ALIGN true
#endif
constexpr int I_IN = 16 * 112, I_OUT = 16 * 32, I_G = 16 * 88, I_DN = 44 * 32, I_LAYER = I_IN + I_OUT + 2 * I_G + I_DN;
#define TR_MAPF(x) (x)
#define TR_DECODE(T, IT0_) do { const int IT_ = TR_MAPF(IT0_); const int l_ = (IT_) / I_LAYER; int r_ = (IT_) % I_LAYER; bf16* Wl_ = (bf16*)(ws + WS_W + (size_t)l_ * W_LAYER); \
    if (r_ < I_IN) { T.W = w_in + (size_t)l_ * D * INW; T.WT = Wl_ + W_IN_OFF / 2; T.K = D; T.N = INW; T.item = r_; T.mode = 0; } \
    else if (r_ < I_IN + I_OUT) { T.W = w_out + (size_t)l_ * D * D; T.WT = Wl_ + W_OUT_OFF / 2; T.K = D; T.N = D; T.item = r_ - I_IN; T.mode = 0; } \
    else if (r_ < I_IN + I_OUT + I_G) { T.W = w_gate + (size_t)l_ * D * DFF; T.WT = Wl_ + W_GU_OFF / 2; T.K = D; T.N = DFF; T.item = r_ - I_IN - I_OUT; T.mode = 1; } \
    else if (r_ < I_IN + I_OUT + 2 * I_G) { T.W = w_up + (size_t)l_ * D * DFF; T.WT = Wl_ + W_GU_OFF / 2; T.K = D; T.N = DFF; T.item = r_ - I_IN - I_OUT - I_G; T.mode = 2; } \
    else { T.W = w_down + (size_t)l_ * DFF * D; T.WT = Wl_ + W_DN_OFF / 2; T.K = DFF; T.N = D; T.item = r_ - I_IN - I_OUT - 2 * I_G; T.mode = 0; } } while (0)
#define TRANSPOSE_RANGE(IT0, IT1, WIDX, NW) do { LAS float* scr_ = (LAS float*)(lds + wave * 16384); int it_ = (IT0) + (WIDX); \
    if (it_ < (IT1)) { TrItem cur_; TR_DECODE(cur_, it_); f32x4 v_[8]; transpose_load(v_, cur_, lane); \
        for (;;) { const int nx_ = it_ + (NW); const bool more_ = nx_ < (IT1); TrItem nt_ = cur_; f32x4 vn_[8]; \
            if (more_) { TR_DECODE(nt_, nx_); transpose_load(vn_, nt_, lane); } \
            transpose_store(v_, cur_, scr_, lane); \
            if (!more_) break; \
            cur_ = nt_; it_ = nx_; \
            _Pragma("unroll") for (int i_ = 0; i_ < 8; ++i_) v_[i_] = vn_[i_]; } } } while (0)
#define TRANSPOSE_RANGE_SIMPLE(IT0, IT1, WIDX, NW) do { LAS float* scr_ = (LAS float*)(lds + wave * 16384); \
    for (int it_ = (IT0) + (WIDX); it_ < (IT1); it_ += (NW)) { TrItem cur_; TR_DECODE(cur_, it_); f32x4 v_[8]; transpose_load(v_, cur_, lane); transpose_store(v_, cur_, scr_, lane); } } while (0)
#define SHW_FILL_LOADS
#define SHW_FILL_FOR for (int ib_ = 0; ib_ < 8; ib_ += SHW_FILL_ALL) { f32x4 fa_[SHW_FILL_ALL], fc_[SHW_FILL_ALL]; _Pragma("unroll") for (int it_ = 0; it_ < SHW_FILL_ALL; ++it_) { const int i_ = tid + (ib_ + it_) * (NWAVES * 64), grp_ = i_ >> 10, b_ = (i_ >> 7) & 7, ch_ = i_ & 127; \
        const float* src_ = MOD + ((size_t)(grp_ >> 1) * BATCH + b_) * (NMOD * D) + ((grp_ & 1) ? 3 * D : 0) + ch_ * 8; fa_[it_] = *(const f32x4*)src_; fc_[it_] = *(const f32x4*)(src_ + 4); } \
        _Pragma("unroll") for (int it_ = 0; it_ < SHW_FILL_ALL; ++it_)
#define SHW_FILL_IDX const int i_ = tid + (ib_ + it_) * (NWAVES * 64); const f32x4 a_ = fa_[it_], c_ = fc_[it_];
#define SHW_FILL_END }
#define SHW_MFMA_ALL() do { __syncthreads(); SHW_FILL_LOADS \
    SHW_FILL_FOR { SHW_FILL_IDX const int grp_ = i_ >> 10, b_ = (i_ >> 7) & 7, ch_ = i_ & 127; \
        v4u hi_, lo_; hi_.x = pk2(a_[0], a_[1]); hi_.y = pk2(a_[2], a_[3]); hi_.z = pk2(c_[0], c_[1]); hi_.w = pk2(c_[2], c_[3]); \
        lo_.x = pk2(a_[0] - __builtin_bit_cast(float, hi_.x << 16), a_[1] - __builtin_bit_cast(float, hi_.x & 0xffff0000u)); lo_.y = pk2(a_[2] - __builtin_bit_cast(float, hi_.y << 16), a_[3] - __builtin_bit_cast(float, hi_.y & 0xffff0000u)); \
        lo_.z = pk2(c_[0] - __builtin_bit_cast(float, hi_.z << 16), c_[1] - __builtin_bit_cast(float, hi_.z & 0xffff0000u)); lo_.w = pk2(c_[2] - __builtin_bit_cast(float, hi_.w << 16), c_[3] - __builtin_bit_cast(float, hi_.w & 0xffff0000u)); \
        *(LAS v4u*)(lds + grp_ * 32768 + b_ * 2048 + ((ch_ ^ b_) << 4)) = hi_; *(LAS v4u*)(lds + grp_ * 32768 + (8 + b_) * 2048 + ((ch_ ^ (8 + b_)) << 4)) = lo_; } SHW_FILL_END \
    __syncthreads(); \
    for (int it_ = wave * G + vcu; it_ < DEPTH * 9216 / 16; it_ += NWAVES * G) { \
        const int r0_ = it_ * 16, l_ = r0_ / 9216, rr_ = r0_ % 9216, type_ = rr_ >= INW ? 1 : 0, np0_ = type_ ? rr_ - INW : rr_, fr_ = lane & 15, fq_ = lane >> 4; \
        const bf16* wrow_ = (const bf16*)(ws + WS_W + (size_t)l_ * W_LAYER + (type_ ? W_GU_OFF : W_IN_OFF)) + (size_t)(np0_ + fr_) * D + 8 * fq_; \
        LAS unsigned char* ab_ = lds + (l_ * 2 + type_) * 32768 + fr_ * 2048; \
        f32x4 c_ = {0.f, 0.f, 0.f, 0.f}; \
        { bf16x8 bw_[32];                                     \
            _Pragma("unroll") for (int j_ = 0; j_ < 32; ++j_) bw_[j_] = *(const bf16x8*)(wrow_ + j_ * 32); \
            _Pragma("unroll") for (int j_ = 0; j_ < 32; ++j_) { const int ch_ = 4 * j_ + fq_; c_ = mfma16(*(const LAS bf16x8*)(ab_ + ((ch_ ^ fr_) << 4)), bw_[j_], c_); } } \
        _Pragma("unroll") for (int r_ = 0; r_ < 4; ++r_) { const float t_ = c_[r_] + __shfl_xor(c_[r_], 32); \
            if (lane < 32) { const int bt_ = 4 * fq_ + r_; if (type_) SHW2[((size_t)l_ * BATCH + bt_) * 5632 + np0_ + fr_] = t_; else SHW1[((size_t)l_ * BATCH + bt_) * INW + np0_ + fr_] = t_; } } } } while (0)
#ifndef A0_ROWS
#define A0_ROWS 8
#endif
#ifndef A2_PAD
#define A2_PAD 0
#endif
constexpr int A2_PITCH = D + A2_PAD;
struct Args { const float* in[15]; float* out; unsigned char* ws; };
__global__ void __launch_bounds__(NWAVES * 64, 2) fwd_kernel(Args args) {
    extern __shared__ __attribute__((aligned(16))) unsigned char lds_raw[];
    LAS unsigned char* lds = (LAS unsigned char*)lds_raw;
    volatile LAS unsigned* MISC = (volatile LAS unsigned*)(lds + MISC_OFF);
    const int tid = threadIdx.x, lane = tid & 63, wave = __builtin_amdgcn_readfirstlane(tid >> 6);
    const int G = gridDim.x, bx = blockIdx.x;
    const int vcu = (G % 8 == 0) ? (bx % 8) * (G / 8) + bx / 8 : bx;
    const int gw = vcu * NWAVES + wave, NGW = G * NWAVES;
    unsigned char* ws = args.ws;
    const float* x = args.in[0]; const float* cvec = args.in[1]; const float* w_ada = args.in[2]; const float* b_ada = args.in[3];
    const float* norm_mix_w = args.in[4]; const float* w_in = args.in[5]; const float* ret_norm_w = args.in[6]; const float* hg_lb = args.in[7];
    const float* hg_norm_w = args.in[8]; const float* w_out = args.in[9]; const float* norm_ffn_w = args.in[10]; const float* w_gate = args.in[11];
    const float* w_up = args.in[12]; const float* w_down = args.in[13]; const float* final_w = args.in[14];
    float* out = args.out; bf16* X16 = (bf16*)args.out;
    gu32* ctl = (gu32*)(ws + WS_CTL);
    float* MOD = (float*)(ws + WS_MOD); float* SSUM = (float*)(ws + WS_SSUM); float2* TAB = (float2*)(ws + WS_TAB);
    float* SHW1 = (float*)(ws + WS_SHW1); float* SHW2 = (float*)(ws + WS_SHW2); float* BL = (float*)(ws + WS_BL);
    bf16* ABUF = (bf16*)(ws + WS_A); bf16* PROJ = (bf16*)(ws + WS_PROJ); bf16* URET = (bf16*)(ws + WS_URET); bf16* UHG = (bf16*)(ws + WS_UHG); bf16* A2 = (bf16*)(ws + WS_A2);

    for (int u = tid; u < (LDS_BYTES - LDSCTL_OFF) / 4; u += NWAVES * 64) ((LAS unsigned*)(lds + LDSCTL_OFF))[u] = 0u;
    __syncthreads();
    XcdBarrier bar = xcd_barrier_post((unsigned*)(ctl + CW_BAR), MISC + 8);
#define GRID_BAR() xcd_barrier(bar)

    {
        LAS float* cs = (LAS float*)lds;
        {
            float cv[BATCH * D / (NWAVES * 64)];
#pragma unroll
            for (int it = 0; it < BATCH * D / (NWAVES * 64); ++it) cv[it] = cvec[tid + it * (NWAVES * 64)];
#pragma unroll
            for (int it = 0; it < BATCH * D / (NWAVES * 64); ++it) { const int i = tid + it * (NWAVES * 64);
                cs[i] = pg8::silu_f(cv[it]);
            }
        }
        __syncthreads();
        const int rep_ = 1;
        for (int uidx = vcu; uidx < 240; uidx += G) {
            const int l = uidx / 120, r = uidx % 120, cg = r / 10, ks = r % 10, k0 = (ks * 1024) / 10, k1 = ((ks + 1) * 1024) / 10, n = cg * 512 + tid;
            float acc[BATCH];
#pragma unroll
            for (int b = 0; b < BATCH; ++b) acc[b] = 0.f;
            const float* w = w_ada + (size_t)l * D * (NMOD * D) + n;
            const float* wu = w_ada + (size_t)l * D * (NMOD * D) + cg * 512;
#define ADA_K0 k0
#pragma unroll 17
            for (int k = ADA_K0; k < k1; ++k) { const float wv = LD_ONCE(w + (size_t)k * (NMOD * D));
#pragma unroll
                for (int b = 0; b < BATCH; ++b) acc[b] += cs[b * D + k] * wv; }
            const float bb = ks == 0 ? b_ada[l * NMOD * D + n] : 0.f;
#pragma unroll
            for (int b = 0; b < BATCH; ++b) atomicAdd((rep_ == 1 ? MOD : (float*)(ws + WS_URET)) + ((size_t)l * BATCH + b) * (NMOD * D) + n, acc[b] + bb);
        }
        __syncthreads();
        TRANSPOSE_RANGE(0, DEPTH * I_LAYER, gw, NGW);
        for (int idx = vcu * (NWAVES * 64) + tid; idx < SEQ * 32; idx += G * NWAVES * 64) {
            const int pos = idx >> 5, i = idx & 31;
            const float lin = (float)i / 31.0f;
            const float inv = (float)exp(-(double)lin * 9.210340371976184);
            const float theta = (float)pos * inv;
            const double rev = (double)theta * 0.15915494309189535;
            const double ang = (rev - rint(rev)) * 6.283185307179586;
            TAB[idx] = make_float2((float)cos(ang), (float)sin(ang));
        }
    }
#ifndef X_EARLY_ROWS
#define X_EARLY_ROWS 2
#endif
    f32x4 vx[X_EARLY_ROWS][4];
    const bool xone = (M / A0_ROWS) <= NGW;
#ifndef X_EARLY_DMA
#define X_EARLY_DMA 0
#endif
#define X_REQ() do { if (gw < M / A0_ROWS) { _Pragma("unroll") for (int r = 0; r < X_EARLY_ROWS; ++r) _Pragma("unroll") for (int j = 0; j < 4; ++j) vx[r][j] = LD_ONCE((const f32x4*)(x + (size_t)(gw * A0_ROWS + r) * D) + lane + 64 * j); \
        _Pragma("unroll") for (int r = 0; r < X_EARLY_DMA; ++r) _Pragma("unroll") for (int j = 0; j < 4; ++j) \
            __builtin_amdgcn_global_load_lds((const unsigned*)((const f32x4*)(x + (size_t)(gw * A0_ROWS + X_EARLY_ROWS + r) * D) + lane + 64 * j), (LAS unsigned*)(lds + wave * 16384 + r * 4096 + j * 1024), 16, 0, 0); } } while (0)
    if (xone) { xcd_barrier_hook(bar, [&]() { if (wave != 0) X_REQ(); }); if (wave == 0) X_REQ(); } else GRID_BAR();
    {
#define A0_ROW_PROC(VR_, row_) do { float s = 0.f; \
            _Pragma("unroll") for (int j = 0; j < 4; ++j) s += ((VR_)[j][0] * (VR_)[j][0] + (VR_)[j][1] * (VR_)[j][1]) + ((VR_)[j][2] * (VR_)[j][2] + (VR_)[j][3] * (VR_)[j][3]); \
            s = wave_sum(s); if (lane == 0) SSUM[(row_)] = s; \
            v2u* o8 = (v2u*)(ABUF + (size_t)(row_) * D) + lane; \
            _Pragma("unroll") for (int j = 0; j < 4; ++j) { const f32x4 a = (VR_)[j] * wm[j]; v2u w; w.x = pk2(a[0], a[1]); w.y = pk2(a[2], a[3]); o8[64 * j] = w; } } while (0)
        if (xone) {
            if (gw < M / A0_ROWS) { const int row0 = gw * A0_ROWS, b = row0 >> 11;
                f32x4 vl[A0_ROWS - X_EARLY_ROWS > 0 ? A0_ROWS - X_EARLY_ROWS : 1][4];
#pragma unroll
                for (int r = X_EARLY_ROWS; r < A0_ROWS; ++r)
#pragma unroll
                    for (int j = 0; j < 4; ++j) vl[r - X_EARLY_ROWS][j] = LD_ONCE((const f32x4*)(x + (size_t)(row0 + r) * D) + lane + 64 * j);
                f32x4 wm[4];
#pragma unroll
                for (int j = 0; j < 4; ++j) { const int col = (lane + 64 * j) * 4; wm[j] = (*(const f32x4*)(norm_mix_w + col)) * (1.f + *(const f32x4*)(MOD + (size_t)b * (NMOD * D) + D + col)); }
#pragma unroll
                for (int r = 0; r < X_EARLY_ROWS; ++r) A0_ROW_PROC(vx[r], row0 + r);
#pragma unroll
                for (int r = X_EARLY_ROWS; r < A0_ROWS; ++r) A0_ROW_PROC(vl[r - X_EARLY_ROWS], row0 + r);
            }
        } else
        for (int rg = gw; rg < M / A0_ROWS; rg += NGW) {
            const int row0 = rg * A0_ROWS, b = row0 >> 11;
            f32x4 v[A0_ROWS][4];
#pragma unroll
            for (int r = 0; r < A0_ROWS; ++r)
#pragma unroll
                for (int j = 0; j < 4; ++j) v[r][j] = LD_ONCE((const f32x4*)(x + (size_t)(row0 + r) * D) + lane + 64 * j);
            f32x4 wm[4];
#pragma unroll
            for (int j = 0; j < 4; ++j) { const int col = (lane + 64 * j) * 4; wm[j] = (*(const f32x4*)(norm_mix_w + col)) * (1.f + *(const f32x4*)(MOD + (size_t)b * (NMOD * D) + D + col)); }
#pragma unroll
            for (int r = 0; r < A0_ROWS; ++r) A0_ROW_PROC(v[r], row0 + r);
        }
        SHW_MFMA_ALL();
    }
    GRID_BAR();
    for (int l = 0; l < DEPTH; ++l) {
        const bf16* Wl = (const bf16*)(ws + WS_W + (size_t)l * W_LAYER);
        const float* modl = MOD + (size_t)l * BATCH * (NMOD * D);
        {
            const int nM = M / 256;
            const bool split = (nM * 12) % G == 0 && nM * 4 == G;
            for (int part = 0; part < 2; ++part) {
                const int t0 = part == 0 ? 0 : (split ? 12 : 14), ntl = part == 0 ? (split ? 12 : 14) : (split ? 2 : 0);
                pg8::Gemm g{ABUF, Wl + W_IN_OFF / 2 + (size_t)t0 * 256 * D, M, ntl * 256, D}; pg8::StaticOrder S; S.init(M, ntl * 256, G, bx);
                pg8::EpiWin E{PROJ, SSUM + (size_t)(2 * l) * M, SHW1 + (size_t)l * BATCH * INW, TAB, hg_lb, l, lds + STAGE_OFF, t0};
                pg8::gemm_phase<pg8::EpiWin, pg8::StaticOrder, GEMM_ALIGN, GEMM_SP2>(lds, g, S, E);
                if (part == 0) GRID_BAR();
            }
            int first = bx, step = G;
            if (split) { const int nb = nM * 2; if (bx < nb) { first = bx; step = 1024; } else { first = bx; step = G - nb; } }
            mix_state_loop<128, false>(lds, PROJ, UHG, BL, first, step, 1024, tid);
            mix_state_loop<64, true>(lds, PROJ, URET, BL, first, step, 1024, tid);
        }
        GRID_BAR();
#define DUP3_DUMMY false
        {
            int tid3 = threadIdx.x; asm volatile("" : "+v"(tid3));
            for (int W3 = (tid3 >> 6) * G + bx; W3 < 1536; W3 += NWAVES * G)
            if (W3 < 512) { const int w = W3 * 64 + (tid3 & 63);
                const int bh = w >> 10; bf16* base = URET + (size_t)bh * 32 * 8192 + (size_t)(w & 1023) * 8;
                const float dret = __builtin_amdgcn_exp2f(64.f * __log2f(1.f - exp2f(-5.f - (float)(bh & 3))));
                float S[8]; float z3_ = 0.f; asm volatile("" : "+v"(z3_));
#pragma unroll
                for (int e = 0; e < 8; ++e) S[e] = z3_;
                v4u uv[2][8];
#pragma unroll
                for (int k = 0; k < 8; ++k) uv[0][k] = *(const v4u*)(base + (size_t)k * 8192);
#pragma unroll
                for (int bt = 0; bt < NCH / 8; ++bt) { const int cb = bt * 8;
                    if (bt + 1 < NCH / 8) {
#pragma unroll
                        for (int k = 0; k < 8; ++k) uv[(bt + 1) & 1][k] = *(const v4u*)(base + (size_t)(cb + 8 + k) * 8192);
                    }
                    asm volatile("" ::: "memory");
#pragma unroll
                    for (int k = 0; k < 8; ++k) {
                        v4u sv; sv.x = pk2(S[0], S[1]); sv.y = pk2(S[2], S[3]); sv.z = pk2(S[4], S[5]); sv.w = pk2(S[6], S[7]);
                        *(v4u*)((DUP3_DUMMY ? (bf16*)ABUF + (base - URET) : base) + (size_t)(cb + k) * 8192) = sv;
                        const unsigned uu[4] = {uv[bt & 1][k].x, uv[bt & 1][k].y, uv[bt & 1][k].z, uv[bt & 1][k].w};
#pragma unroll
                        for (int e = 0; e < 4; ++e) { S[2 * e] = dret * S[2 * e] + __builtin_bit_cast(float, uu[e] << 16); S[2 * e + 1] = dret * S[2 * e + 1] + __builtin_bit_cast(float, uu[e] & 0xffff0000u); }
                    }
                    asm volatile("" ::: "memory");
                }
            }
            else { const int w2 = (W3 - 512) * 64 + (tid3 & 63);
                const int bh = w2 >> 11, d0 = (w2 & 15) * 8; bf16* base = UHG + (size_t)bh * 32 * 16384 + (size_t)(w2 & 2047) * 8; const float* blp = BL + (size_t)bh * 32 * 128 + d0;
                float S[8]; float z3_ = 0.f; asm volatile("" : "+v"(z3_));
#pragma unroll
                for (int e = 0; e < 8; ++e) S[e] = z3_;
                v4u uv[2][4]; f32x4 bl0[2][4], bl1[2][4];
#pragma unroll
                for (int k = 0; k < 4; ++k) { uv[0][k] = *(const v4u*)(base + (size_t)k * 16384); bl0[0][k] = *(const f32x4*)(blp + k * 128); bl1[0][k] = *(const f32x4*)(blp + k * 128 + 4); }
#pragma unroll
                for (int bt = 0; bt < NCH / 4; ++bt) { const int cb = bt * 4;
                    if (bt + 1 < NCH / 4) {
#pragma unroll
                        for (int k = 0; k < 4; ++k) { uv[(bt + 1) & 1][k] = *(const v4u*)(base + (size_t)(cb + 4 + k) * 16384); bl0[(bt + 1) & 1][k] = *(const f32x4*)(blp + (cb + 4 + k) * 128); bl1[(bt + 1) & 1][k] = *(const f32x4*)(blp + (cb + 4 + k) * 128 + 4); }
                    }
                    asm volatile("" ::: "memory");
#pragma unroll
                    for (int k = 0; k < 4; ++k) {
                        float dec[8];
#pragma unroll
                        for (int e = 0; e < 4; ++e) { dec[e] = __builtin_amdgcn_exp2f(bl0[bt & 1][k][e]); dec[4 + e] = __builtin_amdgcn_exp2f(bl1[bt & 1][k][e]); }
                        v4u sv; sv.x = pk2(S[0], S[1]); sv.y = pk2(S[2], S[3]); sv.z = pk2(S[4], S[5]); sv.w = pk2(S[6], S[7]);
                        *(v4u*)((DUP3_DUMMY ? (bf16*)((char*)args.out + 33554432) + (base - UHG) : base) + (size_t)(cb + k) * 16384) = sv;
                        const unsigned uu[4] = {uv[bt & 1][k].x, uv[bt & 1][k].y, uv[bt & 1][k].z, uv[bt & 1][k].w};
#pragma unroll
                        for (int e = 0; e < 4; ++e) { S[2 * e] = dec[2 * e] * S[2 * e] + __builtin_bit_cast(float, uu[e] << 16); S[2 * e + 1] = dec[2 * e + 1] * S[2 * e + 1] + __builtin_bit_cast(float, uu[e] & 0xffff0000u); }
                    }
                    asm volatile("" ::: "memory");
                }
            }
        }
        GRID_BAR();
        {
            { mix_out_both(lds, PROJ, UHG, URET, hg_norm_w + l * 512, ret_norm_w + l * 512, ABUF, bx, G, tid); __syncthreads(); }
        }
        GRID_BAR();
        {
            pg8::Gemm g{ABUF, Wl + W_OUT_OFF / 2, M, D, D}; pg8::StaticOrder S; S.init(M, D, G, bx);
            if (l == 0) { pg8::EpiRes<true> E{x, X16, modl + 2 * D, norm_ffn_w + l * D, modl + 4 * D, A2, SSUM + (size_t)(2 * l + 1) * M, A2_PITCH};
                pg8::gemm_phase<pg8::EpiRes<true>, pg8::StaticOrder, true, GEMM_SP2>(lds, g, S, E); }
            else { pg8::EpiRes<false> E{X16, X16, modl + 2 * D, norm_ffn_w + l * D, modl + 4 * D, A2, SSUM + (size_t)(2 * l + 1) * M, A2_PITCH};
                pg8::gemm_phase<pg8::EpiRes<false>, pg8::StaticOrder, true, GEMM_SP2>(lds, g, S, E); }
        }
        GRID_BAR();
        {
            pg8::Gemm g{A2, Wl + W_GU_OFF / 2, M, 2 * DFF, D, A2_PITCH};
            const int nwg6 = (M / 256) * (2 * DFF / 256), remh = nwg6 % G, nfull6 = nwg6 / G; const bool halft = remh != 0 && 2 * remh == G;
            pg8::EpiFfn E{PROJ, SSUM + (size_t)(2 * l + 1) * M, SHW2 + (size_t)l * BATCH * 5632, lds + STAGE_OFF};
            if (halft) {
                pg8::StaticOrder T; T.init(M, 2 * DFF, G, bx % remh); pg8::Unit uh; T.next(nfull6, uh);
                pg8::LimitOrder SL; SL.base.init(M, 2 * DFF, G, bx); SL.maxr = nfull6;
                SL.tA = nullptr; SL.tB = nullptr;
                pg8::gemm_phase<pg8::EpiFfn, pg8::LimitOrder, GEMM_ALIGN, GEMM_SP2>(lds, g, SL, E);
                pg8::gemm_half_unit<pg8::EpiFfn>(lds, g, uh, bx / remh, E, 0);
            } else {
            pg8::StaticOrder S; S.init(M, 2 * DFF, G, bx);
            pg8::gemm_phase<pg8::EpiFfn, pg8::StaticOrder, GEMM_ALIGN, GEMM_SP2>(lds, g, S, E);
            }
        }
        GRID_BAR();
        const bool has_next = (l + 1 < DEPTH);
        const bool fuse_final = !has_next && (M / 256) * (D / 256) == G;
        {
            pg8::Gemm g{PROJ, Wl + W_DN_OFF / 2, M, D, DFF}; pg8::StaticOrder S; S.init(M, D, G, bx);
            if (fuse_final) {
                pg8::EpiFinal E{X16, out, modl + 5 * D, final_w, SSUM + (size_t)(2 * l + 2) * M, &bar};
                pg8::gemm_phase<pg8::EpiFinal, pg8::StaticOrder, false, GEMM_SP2>(lds, g, S, E);
            } else {
                pg8::EpiRes<false> E{X16, X16, modl + 5 * D, has_next ? norm_mix_w + (l + 1) * D : nullptr, modl + BATCH * (NMOD * D) + D, ABUF, SSUM + (size_t)(2 * l + 2) * M};
                pg8::gemm_phase<pg8::EpiRes<false>, pg8::StaticOrder, true, GEMM_SP2>(lds, g, S, E);
            }
        }
        if (fuse_final) return;
        GRID_BAR();
    }
    {
        int tid_f = threadIdx.x; asm volatile("" : "+v"(tid_f)); const int lane_f = tid_f & 63;
        v4u hold[16][2];
#pragma unroll
        for (int i = 0; i < 16; ++i) { const int row = gw + i * NGW; if (row < M) { hold[i][0] = *((const v4u*)(X16 + (size_t)row * D) + lane_f * 2); hold[i][1] = *((const v4u*)(X16 + (size_t)row * D) + lane_f * 2 + 1); } }
        GRID_BAR();
#pragma unroll
        for (int i = 0; i < 16; ++i) { const int row = gw + i * NGW; if (row < M) {
            const float rs = __builtin_amdgcn_rsqf(SSUM[(size_t)4 * M + row] * (1.f / D) + EPS);
#pragma unroll
            for (int hh = 0; hh < 2; ++hh) { const unsigned w4[4] = {hold[i][hh].x, hold[i][hh].y, hold[i][hh].z, hold[i][hh].w};
#pragma unroll
                for (int q = 0; q < 2; ++q) { const int col = lane_f * 16 + hh * 8 + q * 4; const f32x4 fwv = *(const f32x4*)(final_w + col);
                    f32x4 o; o[0] = pg8::f16lo(w4[2 * q]); o[1] = pg8::f16hi(w4[2 * q]); o[2] = pg8::f16lo(w4[2 * q + 1]); o[3] = pg8::f16hi(w4[2 * q + 1]);
                    *(f32x4*)(out + (size_t)row * D + col) = o * rs * fwv; } } } }
    }
}

extern "C" void kernel_launch(void* const* d_in, const int* in_sizes, int n_in, void* d_out, int out_size, void* d_ws, size_t ws_size, hipStream_t stream) {
    static int grid = 0;
    if (grid == 0) {
        if (n_in != 15 || in_sizes[0] != M * D || out_size != M * D || ws_size < WS_END) { fprintf(stderr, "kernel_launch: unexpected shapes (n_in %d, in0 %d, out %d, ws %zu); nothing launched\n", n_in, n_in > 0 ? in_sizes[0] : -1, out_size, ws_size); grid = -1; return; }
        int dev = 0, cus = 0, per_cu = 0;
        if (hipGetDevice(&dev) != hipSuccess || hipDeviceGetAttribute(&cus, hipDeviceAttributeMultiprocessorCount, dev) != hipSuccess) { fprintf(stderr, "kernel_launch: device query failed\n"); grid = -1; return; }
        if (hipFuncSetAttribute((const void*)fwd_kernel, hipFuncAttributeMaxDynamicSharedMemorySize, LDS_BYTES) != hipSuccess) { fprintf(stderr, "kernel_launch: hipFuncSetAttribute failed\n"); grid = -1; return; }
        if (hipOccupancyMaxActiveBlocksPerMultiprocessor(&per_cu, (const void*)fwd_kernel, NWAVES * 64, LDS_BYTES) != hipSuccess || per_cu < 1)
            fprintf(stderr, "kernel_launch: note: occupancy query reports %d workgroups per CU\n", per_cu);
        (void)hipGetLastError();
        grid = cus;
    }
    if (grid < 0) return;
    if (hipMemsetAsync((char*)d_ws + WS_CTL, 0, CTL_ZERO_BYTES, stream) != hipSuccess) { fprintf(stderr, "kernel_launch: hipMemsetAsync failed\n"); return; }
    Args a{};
    for (int i = 0; i < 15; ++i) a.in[i] = (const float*)d_in[i];
    a.out = (float*)d_out; a.ws = (unsigned char*)d_ws;
    hipLaunchKernelGGL(fwd_kernel, dim3(grid), dim3(NWAVES * 64), LDS_BYTES, stream, a);
    const hipError_t le = hipPeekAtLastError();
    if (le != hipSuccess) fprintf(stderr, "kernel_launch: launch failed: %s\n", hipGetErrorName(le));
}
```
